# Optimizing an MI355X kernel written in HIP

```python
import jax
import jax.numpy as jnp
from jax import lax
import numpy as np

D_MODEL = 1024
BATCH = 8
SEQ = 2048
DEPTH = 1

GRID_W = 64
CTX_LEN = 256

NA_HEADS = 8
NA_HEAD_DIM = 64
NA_WIDTH = NA_HEADS * NA_HEAD_DIM
NA_KH = 8
NA_KW = 16
NA_QB_W = 16
NA_KB_W = NA_QB_W + NA_KW
NA_NCB = GRID_W // NA_QB_W

HG_HEADS = 4
HG_DK = 128
HG_WIDTH = HG_HEADS * HG_DK
HG_CHUNK = 64

MIX_WIDTH = NA_WIDTH + HG_WIDTH
IN_COLS = 3 * NA_WIDTH + 5 * HG_WIDTH

PEER_HEADS = 8
PEER_NKEYS = 128
PEER_EXPERTS = PEER_NKEYS * PEER_NKEYS
PEER_TOPK = 16
PEER_DQ = 256
PEER_BLOCK = 128

N_MOD = 6
EPS = 1e-6

kernel_name = "hybrid_natten_hgrn2_peer_dit_layer"


def rms_norm(x, g):
    xf = x.astype(jnp.float32)
    y = xf * lax.rsqrt(jnp.mean(xf * xf, axis=-1, keepdims=True) + EPS)
    return (y * g.astype(jnp.float32)).astype(x.dtype)


def modulate(h, shift, scale):
    return h * (1 + scale) + shift


def neighbourhood_attention(q, k, v, k_ctx, v_ctx, rpb):
    B, S, H, Dh = q.shape
    rows = S // GRID_W
    kh = min(NA_KH, rows)
    scale = Dh ** -0.5
    qg = q.reshape(B, rows, GRID_W, H, Dh)
    kg = k.reshape(B, rows, GRID_W, H, Dh)
    vg = v.reshape(B, rows, GRID_W, H, Dh)
    qcol = np.arange(GRID_W).reshape(NA_NCB, NA_QB_W)
    kc0 = np.clip(qcol[:, 0] - NA_KW // 2, 0, GRID_W - NA_KB_W)
    kcol = kc0[:, None] + np.arange(NA_KB_W)[None, :]
    cstart = np.clip(qcol - NA_KW // 2, 0, GRID_W - NA_KW)
    col_ok = (kcol[:, None, :] >= cstart[..., None]) & (kcol[:, None, :] < cstart[..., None] + NA_KW)
    dc_idx = np.clip(kcol[:, None, :] - qcol[..., None] + NA_KW - 1, 0, 2 * NA_KW - 2)
    n_win = kh * NA_KB_W

    def row_block(r):
        rs = jnp.clip(r - kh // 2, 0, rows - kh)
        q_r = lax.dynamic_index_in_dim(qg, r, axis=1, keepdims=False).reshape(B, NA_NCB, NA_QB_W, H, Dh)
        k_rows = lax.dynamic_slice_in_dim(kg, rs, kh, axis=1)
        v_rows = lax.dynamic_slice_in_dim(vg, rs, kh, axis=1)
        kb = k_rows[:, :, kcol]
        vb = v_rows[:, :, kcol]
        dr_idx = rs + jnp.arange(kh) - r + NA_KH - 1
        bias = rpb[:, dr_idx[None, None, :, None], dc_idx[:, :, None, :]]
        s_win = jnp.einsum('bcqhd,bkcjhd->bhcqkj', q_r, kb).astype(jnp.float32) * scale
        s_win = jnp.where(col_ok[None, None, :, :, None, :], s_win + bias.astype(jnp.float32)[None], -jnp.inf)
        s_ctx = jnp.einsum('bcqhd,blhd->bhcql', q_r, k_ctx).astype(jnp.float32) * scale
        p = jax.nn.softmax(jnp.concatenate([s_win.reshape(B, H, NA_NCB, NA_QB_W, n_win), s_ctx], axis=-1), axis=-1)
        p = p.astype(v.dtype)
        p_win = p[..., :n_win].reshape(B, H, NA_NCB, NA_QB_W, kh, NA_KB_W)
        o = (jnp.einsum('bhcqkj,bkcjhd->bcqhd', p_win, vb)
             + jnp.einsum('bhcql,blhd->bcqhd', p[..., n_win:], v_ctx))
        return o.reshape(B, GRID_W, H, Dh)

    out = lax.map(row_block, jnp.arange(rows))
    return jnp.moveaxis(out, 0, 1).reshape(B, S, H * Dh)


def context_attention(q, k, v):
    B, L, H, Dh = q.shape
    s = jnp.einsum('blhd,bmhd->bhlm', q, k).astype(jnp.float32) * Dh ** -0.5
    p = jax.nn.softmax(s, axis=-1).astype(v.dtype)
    return jnp.einsum('bhlm,bmhd->blhd', p, v).reshape(B, L, H * Dh)


def _na_heads(t):
    B, T, _ = t.shape
    return t.reshape(B, T, NA_HEADS, NA_HEAD_DIM)


def _hg_heads(t):
    B, T, _ = t.shape
    return t.reshape(B, T, HG_HEADS, HG_DK).transpose(0, 2, 1, 3)


def _forget(z, lb):
    lb = lb.reshape(HG_HEADS, 1, HG_DK)
    f = lb + (1 - lb) * jax.nn.sigmoid(z.astype(jnp.float32))
    return jnp.log(f), 1 - f


def _time_flip(t, rev):
    return jnp.flip(t, axis=2) if rev else t


def gla_chunked(q, k, v, log_f, s0, with_output):
    B, H, T, _ = q.shape
    n_chunks = T // HG_CHUNK

    def chunks(t):
        return t.astype(jnp.float32).reshape(B, H, n_chunks, HG_CHUNK, t.shape[-1]).transpose(2, 0, 1, 3, 4)

    kc, vc, lfc = chunks(k), chunks(v), chunks(log_f)

    def update(S, k_n, v_n, b):
        b_last = b[:, :, -1:, :]
        k_dec = k_n * jnp.exp(b_last - b)
        return jnp.exp(b_last[:, :, 0, :])[..., None] * S + jnp.einsum('bhsd,bhsv->bhdv', k_dec, v_n)

    if not with_output:
        def state_step(S, xs):
            k_n, v_n, lf_n = xs
            return update(S, k_n, v_n, jnp.cumsum(lf_n, axis=2)), None
        s_fin, _ = lax.scan(state_step, s0, (kc, vc, lfc))
        return None, s_fin

    qc = chunks(q)
    causal = jnp.tril(jnp.ones((HG_CHUNK, HG_CHUNK), dtype=bool))

    def step(S, xs):
        q_n, k_n, v_n, lf_n = xs
        b = jnp.cumsum(lf_n, axis=2)
        pair = b[:, :, :, None, :] - b[:, :, None, :, :]
        decay = jnp.exp(jnp.where(causal[:, :, None], pair, -jnp.inf))
        A = jnp.einsum('bhtd,bhsd,bhtsd->bhts', q_n, k_n, decay)
        o = jnp.einsum('bhts,bhsv->bhtv', A, v_n) + jnp.einsum('bhtd,bhdv->bhtv', q_n * jnp.exp(b), S)
        return update(S, k_n, v_n, b), o

    s_fin, o = lax.scan(step, s0, (qc, kc, vc, lfc))
    o = o.transpose(1, 2, 0, 3, 4).reshape(B, H, T, -1)
    return o, s_fin


def _gated_out(o, g, norm_g):
    B, H, T, Dv = o.shape
    o = o * lax.rsqrt(jnp.mean(o * o, axis=-1, keepdims=True) + EPS) * norm_g.astype(jnp.float32).reshape(H, 1, Dv)
    o = o * jax.nn.silu(_hg_heads(g).astype(jnp.float32))
    return o.transpose(0, 2, 1, 3).reshape(B, T, H * Dv).astype(g.dtype)


def hgrn2_mixer(px, pc, lb, norm_g, need_ctx):
    qx, vx = jax.nn.silu(_hg_heads(px[0])), _hg_heads(px[3])
    qc, vc = jax.nn.silu(_hg_heads(pc[0])), _hg_heads(pc[3])
    s0 = jnp.zeros((qx.shape[0], HG_HEADS, HG_DK, HG_DK), jnp.float32)
    outs_x, outs_c = [], []
    for d in range(2):
        rev = d == 1
        lf_c, k_c = _forget(_hg_heads(pc[1 + d]), lb[d])
        lf_x, k_x = _forget(_hg_heads(px[1 + d]), lb[d])
        o_c, s_c = gla_chunked(_time_flip(qc, rev), _time_flip(k_c, rev), _time_flip(vc, rev),
                               _time_flip(lf_c, rev), s0, need_ctx)
        o_x, _ = gla_chunked(_time_flip(qx, rev), _time_flip(k_x, rev), _time_flip(vx, rev),
                             _time_flip(lf_x, rev), s_c, True)
        outs_x.append(_time_flip(o_x, rev))
        if need_ctx:
            outs_c.append(_time_flip(o_c, rev))
    y_x = _gated_out(outs_x[0] + outs_x[1], px[4], norm_g)
    y_c = _gated_out(outs_c[0] + outs_c[1], pc[4], norm_g) if need_ctx else None
    return y_x, y_c


def peer_ffn(h, wq, sub_keys, u, v):
    B, T, D = h.shape
    tok = h.reshape(-1, PEER_BLOCK, D)

    def block(t):
        q = (t @ wq).reshape(PEER_BLOCK, PEER_HEADS, 2, PEER_DQ // 2)
        s = jnp.einsum('tpcd,pckd->tpck', q, sub_keys).astype(jnp.float32)
        s1, i1 = lax.top_k(s[:, :, 0], PEER_TOPK)
        s2, i2 = lax.top_k(s[:, :, 1], PEER_TOPK)
        cand = (s1[..., :, None] + s2[..., None, :]).reshape(PEER_BLOCK, PEER_HEADS, PEER_TOPK * PEER_TOPK)
        cidx = (i1[..., :, None] * PEER_NKEYS + i2[..., None, :]).reshape(PEER_BLOCK, PEER_HEADS, PEER_TOPK * PEER_TOPK)
        top, pos = lax.top_k(cand, PEER_TOPK)
        idx = jnp.take_along_axis(cidx, pos, axis=-1)
        g = jax.nn.softmax(top, axis=-1)
        a = jax.nn.gelu(jnp.einsum('tpkd,td->tpk', u[idx], t).astype(jnp.float32), approximate=False)
        return jnp.einsum('tpk,tpkd->td', (g * a).astype(t.dtype), v[idx])

    return lax.map(block, tok).reshape(B, T, D)


def setup_inputs(seed: int = 0) -> dict:
    key = jax.random.key(seed)
    ks = jax.random.split(key, 18)

    def nrm(k, shape, scale):
        return jax.random.normal(k, shape, jnp.float32) * scale

    return {
        'x': nrm(ks[0], (BATCH, SEQ, D_MODEL), 1.0),
        'c': nrm(ks[1], (BATCH, D_MODEL), 1.0),
        'ctx': nrm(ks[2], (BATCH, CTX_LEN, D_MODEL), 1.0),
        'c_ctx': nrm(ks[3], (D_MODEL,), 1.0),
        'w_mod': nrm(ks[4], (DEPTH, D_MODEL, N_MOD * D_MODEL), 0.5 * D_MODEL ** -0.5),
        'b_mod': nrm(ks[5], (DEPTH, N_MOD * D_MODEL), 0.01),
        'norm1': 1.0 + nrm(ks[6], (DEPTH, D_MODEL), 0.05),
        'norm2': 1.0 + nrm(ks[7], (DEPTH, D_MODEL), 0.05),
        'w_in': nrm(ks[8], (DEPTH, D_MODEL, IN_COLS), D_MODEL ** -0.5),
        'w_out': nrm(ks[9], (DEPTH, MIX_WIDTH, D_MODEL), MIX_WIDTH ** -0.5),
        'na_rpb': nrm(ks[10], (DEPTH, NA_HEADS, 2 * NA_KH - 1, 2 * NA_KW - 1), 0.2),
        'hg_lb': nrm(ks[11], (DEPTH + 1, 2, HG_WIDTH), 1.0),
        'hg_norm': 1.0 + nrm(ks[12], (DEPTH, HG_WIDTH), 0.05),
        'peer_wq': nrm(ks[13], (DEPTH, D_MODEL, PEER_HEADS * PEER_DQ), D_MODEL ** -0.5),
        'peer_keys': nrm(ks[14], (DEPTH, PEER_HEADS, 2, PEER_NKEYS, PEER_DQ // 2), (PEER_DQ // 2) ** -0.5),
        'peer_u': nrm(ks[15], (DEPTH, PEER_EXPERTS, D_MODEL), D_MODEL ** -0.5),
        'peer_v': nrm(ks[16], (DEPTH, PEER_EXPERTS, D_MODEL), PEER_HEADS ** -0.5),
        'norm_f': 1.0 + nrm(ks[17], (D_MODEL,), 0.05),
    }


def reference(x, c, ctx, c_ctx, w_mod, b_mod, norm1, norm2, w_in, w_out, na_rpb, hg_lb, hg_norm,
              peer_wq, peer_keys, peer_u, peer_v, norm_f):
    lb_all = jnp.cumsum(jax.nn.softmax(hg_lb.astype(jnp.float32), axis=0), axis=0)
    splits = [NA_WIDTH, 2 * NA_WIDTH, 3 * NA_WIDTH] + [3 * NA_WIDTH + j * HG_WIDTH for j in range(1, 5)]
    for l in range(DEPTH):
        need_ctx = l < DEPTH - 1
        mod_x = (jax.nn.silu(c) @ w_mod[l] + b_mod[l])[:, None, :]
        mod_c = jax.nn.silu(c_ctx) @ w_mod[l] + b_mod[l]
        sh1, sc1, gt1, sh2, sc2, gt2 = jnp.split(mod_x, N_MOD, axis=-1)
        csh1, csc1, cgt1, csh2, csc2, cgt2 = jnp.split(mod_c, N_MOD, axis=-1)

        px = jnp.split(modulate(rms_norm(x, norm1[l]), sh1, sc1) @ w_in[l], splits, axis=-1)
        pc = jnp.split(modulate(rms_norm(ctx, norm1[l]), csh1, csc1) @ w_in[l], splits, axis=-1)
        k_ctx, v_ctx = _na_heads(pc[1]), _na_heads(pc[2])
        na_x = neighbourhood_attention(_na_heads(px[0]), _na_heads(px[1]), _na_heads(px[2]),
                                       k_ctx, v_ctx, na_rpb[l])
        hg_x, hg_c = hgrn2_mixer(px[3:], pc[3:], lb_all[l], hg_norm[l], need_ctx)
        x = x + gt1 * (jnp.concatenate([na_x, hg_x], axis=-1) @ w_out[l])
        if need_ctx:
            na_c = context_attention(_na_heads(pc[0]), k_ctx, v_ctx)
            ctx = ctx + cgt1 * (jnp.concatenate([na_c, hg_c], axis=-1) @ w_out[l])
            ctx = ctx + cgt2 * peer_ffn(modulate(rms_norm(ctx, norm2[l]), csh2, csc2),
                                        peer_wq[l], peer_keys[l], peer_u[l], peer_v[l])

        x = x + gt2 * peer_ffn(modulate(rms_norm(x, norm2[l]), sh2, sc2),
                               peer_wq[l], peer_keys[l], peer_u[l], peer_v[l])
    return rms_norm(x, norm_f)
```

```cpp
#include <hip/hip_runtime.h>
#include <cstdint>
#include <cstdio>

typedef unsigned short bf16_t;
typedef short bf16x8 __attribute__((ext_vector_type(8)));
typedef float f32x4 __attribute__((ext_vector_type(4)));
typedef unsigned u32x4 __attribute__((ext_vector_type(4)));
typedef unsigned u32x2 __attribute__((ext_vector_type(2)));

namespace {
constexpr int NB = 8, NS = 2048, ND = 1024, NL = 256, GW = 64, NROWS = 32;
constexpr int MT = NB * NS;
constexpr int MC = NB * NL;
constexpr int MA = MT + MC;
constexpr int NIN = 4096;
constexpr int NT = 512;
constexpr float EPS = 1e-6f;

constexpr size_t MiB = 1ull << 20;
constexpr size_t WS_CTL = 0;
constexpr size_t WS_MOD = 64 * 1024;
constexpr size_t WS_LB = 320 * 1024;
constexpr size_t WS_KEYS = 512 * 1024;
constexpr size_t WS_WIN = 1 * MiB;
constexpr size_t WS_WOUT = 9 * MiB;
constexpr size_t WS_WQ = 11 * MiB;
constexpr size_t WS_U = 15 * MiB;
constexpr size_t WS_V = 47 * MiB;
constexpr size_t WS_XN = 79 * MiB;
constexpr size_t WS_NAQ = 115 * MiB;
constexpr size_t WS_NAK = 131 * MiB;
constexpr size_t WS_NAV = 149 * MiB;
constexpr size_t WS_HQ = 167 * MiB;
constexpr size_t WS_ZF = 183 * MiB;
constexpr size_t WS_ZB = 201 * MiB;
constexpr size_t WS_HI = 219 * MiB;
constexpr size_t WS_HG = 237 * MiB;
constexpr size_t WS_END = 253 * MiB;
constexpr size_t WS_PQ = 115 * MiB;
constexpr size_t WS_PIDX = 179 * MiB;
constexpr size_t WS_PG = 187 * MiB;

struct Params {
    const float* x; const float* c; const float* ctx; const float* c_ctx; const float* w_mod; const float* b_mod;
    const float* norm1; const float* norm2; const float* w_in; const float* w_out; const float* rpb; const float* hg_lb;
    const float* hg_norm; const float* wq; const float* keys; const float* pu; const float* pv; const float* norm_f;
    float* out; unsigned char* ws;
};

__device__ __forceinline__ bf16_t f2bf(float f) { unsigned u = __float_as_uint(f); u += 0x7fffu + ((u >> 16) & 1u); return (bf16_t)(u >> 16); }
__device__ __forceinline__ float bf2f(bf16_t h) { return __uint_as_float(((unsigned)h) << 16); }
__device__ __forceinline__ unsigned pack2(float lo, float hi) { return (unsigned)f2bf(lo) | ((unsigned)f2bf(hi) << 16); }
__device__ __forceinline__ float bflo(unsigned w) { return __uint_as_float(w << 16); }
__device__ __forceinline__ float bfhi(unsigned w) { return __uint_as_float(w & 0xffff0000u); }
__device__ __forceinline__ float silu_f(float v) { return v / (1.f + __expf(-v)); }
__device__ __forceinline__ float sigmoid_f(float v) { return 1.f / (1.f + __expf(-v)); }
__device__ __forceinline__ float wave_sum(float v) {
#pragma unroll
    for (int o = 32; o >= 1; o >>= 1) v += __shfl_xor(v, o);
    return v;
}

__device__ void mod_phase(const Params& p, float* lds) {
    float* sc = lds;
    float* red = lds + 9 * 1024;
    const int tid = threadIdx.x;
    float* mod = (float*)(p.ws + WS_MOD);
    for (int i = tid; i < 9 * 1024; i += NT) {
        const int r = i >> 10, k = i & 1023;
        const float v = (r < 8) ? p.c[r * 1024 + k] : p.c_ctx[k];
        sc[i] = silu_f(v);
    }
    __syncthreads();
    const int col = tid & 63, ks = tid >> 6;
    for (int unit = blockIdx.x; unit < 6144 / 64; unit += gridDim.x) {
        const int j = unit * 64 + col;
        float acc[9];
#pragma unroll
        for (int r = 0; r < 9; ++r) acc[r] = 0.f;
        for (int k = ks * 128; k < ks * 128 + 128; ++k) {
            const float w = p.w_mod[(size_t)k * 6144 + j];
#pragma unroll
            for (int r = 0; r < 9; ++r) acc[r] += sc[r * 1024 + k] * w;
        }
#pragma unroll
        for (int r = 0; r < 9; ++r) red[(ks * 9 + r) * 64 + col] = acc[r];
        __syncthreads();
        for (int i = tid; i < 9 * 64; i += NT) {
            const int r = i >> 6, cc = i & 63;
            float s = 0.f;
#pragma unroll
            for (int q = 0; q < 8; ++q) s += red[(q * 9 + r) * 64 + cc];
            mod[r * 6144 + unit * 64 + cc] = s + p.b_mod[unit * 64 + cc];
        }
        __syncthreads();
    }
    float* lb = (float*)(p.ws + WS_LB);
    for (int i = blockIdx.x * NT + tid; i < 1024; i += gridDim.x * NT) {
        const float a0 = p.hg_lb[i], a1 = p.hg_lb[1024 + i];
        lb[i] = 1.f / (1.f + __expf(a1 - a0));
    }
}

__device__ void transpose_convert(const float* W, bf16_t* Wt, int K, int N, float* lds) {
    const int tid = threadIdx.x;
    const int tk = K / 64, tn = N / 64;
    for (int unit = blockIdx.x; unit < tk * tn; unit += gridDim.x) {
        const int k0 = (unit / tn) * 64, n0 = (unit % tn) * 64;
        for (int i = tid; i < 64 * 64; i += NT) { const int r = i >> 6, cc = i & 63; lds[r * 65 + cc] = W[(size_t)(k0 + r) * N + n0 + cc]; }
        __syncthreads();
        for (int i = tid; i < 64 * 64; i += NT) { const int n = i >> 6, k = i & 63; Wt[(size_t)(n0 + n) * K + k0 + k] = f2bf(lds[k * 65 + n]); }
        __syncthreads();
    }
}
__device__ void convert_flat(const float* src, bf16_t* dst, size_t n) {
    const size_t stride = (size_t)gridDim.x * NT * 4;
    for (size_t i = ((size_t)blockIdx.x * NT + threadIdx.x) * 4; i < n; i += stride) {
        const f32x4 v = *(const f32x4*)(src + i);
        u32x2 o; o.x = pack2(v[0], v[1]); o.y = pack2(v[2], v[3]);
        *(u32x2*)(dst + i) = o;
    }
}

__device__ void prep_phase(const Params& p, int which) {
    const int tid = threadIdx.x, lane = tid & 63, wave = tid >> 6;
    const float* mod = (const float*)(p.ws + WS_MOD);
    bf16_t* dst = (bf16_t*)(p.ws + WS_XN);
    const int nrows = which == 0 ? MA : MT;
    const float* g = which == 0 ? p.norm1 : p.norm2;
    for (int row = blockIdx.x * 8 + wave; row < nrows; row += gridDim.x * 8) {
        const float* src; int mr;
        if (which == 0) { if (row < MT) { src = p.x + (size_t)row * ND; mr = row / NS; } else { src = p.ctx + (size_t)(row - MT) * ND; mr = 8; } }
        else { src = p.out + (size_t)row * ND; mr = row / NS; }
        const float* sh = mod + mr * 6144 + (which == 0 ? 0 : 3072);
        const float* scl = mod + mr * 6144 + (which == 0 ? 1024 : 4096);
        f32x4 v[4]; float ss = 0.f;
#pragma unroll
        for (int i = 0; i < 4; ++i) { v[i] = *(const f32x4*)(src + i * 256 + lane * 4); ss += v[i][0] * v[i][0] + v[i][1] * v[i][1] + v[i][2] * v[i][2] + v[i][3] * v[i][3]; }
        ss = wave_sum(ss);
        const float rstd = rsqrtf(ss * (1.f / ND) + EPS);
#pragma unroll
        for (int i = 0; i < 4; ++i) {
            const int d = i * 256 + lane * 4;
            const f32x4 gg = *(const f32x4*)(g + d), s1 = *(const f32x4*)(sh + d), s2 = *(const f32x4*)(scl + d);
            float h[4];
#pragma unroll
            for (int e = 0; e < 4; ++e) h[e] = (v[i][e] * rstd * gg[e]) * (1.f + s2[e]) + s1[e];
            u32x2 o; o.x = pack2(h[0], h[1]); o.y = pack2(h[2], h[3]);
            *(u32x2*)(dst + (size_t)row * ND + d) = o;
        }
    }
}

template <class Epi>
__device__ __forceinline__ void gemm_tile(const bf16_t* __restrict__ A, int lda, const bf16_t* __restrict__ Bt, int ldb, int K, int m0, int n0, unsigned char* lds, const Epi& epi) {
    unsigned char* As = lds; unsigned char* Bs = lds + 32768;
    const int tid = threadIdx.x, lane = tid & 63, wave = tid >> 6;
    const int wm = wave >> 1, wn = wave & 1;
    const int lr = tid >> 3, lc = tid & 7;
    const int fr = lane & 15, fq = lane >> 4;
    f32x4 acc[4][4];
#pragma unroll
    for (int i = 0; i < 4; ++i)
#pragma unroll
        for (int j = 0; j < 4; ++j) acc[i][j] = (f32x4){0.f, 0.f, 0.f, 0.f};
    u32x4 ra[4], rb[2];
    const bf16_t* Ap = A + (size_t)(m0 + lr) * lda + lc * 8;
    const bf16_t* Bp = Bt + (size_t)(n0 + lr) * ldb + lc * 8;
#pragma unroll
    for (int i = 0; i < 4; ++i) ra[i] = *(const u32x4*)(Ap + (size_t)(i * 64) * lda);
#pragma unroll
    for (int i = 0; i < 2; ++i) rb[i] = *(const u32x4*)(Bp + (size_t)(i * 64) * ldb);
    const int nkt = K / 64;
    for (int kt = 0; kt < nkt; ++kt) {
#pragma unroll
        for (int i = 0; i < 4; ++i) { const int r = lr + i * 64; *(u32x4*)(As + r * 128 + ((lc ^ (r & 7)) << 4)) = ra[i]; }
#pragma unroll
        for (int i = 0; i < 2; ++i) { const int r = lr + i * 64; *(u32x4*)(Bs + r * 128 + ((lc ^ (r & 7)) << 4)) = rb[i]; }
        __syncthreads();
        if (kt + 1 < nkt) {
            const int k0 = (kt + 1) * 64;
#pragma unroll
            for (int i = 0; i < 4; ++i) ra[i] = *(const u32x4*)(Ap + (size_t)(i * 64) * lda + k0);
#pragma unroll
            for (int i = 0; i < 2; ++i) rb[i] = *(const u32x4*)(Bp + (size_t)(i * 64) * ldb + k0);
        }
#pragma unroll
        for (int kk = 0; kk < 2; ++kk) {
            const int ch = kk * 4 + fq;
            bf16x8 fa[4], fb[4];
#pragma unroll
            for (int i = 0; i < 4; ++i) { const int r = wm * 64 + i * 16 + fr; fa[i] = *(const bf16x8*)(As + r * 128 + ((ch ^ (r & 7)) << 4)); }
#pragma unroll
            for (int j = 0; j < 4; ++j) { const int r = wn * 64 + j * 16 + fr; fb[j] = *(const bf16x8*)(Bs + r * 128 + ((ch ^ (r & 7)) << 4)); }
#pragma unroll
            for (int i = 0; i < 4; ++i)
#pragma unroll
                for (int j = 0; j < 4; ++j) acc[i][j] = __builtin_amdgcn_mfma_f32_16x16x32_bf16(fb[j], fa[i], acc[i][j], 0, 0, 0);
        }
        __syncthreads();
    }
#pragma unroll
    for (int i = 0; i < 4; ++i)
#pragma unroll
        for (int j = 0; j < 4; ++j) epi(m0 + wm * 64 + i * 16 + fr, n0 + wn * 64 + j * 16 + fq * 4, acc[i][j]);
}

__device__ __forceinline__ void store_bf16x4(bf16_t* dst, const f32x4& v) { u32x2 o; o.x = pack2(v[0], v[1]); o.y = pack2(v[2], v[3]); *(u32x2*)dst = o; }

struct EpiInProj {
    unsigned char* ws;
    __device__ __forceinline__ void operator()(int m, int n, const f32x4& v) const {
        const int seg = n >> 9, c = n & 511;
        const size_t o = (size_t)m * 512 + c;
        switch (seg) {
            case 0: { f32x4 s = v * 0.125f; store_bf16x4((bf16_t*)(ws + WS_NAQ) + o, s); break; }
            case 1: store_bf16x4((bf16_t*)(ws + WS_NAK) + o, v); break;
            case 2: store_bf16x4((bf16_t*)(ws + WS_NAV) + o, v); break;
            case 3: { f32x4 s; s[0] = silu_f(v[0]); s[1] = silu_f(v[1]); s[2] = silu_f(v[2]); s[3] = silu_f(v[3]); store_bf16x4((bf16_t*)(ws + WS_HQ) + o, s); break; }
            case 4: store_bf16x4((bf16_t*)(ws + WS_ZF) + o, v); break;
            case 5: store_bf16x4((bf16_t*)(ws + WS_ZB) + o, v); break;
            case 6: store_bf16x4((bf16_t*)(ws + WS_HI) + o, v); break;
            default: { f32x4 s; s[0] = silu_f(v[0]); s[1] = silu_f(v[1]); s[2] = silu_f(v[2]); s[3] = silu_f(v[3]); store_bf16x4((bf16_t*)(ws + WS_HG) + o, s); break; }
        }
    }
};
__device__ void inproj_phase(const Params& p, unsigned char* lds) {
    const bf16_t* A = (const bf16_t*)(p.ws + WS_XN); const bf16_t* Bt = (const bf16_t*)(p.ws + WS_WIN);
    EpiInProj epi{p.ws};
    const int nlat = 64 * 32, nctx = 8 * 20;
    for (int unit = blockIdx.x; unit < nlat + nctx; unit += gridDim.x) {
        int mt, nt;
        if (unit < nlat) { mt = unit >> 5; nt = unit & 31; }
        else { const int u = unit - nlat; mt = 64 + u / 20; const int q = u % 20; nt = q < 8 ? 4 + q : 16 + (q - 8); }
        gemm_tile(A, ND, Bt, ND, ND, mt * 256, nt * 128, lds, epi);
    }
}

struct EpiOutProj {
    const float* x; const float* mod; float* out;
    __device__ __forceinline__ void operator()(int m, int n, const f32x4& v) const {
        const int b = m / NS;
        const f32x4 xv = *(const f32x4*)(x + (size_t)m * ND + n), g = *(const f32x4*)(mod + b * 6144 + 2048 + n);
        *(f32x4*)(out + (size_t)m * ND + n) = xv + g * v;
    }
};
__device__ void outproj_phase(const Params& p, unsigned char* lds) {
    const bf16_t* A = (const bf16_t*)(p.ws + WS_XN); const bf16_t* Bt = (const bf16_t*)(p.ws + WS_WOUT);
    EpiOutProj epi{p.x, (const float*)(p.ws + WS_MOD), p.out};
    for (int unit = blockIdx.x; unit < 64 * 8; unit += gridDim.x) gemm_tile(A, ND, Bt, ND, ND, (unit >> 3) * 256, (unit & 7) * 128, lds, epi);
}
struct EpiPq { bf16_t* pq; __device__ __forceinline__ void operator()(int m, int n, const f32x4& v) const { store_bf16x4(pq + (size_t)m * 2048 + n, v); } };
__device__ void pq_phase(const Params& p, unsigned char* lds) {
    const bf16_t* A = (const bf16_t*)(p.ws + WS_XN); const bf16_t* Bt = (const bf16_t*)(p.ws + WS_WQ);
    EpiPq epi{(bf16_t*)(p.ws + WS_PQ)};
    for (int unit = blockIdx.x; unit < 64 * 16; unit += gridDim.x) gemm_tile(A, ND, Bt, ND, ND, (unit >> 4) * 256, (unit & 15) * 128, lds, epi);
}

__device__ void na_naive_phase(const Params& p) {
    const bf16_t* Q = (const bf16_t*)(p.ws + WS_NAQ); const bf16_t* Kk = (const bf16_t*)(p.ws + WS_NAK); const bf16_t* V = (const bf16_t*)(p.ws + WS_NAV);
    bf16_t* mix = (bf16_t*)(p.ws + WS_XN);
    const int tid = threadIdx.x;
    for (int unit = blockIdx.x; unit < MT / 64; unit += gridDim.x) {
        const int tok = unit * 64 + (tid >> 3), h = tid & 7;
        const int b = tok / NS, s = tok % NS, r = s >> 6, qc = s & 63;
        const int rs = min(max(r - 4, 0), NROWS - 8), cs = min(max(qc - 8, 0), GW - 16);
        float q[64], o[64];
        {
            const u32x4* qp = (const u32x4*)(Q + (size_t)tok * 512 + h * 64);
#pragma unroll
            for (int i = 0; i < 8; ++i) { const u32x4 w = qp[i];
#pragma unroll
                for (int e = 0; e < 4; ++e) { q[i * 8 + e * 2] = bflo(w[e]); q[i * 8 + e * 2 + 1] = bfhi(w[e]); } }
        }
#pragma unroll
        for (int i = 0; i < 64; ++i) o[i] = 0.f;
        float mx = -1e30f, l = 0.f;
        for (int it = 0; it < 128 + 256; ++it) {
            int kt; float bias = 0.f;
            if (it < 128) { const int kr = it >> 4, kc = it & 15; kt = b * NS + (rs + kr) * 64 + cs + kc; bias = p.rpb[h * 15 * 31 + (rs + kr - r + 7) * 31 + (cs + kc - qc + 15)]; }
            else kt = MT + b * NL + (it - 128);
            const u32x4* kp = (const u32x4*)(Kk + (size_t)kt * 512 + h * 64);
            float d = 0.f;
#pragma unroll
            for (int i = 0; i < 8; ++i) { const u32x4 w = kp[i];
#pragma unroll
                for (int e = 0; e < 4; ++e) { d += q[i * 8 + e * 2] * bflo(w[e]); d += q[i * 8 + e * 2 + 1] * bfhi(w[e]); } }
            d += bias;
            const float mn = fmaxf(mx, d), sc = __expf(mx - mn), pe = __expf(d - mn);
            l = l * sc + pe; mx = mn;
            const u32x4* vp = (const u32x4*)(V + (size_t)kt * 512 + h * 64);
#pragma unroll
            for (int i = 0; i < 8; ++i) { const u32x4 w = vp[i];
#pragma unroll
                for (int e = 0; e < 4; ++e) { o[i * 8 + e * 2] = o[i * 8 + e * 2] * sc + pe * bflo(w[e]); o[i * 8 + e * 2 + 1] = o[i * 8 + e * 2 + 1] * sc + pe * bfhi(w[e]); } }
        }
        const float inv = 1.f / l;
        u32x4* op = (u32x4*)(mix + (size_t)tok * ND + h * 64);
#pragma unroll
        for (int i = 0; i < 8; ++i) { u32x4 w;
#pragma unroll
            for (int e = 0; e < 4; ++e) w[e] = pack2(o[i * 8 + e * 2] * inv, o[i * 8 + e * 2 + 1] * inv);
            op[i] = w; }
    }
}

__device__ void hg_naive_phase(const Params& p) {
    const bf16_t* HQ = (const bf16_t*)(p.ws + WS_HQ); const bf16_t* HI = (const bf16_t*)(p.ws + WS_HI);
    const float* lbp = (const float*)(p.ws + WS_LB);
    const int tid = threadIdx.x, vl = tid >> 4, dsl = tid & 15;
    for (int unit = blockIdx.x; unit < NB * 4 * 2 * 4; unit += gridDim.x) {
        const int vs = unit & 3, dir = (unit >> 2) & 1, h = (unit >> 3) & 3, b = unit >> 5;
        const bf16_t* Z = (const bf16_t*)(p.ws + (dir ? WS_ZB : WS_ZF));
        float* O = p.out + (size_t)dir * MT * 512;
        const int v = vs * 32 + vl, d0 = dsl * 8;
        float lb[8], S[8];
#pragma unroll
        for (int e = 0; e < 8; ++e) { lb[e] = lbp[dir * 512 + h * 128 + d0 + e]; S[e] = 0.f; }
        for (int step = 0; step < NL + NS; ++step) {
            const bool isctx = step < NL;
            int t = isctx ? step : step - NL;
            if (dir) t = (isctx ? NL : NS) - 1 - t;
            const size_t row = isctx ? (size_t)MT + b * NL + t : (size_t)b * NS + t;
            const u32x4 zw = *(const u32x4*)(Z + row * 512 + h * 128 + d0);
            const float vv = bf2f(HI[row * 512 + h * 128 + v]);
            float z[8];
#pragma unroll
            for (int e = 0; e < 4; ++e) { z[e * 2] = bflo(zw[e]); z[e * 2 + 1] = bfhi(zw[e]); }
#pragma unroll
            for (int e = 0; e < 8; ++e) { const float f = lb[e] + (1.f - lb[e]) * sigmoid_f(z[e]); S[e] = f * S[e] + (1.f - f) * vv; }
            if (!isctx) {
                const u32x4 qw = *(const u32x4*)(HQ + row * 512 + h * 128 + d0);
                float acc = 0.f;
#pragma unroll
                for (int e = 0; e < 4; ++e) { acc += bflo(qw[e]) * S[e * 2]; acc += bfhi(qw[e]) * S[e * 2 + 1]; }
                acc += __shfl_xor(acc, 1); acc += __shfl_xor(acc, 2); acc += __shfl_xor(acc, 4); acc += __shfl_xor(acc, 8);
                if (dsl == 0) O[row * 512 + h * 128 + v] = acc;
            }
        }
    }
}

__device__ void hgmix_phase(const Params& p) {
    const float* OF = p.out; const float* OB = p.out + (size_t)MT * 512;
    const bf16_t* HG = (const bf16_t*)(p.ws + WS_HG);
    bf16_t* mix = (bf16_t*)(p.ws + WS_XN);
    const int tid = threadIdx.x, lane = tid & 63, wave = tid >> 6;
    for (int row = blockIdx.x * 8 + wave; row < MT; row += gridDim.x * 8) {
        const int c0 = lane * 8;
        float o[8]; float ss = 0.f;
        const f32x4 a0 = *(const f32x4*)(OF + (size_t)row * 512 + c0), a1 = *(const f32x4*)(OF + (size_t)row * 512 + c0 + 4);
        const f32x4 b0 = *(const f32x4*)(OB + (size_t)row * 512 + c0), b1 = *(const f32x4*)(OB + (size_t)row * 512 + c0 + 4);
#pragma unroll
        for (int e = 0; e < 4; ++e) { o[e] = a0[e] + b0[e]; o[4 + e] = a1[e] + b1[e]; }
#pragma unroll
        for (int e = 0; e < 8; ++e) ss += o[e] * o[e];
        ss += __shfl_xor(ss, 1); ss += __shfl_xor(ss, 2); ss += __shfl_xor(ss, 4); ss += __shfl_xor(ss, 8);
        const float rstd = rsqrtf(ss * (1.f / 128.f) + EPS);
        const u32x4 gw = *(const u32x4*)(HG + (size_t)row * 512 + c0);
        float r[8];
#pragma unroll
        for (int e = 0; e < 4; ++e) { r[e * 2] = o[e * 2] * rstd * p.hg_norm[c0 + e * 2] * bflo(gw[e]); r[e * 2 + 1] = o[e * 2 + 1] * rstd * p.hg_norm[c0 + e * 2 + 1] * bfhi(gw[e]); }
        u32x4 w; w[0] = pack2(r[0], r[1]); w[1] = pack2(r[2], r[3]); w[2] = pack2(r[4], r[5]); w[3] = pack2(r[6], r[7]);
        *(u32x4*)(mix + (size_t)row * ND + 512 + c0) = w;
    }
}

__device__ __forceinline__ void wave_argmax(float& v, int& i) {
#pragma unroll
    for (int o = 32; o >= 1; o >>= 1) { const float ov = __shfl_xor(v, o); const int oi = __shfl_xor(i, o); if (ov > v || (ov == v && oi < i)) { v = ov; i = oi; } }
}
__device__ void topk_phase(const Params& p, float* lds) {
    constexpr int LDW = 260;
    const bf16_t* PQ = (const bf16_t*)(p.ws + WS_PQ); const bf16_t* KEYS = (const bf16_t*)(p.ws + WS_KEYS);
    int* PIDX = (int*)(p.ws + WS_PIDX); float* PG = (float*)(p.ws + WS_PG);
    const int tid = threadIdx.x, lane = tid & 63, wave = tid >> 6, fr = lane & 15, fq = lane >> 4;
    for (int unit = blockIdx.x; unit < (MT / 64) * 8; unit += gridDim.x) {
        const int hp = unit & 7, t0 = (unit >> 3) * 64;
        {
            const int c = wave >> 2, kb = (wave & 3) * 32;
            f32x4 acc[4][2];
#pragma unroll
            for (int i = 0; i < 4; ++i) { acc[i][0] = (f32x4){0.f, 0.f, 0.f, 0.f}; acc[i][1] = (f32x4){0.f, 0.f, 0.f, 0.f}; }
#pragma unroll
            for (int ks = 0; ks < 4; ++ks) {
                bf16x8 fa[4], fb[2];
#pragma unroll
                for (int i = 0; i < 4; ++i) fa[i] = *(const bf16x8*)(PQ + (size_t)(t0 + i * 16 + fr) * 2048 + hp * 256 + c * 128 + ks * 32 + fq * 8);
#pragma unroll
                for (int j = 0; j < 2; ++j) fb[j] = *(const bf16x8*)(KEYS + (size_t)((hp * 2 + c) * 128 + kb + j * 16 + fr) * 128 + ks * 32 + fq * 8);
#pragma unroll
                for (int i = 0; i < 4; ++i)
#pragma unroll
                    for (int j = 0; j < 2; ++j) acc[i][j] = __builtin_amdgcn_mfma_f32_16x16x32_bf16(fa[i], fb[j], acc[i][j], 0, 0, 0);
            }
#pragma unroll
            for (int i = 0; i < 4; ++i)
#pragma unroll
                for (int j = 0; j < 2; ++j)
#pragma unroll
                    for (int e = 0; e < 4; ++e) lds[(i * 16 + fq * 4 + e) * LDW + c * 128 + kb + j * 16 + fr] = acc[i][j][e];
        }
        __syncthreads();
        for (int tt = 0; tt < 8; ++tt) {
            const int tl = wave * 8 + tt;
            const float* row = lds + tl * LDW;
            float selv[2]; int seli[2];
#pragma unroll
            for (int c = 0; c < 2; ++c) {
                float a0 = row[c * 128 + lane], a1 = row[c * 128 + 64 + lane];
                float sv = 0.f; int si = 0;
                for (int it = 0; it < 16; ++it) {
                    float bv; int bi;
                    if (a0 >= a1) { bv = a0; bi = lane; } else { bv = a1; bi = lane + 64; }
                    wave_argmax(bv, bi);
                    if (lane == it) { sv = bv; si = bi; }
                    if ((bi & 63) == lane) { if (bi >= 64) a1 = -3.0e38f; else a0 = -3.0e38f; }
                }
                selv[c] = sv; seli[c] = si;
            }
            float cv[4];
            const float s1 = __shfl(selv[0], lane >> 2);
#pragma unroll
            for (int e = 0; e < 4; ++e) cv[e] = s1 + __shfl(selv[1], (lane & 3) * 4 + e);
            float topv = 0.f; int topc = 0;
            for (int it = 0; it < 16; ++it) {
                float bv = cv[0]; int bi = lane * 4;
#pragma unroll
                for (int e = 1; e < 4; ++e) if (cv[e] > bv) { bv = cv[e]; bi = lane * 4 + e; }
                wave_argmax(bv, bi);
                if (lane == it) { topv = bv; topc = bi; }
                if ((bi >> 2) == lane) {
#pragma unroll
                    for (int e = 0; e < 4; ++e) if ((bi & 3) == e) cv[e] = -3.0e38f;
                }
            }
            const float mxv = __shfl(topv, 0);
            float ex = lane < 16 ? __expf(topv - mxv) : 0.f;
            const float sum = wave_sum(ex);
            const int i1 = __shfl(seli[0], topc >> 4), i2 = __shfl(seli[1], topc & 15);
            if (lane < 16) {
                const size_t o = ((size_t)(t0 + tl) * 8 + hp) * 16 + lane;
                PIDX[o] = i1 * 128 + i2; PG[o] = ex / sum;
            }
        }
        __syncthreads();
    }
}

__device__ void gather_phase(const Params& p, float* lds) {
    const bf16_t* H2 = (const bf16_t*)(p.ws + WS_XN); const bf16_t* U = (const bf16_t*)(p.ws + WS_U); const bf16_t* V = (const bf16_t*)(p.ws + WS_V);
    const int* PIDX = (const int*)(p.ws + WS_PIDX); const float* PG = (const float*)(p.ws + WS_PG);
    const float* mod = (const float*)(p.ws + WS_MOD);
    const int tid = threadIdx.x, lane = tid & 63, wave = tid >> 6;
    float* part = lds;
    float* red = lds + 8 * 1024;
    for (int tok = blockIdx.x; tok < MT; tok += gridDim.x) {
        const int b = tok / NS;
        float hv[16];
        {
            const u32x4 w0 = *(const u32x4*)(H2 + (size_t)tok * ND + lane * 8), w1 = *(const u32x4*)(H2 + (size_t)tok * ND + 512 + lane * 8);
#pragma unroll
            for (int e = 0; e < 4; ++e) { hv[e * 2] = bflo(w0[e]); hv[e * 2 + 1] = bfhi(w0[e]); hv[8 + e * 2] = bflo(w1[e]); hv[8 + e * 2 + 1] = bfhi(w1[e]); }
        }
        float acc[16];
#pragma unroll
        for (int e = 0; e < 16; ++e) acc[e] = 0.f;
        for (int k = 0; k < 16; ++k) {
            const size_t o = ((size_t)tok * 8 + wave) * 16 + k;
            const int idx = PIDX[o]; const float g = PG[o];
            const u32x4 u0 = *(const u32x4*)(U + (size_t)idx * ND + lane * 8), u1 = *(const u32x4*)(U + (size_t)idx * ND + 512 + lane * 8);
            float d = 0.f;
#pragma unroll
            for (int e = 0; e < 4; ++e) { d += hv[e * 2] * bflo(u0[e]) + hv[e * 2 + 1] * bfhi(u0[e]); d += hv[8 + e * 2] * bflo(u1[e]) + hv[8 + e * 2 + 1] * bfhi(u1[e]); }
            d = wave_sum(d);
            const float a = 0.5f * d * (1.f + erff(d * 0.70710678118654752f));
            const float w = g * a;
            const u32x4 v0 = *(const u32x4*)(V + (size_t)idx * ND + lane * 8), v1 = *(const u32x4*)(V + (size_t)idx * ND + 512 + lane * 8);
#pragma unroll
            for (int e = 0; e < 4; ++e) { acc[e * 2] += w * bflo(v0[e]); acc[e * 2 + 1] += w * bfhi(v0[e]); acc[8 + e * 2] += w * bflo(v1[e]); acc[8 + e * 2 + 1] += w * bfhi(v1[e]); }
        }
#pragma unroll
        for (int e = 0; e < 8; ++e) { part[wave * 1024 + lane * 8 + e] = acc[e]; part[wave * 1024 + 512 + lane * 8 + e] = acc[8 + e]; }
        __syncthreads();
        float y[2]; float ss = 0.f;
#pragma unroll
        for (int q = 0; q < 2; ++q) {
            const int d = tid + q * NT;
            float s = 0.f;
#pragma unroll
            for (int w = 0; w < 8; ++w) s += part[w * 1024 + d];
            y[q] = p.out[(size_t)tok * ND + d] + mod[b * 6144 + 5120 + d] * s;
            ss += y[q] * y[q];
        }
        ss = wave_sum(ss);
        if (lane == 0) red[wave] = ss;
        __syncthreads();
        float tot = 0.f;
#pragma unroll
        for (int w = 0; w < 8; ++w) tot += red[w];
        const float rstd = rsqrtf(tot * (1.f / ND) + EPS);
#pragma unroll
        for (int q = 0; q < 2; ++q) { const int d = tid + q * NT; p.out[(size_t)tok * ND + d] = y[q] * rstd * p.norm_f[d]; }
        __syncthreads();
    }
}

__global__ void __launch_bounds__(NT) k_mod(Params p) { __shared__ float lds[9 * 1024 + 8 * 9 * 64]; mod_phase(p, lds); }
__global__ void __launch_bounds__(NT) k_wconv(Params p) {
    __shared__ float lds[64 * 65];
    transpose_convert(p.w_in, (bf16_t*)(p.ws + WS_WIN), ND, NIN, lds);
    transpose_convert(p.w_out, (bf16_t*)(p.ws + WS_WOUT), ND, ND, lds);
    transpose_convert(p.wq, (bf16_t*)(p.ws + WS_WQ), ND, 2048, lds);
    convert_flat(p.keys, (bf16_t*)(p.ws + WS_KEYS), (size_t)8 * 2 * 128 * 128);
    convert_flat(p.pu, (bf16_t*)(p.ws + WS_U), (size_t)16384 * 1024);
    convert_flat(p.pv, (bf16_t*)(p.ws + WS_V), (size_t)16384 * 1024);
}
__global__ void __launch_bounds__(NT) k_prep(Params p, int which) { prep_phase(p, which); }
__global__ void __launch_bounds__(NT) k_inproj(Params p) { __shared__ __attribute__((aligned(16))) unsigned char lds[49152]; inproj_phase(p, lds); }
__global__ void __launch_bounds__(NT) k_na(Params p) { na_naive_phase(p); }
__global__ void __launch_bounds__(NT) k_hg(Params p) { hg_naive_phase(p); }
__global__ void __launch_bounds__(NT) k_hgmix(Params p) { hgmix_phase(p); }
__global__ void __launch_bounds__(NT) k_outproj(Params p) { __shared__ __attribute__((aligned(16))) unsigned char lds[49152]; outproj_phase(p, lds); }
__global__ void __launch_bounds__(NT) k_pq(Params p) { __shared__ __attribute__((aligned(16))) unsigned char lds[49152]; pq_phase(p, lds); }
__global__ void __launch_bounds__(NT) k_topk(Params p) { __shared__ float lds[64 * 260]; topk_phase(p, lds); }
__global__ void __launch_bounds__(NT) k_gather(Params p) { __shared__ float lds[8 * 1024 + 8]; gather_phase(p, lds); }
}

extern "C" void kernel_launch(void* const* d_in, const int* in_sizes, int n_in, void* d_out, int out_size, void* d_ws, size_t ws_size, hipStream_t stream) {
    if (n_in != 18 || ws_size < WS_END) { fprintf(stderr, "kernel_launch: unexpected n_in %d / ws_size %zu\n", n_in, ws_size); return; }
    Params p{};
    p.x = (const float*)d_in[0]; p.c = (const float*)d_in[1]; p.ctx = (const float*)d_in[2]; p.c_ctx = (const float*)d_in[3];
    p.w_mod = (const float*)d_in[4]; p.b_mod = (const float*)d_in[5]; p.norm1 = (const float*)d_in[6]; p.norm2 = (const float*)d_in[7];
    p.w_in = (const float*)d_in[8]; p.w_out = (const float*)d_in[9]; p.rpb = (const float*)d_in[10]; p.hg_lb = (const float*)d_in[11];
    p.hg_norm = (const float*)d_in[12]; p.wq = (const float*)d_in[13]; p.keys = (const float*)d_in[14]; p.pu = (const float*)d_in[15];
    p.pv = (const float*)d_in[16]; p.norm_f = (const float*)d_in[17];
    p.out = (float*)d_out; p.ws = (unsigned char*)d_ws;
    const dim3 blk(NT);
    k_mod<<<96, blk, 0, stream>>>(p);
    k_wconv<<<1024, blk, 0, stream>>>(p);
    k_prep<<<1024, blk, 0, stream>>>(p, 0);
    k_inproj<<<512, blk, 0, stream>>>(p);
    k_na<<<256, blk, 0, stream>>>(p);
    k_hg<<<256, blk, 0, stream>>>(p);
    k_hgmix<<<1024, blk, 0, stream>>>(p);
    k_outproj<<<512, blk, 0, stream>>>(p);
    k_prep<<<1024, blk, 0, stream>>>(p, 1);
    k_pq<<<512, blk, 0, stream>>>(p);
    k_topk<<<1024, blk, 0, stream>>>(p);
    k_gather<<<2048, blk, 0, stream>>>(p);
}
```

```cpp
#include <hip/hip_runtime.h>
#include <hip/hip_cooperative_groups.h>
#include <cstdint>
#include <cstdio>

typedef unsigned short bf16_t;
typedef short bf16x8 __attribute__((ext_vector_type(8)));
typedef float f32x4 __attribute__((ext_vector_type(4)));
typedef unsigned u32x4 __attribute__((ext_vector_type(4)));
typedef unsigned u32x2 __attribute__((ext_vector_type(2)));

namespace cg = cooperative_groups;
namespace {
constexpr int NB = 8, NS = 2048, ND = 1024, NL = 256, GW = 64, NROWS = 32;
constexpr int MT = NB * NS;
constexpr int MC = NB * NL;
constexpr int MA = MT + MC;
constexpr int NIN = 4096;
constexpr int NT = 512;
constexpr float EPS = 1e-6f;

constexpr size_t MiB = 1ull << 20;
constexpr size_t WS_CTL = 0;
constexpr size_t WS_MOD = 64 * 1024;
constexpr size_t WS_LB = 320 * 1024;
constexpr size_t WS_KEYS = 512 * 1024;
constexpr size_t WS_WIN = 1 * MiB;
constexpr size_t WS_WOUT = 9 * MiB;
constexpr size_t WS_WQ = 11 * MiB;
constexpr size_t WS_U = 15 * MiB;
constexpr size_t WS_V = 47 * MiB;
constexpr size_t WS_XN = 79 * MiB;
constexpr size_t WS_NAQ = 115 * MiB;
constexpr size_t WS_NAK = 131 * MiB;
constexpr size_t WS_NAV = 149 * MiB;
constexpr size_t WS_HQ = 167 * MiB;
constexpr size_t WS_ZF = 183 * MiB;
constexpr size_t WS_ZB = 201 * MiB;
constexpr size_t WS_HI = 219 * MiB;
constexpr size_t WS_HG = 237 * MiB;
constexpr size_t WS_END = 253 * MiB;
constexpr size_t WS_PQ = 115 * MiB;
constexpr size_t WS_PIDX = 179 * MiB;
constexpr size_t WS_PG = 187 * MiB;

struct Params {
    const float* x; const float* c; const float* ctx; const float* c_ctx; const float* w_mod; const float* b_mod;
    const float* norm1; const float* norm2; const float* w_in; const float* w_out; const float* rpb; const float* hg_lb;
    const float* hg_norm; const float* wq; const float* keys; const float* pu; const float* pv; const float* norm_f;
    float* out; unsigned char* ws;
};

__device__ __forceinline__ bf16_t f2bf(float f) { unsigned u = __float_as_uint(f); u += 0x7fffu + ((u >> 16) & 1u); return (bf16_t)(u >> 16); }
__device__ __forceinline__ float bf2f(bf16_t h) { return __uint_as_float(((unsigned)h) << 16); }
__device__ __forceinline__ unsigned pack2(float lo, float hi) { return (unsigned)f2bf(lo) | ((unsigned)f2bf(hi) << 16); }
__device__ __forceinline__ float bflo(unsigned w) { return __uint_as_float(w << 16); }
__device__ __forceinline__ float bfhi(unsigned w) { return __uint_as_float(w & 0xffff0000u); }
__device__ __forceinline__ float silu_f(float v) { return v / (1.f + __expf(-v)); }
__device__ __forceinline__ float sigmoid_f(float v) { return 1.f / (1.f + __expf(-v)); }
__device__ __forceinline__ float wave_sum(float v) {
#pragma unroll
    for (int o = 32; o >= 1; o >>= 1) v += __shfl_xor(v, o);
    return v;
}

__device__ void mod_phase(const Params& p, float* lds) {
    float* sc = lds;
    float* red = lds + 9 * 1024;
    const int tid = threadIdx.x;
    float* mod = (float*)(p.ws + WS_MOD);
    for (int i = tid; i < 9 * 1024; i += NT) {
        const int r = i >> 10, k = i & 1023;
        const float v = (r < 8) ? p.c[r * 1024 + k] : p.c_ctx[k];
        sc[i] = silu_f(v);
    }
    __syncthreads();
    const int col = tid & 63, ks = tid >> 6;
    for (int unit = blockIdx.x; unit < 6144 / 64; unit += gridDim.x) {
        const int j = unit * 64 + col;
        float acc[9];
#pragma unroll
        for (int r = 0; r < 9; ++r) acc[r] = 0.f;
        for (int k = ks * 128; k < ks * 128 + 128; ++k) {
            const float w = p.w_mod[(size_t)k * 6144 + j];
#pragma unroll
            for (int r = 0; r < 9; ++r) acc[r] += sc[r * 1024 + k] * w;
        }
#pragma unroll
        for (int r = 0; r < 9; ++r) red[(ks * 9 + r) * 64 + col] = acc[r];
        __syncthreads();
        for (int i = tid; i < 9 * 64; i += NT) {
            const int r = i >> 6, cc = i & 63;
            float s = 0.f;
#pragma unroll
            for (int q = 0; q < 8; ++q) s += red[(q * 9 + r) * 64 + cc];
            mod[r * 6144 + unit * 64 + cc] = s + p.b_mod[unit * 64 + cc];
        }
        __syncthreads();
    }
    float* lb = (float*)(p.ws + WS_LB);
    for (int i = blockIdx.x * NT + tid; i < 1024; i += gridDim.x * NT) {
        const float a0 = p.hg_lb[i], a1 = p.hg_lb[1024 + i];
        lb[i] = 1.f / (1.f + __expf(a1 - a0));
    }
}

__device__ void transpose_convert(const float* W, bf16_t* Wt, int K, int N, float* lds) {
    const int tid = threadIdx.x;
    const int tk = K / 64, tn = N / 64;
    for (int unit = blockIdx.x; unit < tk * tn; unit += gridDim.x) {
        const int k0 = (unit / tn) * 64, n0 = (unit % tn) * 64;
        for (int i = tid; i < 64 * 64; i += NT) { const int r = i >> 6, cc = i & 63; lds[r * 65 + cc] = W[(size_t)(k0 + r) * N + n0 + cc]; }
        __syncthreads();
        for (int i = tid; i < 64 * 64; i += NT) { const int n = i >> 6, k = i & 63; Wt[(size_t)(n0 + n) * K + k0 + k] = f2bf(lds[k * 65 + n]); }
        __syncthreads();
    }
}
__device__ void convert_flat(const float* src, bf16_t* dst, size_t n) {
    const size_t stride = (size_t)gridDim.x * NT * 4;
    for (size_t i = ((size_t)blockIdx.x * NT + threadIdx.x) * 4; i < n; i += stride) {
        const f32x4 v = *(const f32x4*)(src + i);
        u32x2 o; o.x = pack2(v[0], v[1]); o.y = pack2(v[2], v[3]);
        *(u32x2*)(dst + i) = o;
    }
}

__device__ void prep_phase(const Params& p, int which) {
    const int tid = threadIdx.x, lane = tid & 63, wave = tid >> 6;
    const float* mod = (const float*)(p.ws + WS_MOD);
    bf16_t* dst = (bf16_t*)(p.ws + WS_XN);
    const int nrows = which == 0 ? MA : MT;
    const float* g = which == 0 ? p.norm1 : p.norm2;
    for (int row = blockIdx.x * 8 + wave; row < nrows; row += gridDim.x * 8) {
        const float* src; int mr;
        if (which == 0) { if (row < MT) { src = p.x + (size_t)row * ND; mr = row / NS; } else { src = p.ctx + (size_t)(row - MT) * ND; mr = 8; } }
        else { src = p.out + (size_t)row * ND; mr = row / NS; }
        const float* sh = mod + mr * 6144 + (which == 0 ? 0 : 3072);
        const float* scl = mod + mr * 6144 + (which == 0 ? 1024 : 4096);
        f32x4 v[4]; float ss = 0.f;
#pragma unroll
        for (int i = 0; i < 4; ++i) { v[i] = *(const f32x4*)(src + i * 256 + lane * 4); ss += v[i][0] * v[i][0] + v[i][1] * v[i][1] + v[i][2] * v[i][2] + v[i][3] * v[i][3]; }
        ss = wave_sum(ss);
        const float rstd = rsqrtf(ss * (1.f / ND) + EPS);
#pragma unroll
        for (int i = 0; i < 4; ++i) {
            const int d = i * 256 + lane * 4;
            const f32x4 gg = *(const f32x4*)(g + d), s1 = *(const f32x4*)(sh + d), s2 = *(const f32x4*)(scl + d);
            float h[4];
#pragma unroll
            for (int e = 0; e < 4; ++e) h[e] = (v[i][e] * rstd * gg[e]) * (1.f + s2[e]) + s1[e];
            u32x2 o; o.x = pack2(h[0], h[1]); o.y = pack2(h[2], h[3]);
            *(u32x2*)(dst + (size_t)row * ND + d) = o;
        }
    }
}

template <class Epi>
__device__ __forceinline__ void gemm_tile(const bf16_t* __restrict__ A, int lda, const bf16_t* __restrict__ Bt, int ldb, int K, int m0, int n0, unsigned char* lds, const Epi& epi) {
    unsigned char* As = lds; unsigned char* Bs = lds + 32768;
    const int tid = threadIdx.x, lane = tid & 63, wave = tid >> 6;
    const int wm = wave >> 1, wn = wave & 1;
    const int lr = tid >> 3, lc = tid & 7;
    const int fr = lane & 15, fq = lane >> 4;
    f32x4 acc[4][4];
#pragma unroll
    for (int i = 0; i < 4; ++i)
#pragma unroll
        for (int j = 0; j < 4; ++j) acc[i][j] = (f32x4){0.f, 0.f, 0.f, 0.f};
    u32x4 ra[4], rb[2];
    const bf16_t* Ap = A + (size_t)(m0 + lr) * lda + lc * 8;
    const bf16_t* Bp = Bt + (size_t)(n0 + lr) * ldb + lc * 8;
#pragma unroll
    for (int i = 0; i < 4; ++i) ra[i] = *(const u32x4*)(Ap + (size_t)(i * 64) * lda);
#pragma unroll
    for (int i = 0; i < 2; ++i) rb[i] = *(const u32x4*)(Bp + (size_t)(i * 64) * ldb);
    const int nkt = K / 64;
    for (int kt = 0; kt < nkt; ++kt) {
#pragma unroll
        for (int i = 0; i < 4; ++i) { const int r = lr + i * 64; *(u32x4*)(As + r * 128 + ((lc ^ (r & 7)) << 4)) = ra[i]; }
#pragma unroll
        for (int i = 0; i < 2; ++i) { const int r = lr + i * 64; *(u32x4*)(Bs + r * 128 + ((lc ^ (r & 7)) << 4)) = rb[i]; }
        __syncthreads();
        if (kt + 1 < nkt) {
            const int k0 = (kt + 1) * 64;
#pragma unroll
            for (int i = 0; i < 4; ++i) ra[i] = *(const u32x4*)(Ap + (size_t)(i * 64) * lda + k0);
#pragma unroll
            for (int i = 0; i < 2; ++i) rb[i] = *(const u32x4*)(Bp + (size_t)(i * 64) * ldb + k0);
        }
#pragma unroll
        for (int kk = 0; kk < 2; ++kk) {
            const int ch = kk * 4 + fq;
            bf16x8 fa[4], fb[4];
#pragma unroll
            for (int i = 0; i < 4; ++i) { const int r = wm * 64 + i * 16 + fr; fa[i] = *(const bf16x8*)(As + r * 128 + ((ch ^ (r & 7)) << 4)); }
#pragma unroll
            for (int j = 0; j < 4; ++j) { const int r = wn * 64 + j * 16 + fr; fb[j] = *(const bf16x8*)(Bs + r * 128 + ((ch ^ (r & 7)) << 4)); }
#pragma unroll
            for (int i = 0; i < 4; ++i)
#pragma unroll
                for (int j = 0; j < 4; ++j) acc[i][j] = __builtin_amdgcn_mfma_f32_16x16x32_bf16(fb[j], fa[i], acc[i][j], 0, 0, 0);
        }
        __syncthreads();
    }
#pragma unroll
    for (int i = 0; i < 4; ++i)
#pragma unroll
        for (int j = 0; j < 4; ++j) epi(m0 + wm * 64 + i * 16 + fr, n0 + wn * 64 + j * 16 + fq * 4, acc[i][j]);
}

__device__ __forceinline__ void store_bf16x4(bf16_t* dst, const f32x4& v) { u32x2 o; o.x = pack2(v[0], v[1]); o.y = pack2(v[2], v[3]); *(u32x2*)dst = o; }

struct EpiInProj {
    unsigned char* ws;
    __device__ __forceinline__ void operator()(int m, int n, const f32x4& v) const {
        const int seg = n >> 9, c = n & 511;
        const size_t o = (size_t)m * 512 + c;
        switch (seg) {
            case 0: { f32x4 s = v * 0.125f; store_bf16x4((bf16_t*)(ws + WS_NAQ) + o, s); break; }
            case 1: store_bf16x4((bf16_t*)(ws + WS_NAK) + o, v); break;
            case 2: store_bf16x4((bf16_t*)(ws + WS_NAV) + o, v); break;
            case 3: { f32x4 s; s[0] = silu_f(v[0]); s[1] = silu_f(v[1]); s[2] = silu_f(v[2]); s[3] = silu_f(v[3]); store_bf16x4((bf16_t*)(ws + WS_HQ) + o, s); break; }
            case 4: store_bf16x4((bf16_t*)(ws + WS_ZF) + o, v); break;
            case 5: store_bf16x4((bf16_t*)(ws + WS_ZB) + o, v); break;
            case 6: store_bf16x4((bf16_t*)(ws + WS_HI) + o, v); break;
            default: { f32x4 s; s[0] = silu_f(v[0]); s[1] = silu_f(v[1]); s[2] = silu_f(v[2]); s[3] = silu_f(v[3]); store_bf16x4((bf16_t*)(ws + WS_HG) + o, s); break; }
        }
    }
};
__device__ void inproj_phase(const Params& p, unsigned char* lds) {
    const bf16_t* A = (const bf16_t*)(p.ws + WS_XN); const bf16_t* Bt = (const bf16_t*)(p.ws + WS_WIN);
    EpiInProj epi{p.ws};
    const int nlat = 64 * 32, nctx = 8 * 20;
    for (int unit = blockIdx.x; unit < nlat + nctx; unit += gridDim.x) {
        int mt, nt;
        if (unit < nlat) { mt = unit >> 5; nt = unit & 31; }
        else { const int u = unit - nlat; mt = 64 + u / 20; const int q = u % 20; nt = q < 8 ? 4 + q : 16 + (q - 8); }
        gemm_tile(A, ND, Bt, ND, ND, mt * 256, nt * 128, lds, epi);
    }
}

struct EpiOutProj {
    const float* x; const float* mod; float* out;
    __device__ __forceinline__ void operator()(int m, int n, const f32x4& v) const {
        const int b = m / NS;
        const f32x4 xv = *(const f32x4*)(x + (size_t)m * ND + n), g = *(const f32x4*)(mod + b * 6144 + 2048 + n);
        *(f32x4*)(out + (size_t)m * ND + n) = xv + g * v;
    }
};
__device__ void outproj_phase(const Params& p, unsigned char* lds) {
    const bf16_t* A = (const bf16_t*)(p.ws + WS_XN); const bf16_t* Bt = (const bf16_t*)(p.ws + WS_WOUT);
    EpiOutProj epi{p.x, (const float*)(p.ws + WS_MOD), p.out};
    for (int unit = blockIdx.x; unit < 64 * 8; unit += gridDim.x) gemm_tile(A, ND, Bt, ND, ND, (unit >> 3) * 256, (unit & 7) * 128, lds, epi);
}
struct EpiPq { bf16_t* pq; __device__ __forceinline__ void operator()(int m, int n, const f32x4& v) const { store_bf16x4(pq + (size_t)m * 2048 + n, v); } };
__device__ void pq_phase(const Params& p, unsigned char* lds) {
    const bf16_t* A = (const bf16_t*)(p.ws + WS_XN); const bf16_t* Bt = (const bf16_t*)(p.ws + WS_WQ);
    EpiPq epi{(bf16_t*)(p.ws + WS_PQ)};
    for (int unit = blockIdx.x; unit < 64 * 16; unit += gridDim.x) gemm_tile(A, ND, Bt, ND, ND, (unit >> 4) * 256, (unit & 15) * 128, lds, epi);
}

__device__ void na_naive_phase(const Params& p) {
    const bf16_t* Q = (const bf16_t*)(p.ws + WS_NAQ); const bf16_t* Kk = (const bf16_t*)(p.ws + WS_NAK); const bf16_t* V = (const bf16_t*)(p.ws + WS_NAV);
    bf16_t* mix = (bf16_t*)(p.ws + WS_XN);
    const int tid = threadIdx.x;
    for (int unit = blockIdx.x; unit < MT / 64; unit += gridDim.x) {
        const int tok = unit * 64 + (tid >> 3), h = tid & 7;
        const int b = tok / NS, s = tok % NS, r = s >> 6, qc = s & 63;
        const int rs = min(max(r - 4, 0), NROWS - 8), cs = min(max(qc - 8, 0), GW - 16);
        float q[64], o[64];
        {
            const u32x4* qp = (const u32x4*)(Q + (size_t)tok * 512 + h * 64);
#pragma unroll
            for (int i = 0; i < 8; ++i) { const u32x4 w = qp[i];
#pragma unroll
                for (int e = 0; e < 4; ++e) { q[i * 8 + e * 2] = bflo(w[e]); q[i * 8 + e * 2 + 1] = bfhi(w[e]); } }
        }
#pragma unroll
        for (int i = 0; i < 64; ++i) o[i] = 0.f;
        float mx = -1e30f, l = 0.f;
        for (int it = 0; it < 128 + 256; ++it) {
            int kt; float bias = 0.f;
            if (it < 128) { const int kr = it >> 4, kc = it & 15; kt = b * NS + (rs + kr) * 64 + cs + kc; bias = p.rpb[h * 15 * 31 + (rs + kr - r + 7) * 31 + (cs + kc - qc + 15)]; }
            else kt = MT + b * NL + (it - 128);
            const u32x4* kp = (const u32x4*)(Kk + (size_t)kt * 512 + h * 64);
            float d = 0.f;
#pragma unroll
            for (int i = 0; i < 8; ++i) { const u32x4 w = kp[i];
#pragma unroll
                for (int e = 0; e < 4; ++e) { d += q[i * 8 + e * 2] * bflo(w[e]); d += q[i * 8 + e * 2 + 1] * bfhi(w[e]); } }
            d += bias;
            const float mn = fmaxf(mx, d), sc = __expf(mx - mn), pe = __expf(d - mn);
            l = l * sc + pe; mx = mn;
            const u32x4* vp = (const u32x4*)(V + (size_t)kt * 512 + h * 64);
#pragma unroll
            for (int i = 0; i < 8; ++i) { const u32x4 w = vp[i];
#pragma unroll
                for (int e = 0; e < 4; ++e) { o[i * 8 + e * 2] = o[i * 8 + e * 2] * sc + pe * bflo(w[e]); o[i * 8 + e * 2 + 1] = o[i * 8 + e * 2 + 1] * sc + pe * bfhi(w[e]); } }
        }
        const float inv = 1.f / l;
        u32x4* op = (u32x4*)(mix + (size_t)tok * ND + h * 64);
#pragma unroll
        for (int i = 0; i < 8; ++i) { u32x4 w;
#pragma unroll
            for (int e = 0; e < 4; ++e) w[e] = pack2(o[i * 8 + e * 2] * inv, o[i * 8 + e * 2 + 1] * inv);
            op[i] = w; }
    }
}

__device__ void hg_naive_phase(const Params& p) {
    const bf16_t* HQ = (const bf16_t*)(p.ws + WS_HQ); const bf16_t* HI = (const bf16_t*)(p.ws + WS_HI);
    const float* lbp = (const float*)(p.ws + WS_LB);
    const int tid = threadIdx.x, vl = tid >> 4, dsl = tid & 15;
    for (int unit = blockIdx.x; unit < NB * 4 * 2 * 4; unit += gridDim.x) {
        const int vs = unit & 3, dir = (unit >> 2) & 1, h = (unit >> 3) & 3, b = unit >> 5;
        const bf16_t* Z = (const bf16_t*)(p.ws + (dir ? WS_ZB : WS_ZF));
        float* O = p.out + (size_t)dir * MT * 512;
        const int v = vs * 32 + vl, d0 = dsl * 8;
        float lb[8], S[8];
#pragma unroll
        for (int e = 0; e < 8; ++e) { lb[e] = lbp[dir * 512 + h * 128 + d0 + e]; S[e] = 0.f; }
        for (int step = 0; step < NL + NS; ++step) {
            const bool isctx = step < NL;
            int t = isctx ? step : step - NL;
            if (dir) t = (isctx ? NL : NS) - 1 - t;
            const size_t row = isctx ? (size_t)MT + b * NL + t : (size_t)b * NS + t;
            const u32x4 zw = *(const u32x4*)(Z + row * 512 + h * 128 + d0);
            const float vv = bf2f(HI[row * 512 + h * 128 + v]);
            float z[8];
#pragma unroll
            for (int e = 0; e < 4; ++e) { z[e * 2] = bflo(zw[e]); z[e * 2 + 1] = bfhi(zw[e]); }
#pragma unroll
            for (int e = 0; e < 8; ++e) { const float f = lb[e] + (1.f - lb[e]) * sigmoid_f(z[e]); S[e] = f * S[e] + (1.f - f) * vv; }
            if (!isctx) {
                const u32x4 qw = *(const u32x4*)(HQ + row * 512 + h * 128 + d0);
                float acc = 0.f;
#pragma unroll
                for (int e = 0; e < 4; ++e) { acc += bflo(qw[e]) * S[e * 2]; acc += bfhi(qw[e]) * S[e * 2 + 1]; }
                acc += __shfl_xor(acc, 1); acc += __shfl_xor(acc, 2); acc += __shfl_xor(acc, 4); acc += __shfl_xor(acc, 8);
                if (dsl == 0) O[row * 512 + h * 128 + v] = acc;
            }
        }
    }
}

__device__ void hgmix_phase(const Params& p) {
    const float* OF = p.out; const float* OB = p.out + (size_t)MT * 512;
    const bf16_t* HG = (const bf16_t*)(p.ws + WS_HG);
    bf16_t* mix = (bf16_t*)(p.ws + WS_XN);
    const int tid = threadIdx.x, lane = tid & 63, wave = tid >> 6;
    for (int row = blockIdx.x * 8 + wave; row < MT; row += gridDim.x * 8) {
        const int c0 = lane * 8;
        float o[8]; float ss = 0.f;
        const f32x4 a0 = *(const f32x4*)(OF + (size_t)row * 512 + c0), a1 = *(const f32x4*)(OF + (size_t)row * 512 + c0 + 4);
        const f32x4 b0 = *(const f32x4*)(OB + (size_t)row * 512 + c0), b1 = *(const f32x4*)(OB + (size_t)row * 512 + c0 + 4);
#pragma unroll
        for (int e = 0; e < 4; ++e) { o[e] = a0[e] + b0[e]; o[4 + e] = a1[e] + b1[e]; }
#pragma unroll
        for (int e = 0; e < 8; ++e) ss += o[e] * o[e];
        ss += __shfl_xor(ss, 1); ss += __shfl_xor(ss, 2); ss += __shfl_xor(ss, 4); ss += __shfl_xor(ss, 8);
        const float rstd = rsqrtf(ss * (1.f / 128.f) + EPS);
        const u32x4 gw = *(const u32x4*)(HG + (size_t)row * 512 + c0);
        float r[8];
#pragma unroll
        for (int e = 0; e < 4; ++e) { r[e * 2] = o[e * 2] * rstd * p.hg_norm[c0 + e * 2] * bflo(gw[e]); r[e * 2 + 1] = o[e * 2 + 1] * rstd * p.hg_norm[c0 + e * 2 + 1] * bfhi(gw[e]); }
        u32x4 w; w[0] = pack2(r[0], r[1]); w[1] = pack2(r[2], r[3]); w[2] = pack2(r[4], r[5]); w[3] = pack2(r[6], r[7]);
        *(u32x4*)(mix + (size_t)row * ND + 512 + c0) = w;
    }
}

__device__ __forceinline__ void wave_argmax(float& v, int& i) {
#pragma unroll
    for (int o = 32; o >= 1; o >>= 1) { const float ov = __shfl_xor(v, o); const int oi = __shfl_xor(i, o); if (ov > v || (ov == v && oi < i)) { v = ov; i = oi; } }
}
__device__ void topk_phase(const Params& p, float* lds) {
    constexpr int LDW = 260;
    const bf16_t* PQ = (const bf16_t*)(p.ws + WS_PQ); const bf16_t* KEYS = (const bf16_t*)(p.ws + WS_KEYS);
    int* PIDX = (int*)(p.ws + WS_PIDX); float* PG = (float*)(p.ws + WS_PG);
    const int tid = threadIdx.x, lane = tid & 63, wave = tid >> 6, fr = lane & 15, fq = lane >> 4;
    for (int unit = blockIdx.x; unit < (MT / 64) * 8; unit += gridDim.x) {
        const int hp = unit & 7, t0 = (unit >> 3) * 64;
        {
            const int c = wave >> 2, kb = (wave & 3) * 32;
            f32x4 acc[4][2];
#pragma unroll
            for (int i = 0; i < 4; ++i) { acc[i][0] = (f32x4){0.f, 0.f, 0.f, 0.f}; acc[i][1] = (f32x4){0.f, 0.f, 0.f, 0.f}; }
#pragma unroll
            for (int ks = 0; ks < 4; ++ks) {
                bf16x8 fa[4], fb[2];
#pragma unroll
                for (int i = 0; i < 4; ++i) fa[i] = *(const bf16x8*)(PQ + (size_t)(t0 + i * 16 + fr) * 2048 + hp * 256 + c * 128 + ks * 32 + fq * 8);
#pragma unroll
                for (int j = 0; j < 2; ++j) fb[j] = *(const bf16x8*)(KEYS + (size_t)((hp * 2 + c) * 128 + kb + j * 16 + fr) * 128 + ks * 32 + fq * 8);
#pragma unroll
                for (int i = 0; i < 4; ++i)
#pragma unroll
                    for (int j = 0; j < 2; ++j) acc[i][j] = __builtin_amdgcn_mfma_f32_16x16x32_bf16(fa[i], fb[j], acc[i][j], 0, 0, 0);
            }
#pragma unroll
            for (int i = 0; i < 4; ++i)
#pragma unroll
                for (int j = 0; j < 2; ++j)
#pragma unroll
                    for (int e = 0; e < 4; ++e) lds[(i * 16 + fq * 4 + e) * LDW + c * 128 + kb + j * 16 + fr] = acc[i][j][e];
        }
        __syncthreads();
        for (int tt = 0; tt < 8; ++tt) {
            const int tl = wave * 8 + tt;
            const float* row = lds + tl * LDW;
            float selv[2]; int seli[2];
#pragma unroll
            for (int c = 0; c < 2; ++c) {
                float a0 = row[c * 128 + lane], a1 = row[c * 128 + 64 + lane];
                float sv = 0.f; int si = 0;
                for (int it = 0; it < 16; ++it) {
                    float bv; int bi;
                    if (a0 >= a1) { bv = a0; bi = lane; } else { bv = a1; bi = lane + 64; }
                    wave_argmax(bv, bi);
                    if (lane == it) { sv = bv; si = bi; }
                    if ((bi & 63) == lane) { if (bi >= 64) a1 = -3.0e38f; else a0 = -3.0e38f; }
                }
                selv[c] = sv; seli[c] = si;
            }
            float cv[4];
            const float s1 = __shfl(selv[0], lane >> 2);
#pragma unroll
            for (int e = 0; e < 4; ++e) cv[e] = s1 + __shfl(selv[1], (lane & 3) * 4 + e);
            float topv = 0.f; int topc = 0;
            for (int it = 0; it < 16; ++it) {
                float bv = cv[0]; int bi = lane * 4;
#pragma unroll
                for (int e = 1; e < 4; ++e) if (cv[e] > bv) { bv = cv[e]; bi = lane * 4 + e; }
                wave_argmax(bv, bi);
                if (lane == it) { topv = bv; topc = bi; }
                if ((bi >> 2) == lane) {
#pragma unroll
                    for (int e = 0; e < 4; ++e) if ((bi & 3) == e) cv[e] = -3.0e38f;
                }
            }
            const float mxv = __shfl(topv, 0);
            float ex = lane < 16 ? __expf(topv - mxv) : 0.f;
            const float sum = wave_sum(ex);
            const int i1 = __shfl(seli[0], topc >> 4), i2 = __shfl(seli[1], topc & 15);
            if (lane < 16) {
                const size_t o = ((size_t)(t0 + tl) * 8 + hp) * 16 + lane;
                PIDX[o] = i1 * 128 + i2; PG[o] = ex / sum;
            }
        }
        __syncthreads();
    }
}

__device__ void gather_phase(const Params& p, float* lds) {
    const bf16_t* H2 = (const bf16_t*)(p.ws + WS_XN); const bf16_t* U = (const bf16_t*)(p.ws + WS_U); const bf16_t* V = (const bf16_t*)(p.ws + WS_V);
    const int* PIDX = (const int*)(p.ws + WS_PIDX); const float* PG = (const float*)(p.ws + WS_PG);
    const float* mod = (const float*)(p.ws + WS_MOD);
    const int tid = threadIdx.x, lane = tid & 63, wave = tid >> 6;
    float* part = lds;
    float* red = lds + 8 * 1024;
    for (int tok = blockIdx.x; tok < MT; tok += gridDim.x) {
        const int b = tok / NS;
        float hv[16];
        {
            const u32x4 w0 = *(const u32x4*)(H2 + (size_t)tok * ND + lane * 8), w1 = *(const u32x4*)(H2 + (size_t)tok * ND + 512 + lane * 8);
#pragma unroll
            for (int e = 0; e < 4; ++e) { hv[e * 2] = bflo(w0[e]); hv[e * 2 + 1] = bfhi(w0[e]); hv[8 + e * 2] = bflo(w1[e]); hv[8 + e * 2 + 1] = bfhi(w1[e]); }
        }
        float acc[16];
#pragma unroll
        for (int e = 0; e < 16; ++e) acc[e] = 0.f;
        for (int k = 0; k < 16; ++k) {
            const size_t o = ((size_t)tok * 8 + wave) * 16 + k;
            const int idx = PIDX[o]; const float g = PG[o];
            const u32x4 u0 = *(const u32x4*)(U + (size_t)idx * ND + lane * 8), u1 = *(const u32x4*)(U + (size_t)idx * ND + 512 + lane * 8);
            float d = 0.f;
#pragma unroll
            for (int e = 0; e < 4; ++e) { d += hv[e * 2] * bflo(u0[e]) + hv[e * 2 + 1] * bfhi(u0[e]); d += hv[8 + e * 2] * bflo(u1[e]) + hv[8 + e * 2 + 1] * bfhi(u1[e]); }
            d = wave_sum(d);
            const float a = 0.5f * d * (1.f + erff(d * 0.70710678118654752f));
            const float w = g * a;
            const u32x4 v0 = *(const u32x4*)(V + (size_t)idx * ND + lane * 8), v1 = *(const u32x4*)(V + (size_t)idx * ND + 512 + lane * 8);
#pragma unroll
            for (int e = 0; e < 4; ++e) { acc[e * 2] += w * bflo(v0[e]); acc[e * 2 + 1] += w * bfhi(v0[e]); acc[8 + e * 2] += w * bflo(v1[e]); acc[8 + e * 2 + 1] += w * bfhi(v1[e]); }
        }
#pragma unroll
        for (int e = 0; e < 8; ++e) { part[wave * 1024 + lane * 8 + e] = acc[e]; part[wave * 1024 + 512 + lane * 8 + e] = acc[8 + e]; }
        __syncthreads();
        float y[2]; float ss = 0.f;
#pragma unroll
        for (int q = 0; q < 2; ++q) {
            const int d = tid + q * NT;
            float s = 0.f;
#pragma unroll
            for (int w = 0; w < 8; ++w) s += part[w * 1024 + d];
            y[q] = p.out[(size_t)tok * ND + d] + mod[b * 6144 + 5120 + d] * s;
            ss += y[q] * y[q];
        }
        ss = wave_sum(ss);
        if (lane == 0) red[wave] = ss;
        __syncthreads();
        float tot = 0.f;
#pragma unroll
        for (int w = 0; w < 8; ++w) tot += red[w];
        const float rstd = rsqrtf(tot * (1.f / ND) + EPS);
#pragma unroll
        for (int q = 0; q < 2; ++q) { const int d = tid + q * NT; p.out[(size_t)tok * ND + d] = y[q] * rstd * p.norm_f[d]; }
        __syncthreads();
    }
}

constexpr int LDS_BYTES = 66560;
__global__ void __launch_bounds__(NT) k_mega(Params p) {
    __shared__ __attribute__((aligned(16))) unsigned char lds[LDS_BYTES];
    cg::grid_group grid = cg::this_grid();
    mod_phase(p, (float*)lds);
    transpose_convert(p.w_in, (bf16_t*)(p.ws + WS_WIN), ND, NIN, (float*)lds);
    transpose_convert(p.w_out, (bf16_t*)(p.ws + WS_WOUT), ND, ND, (float*)lds);
    transpose_convert(p.wq, (bf16_t*)(p.ws + WS_WQ), ND, 2048, (float*)lds);
    convert_flat(p.keys, (bf16_t*)(p.ws + WS_KEYS), (size_t)8 * 2 * 128 * 128);
    convert_flat(p.pu, (bf16_t*)(p.ws + WS_U), (size_t)16384 * 1024);
    convert_flat(p.pv, (bf16_t*)(p.ws + WS_V), (size_t)16384 * 1024);
    grid.sync();
    prep_phase(p, 0);
    grid.sync();
    inproj_phase(p, lds);
    grid.sync();
    na_naive_phase(p);
    hg_naive_phase(p);
    grid.sync();
    hgmix_phase(p);
    grid.sync();
    outproj_phase(p, lds);
    grid.sync();
    prep_phase(p, 1);
    grid.sync();
    pq_phase(p, lds);
    grid.sync();
    topk_phase(p, (float*)lds);
    grid.sync();
    gather_phase(p, (float*)lds);
}
}

extern "C" void kernel_launch(void* const* d_in, const int* in_sizes, int n_in, void* d_out, int out_size, void* d_ws, size_t ws_size, hipStream_t stream) {
    if (n_in != 18 || ws_size < WS_END) { fprintf(stderr, "kernel_launch: unexpected n_in %d / ws_size %zu\n", n_in, ws_size); return; }
    Params p{};
    p.x = (const float*)d_in[0]; p.c = (const float*)d_in[1]; p.ctx = (const float*)d_in[2]; p.c_ctx = (const float*)d_in[3];
    p.w_mod = (const float*)d_in[4]; p.b_mod = (const float*)d_in[5]; p.norm1 = (const float*)d_in[6]; p.norm2 = (const float*)d_in[7];
    p.w_in = (const float*)d_in[8]; p.w_out = (const float*)d_in[9]; p.rpb = (const float*)d_in[10]; p.hg_lb = (const float*)d_in[11];
    p.hg_norm = (const float*)d_in[12]; p.wq = (const float*)d_in[13]; p.keys = (const float*)d_in[14]; p.pu = (const float*)d_in[15];
    p.pv = (const float*)d_in[16]; p.norm_f = (const float*)d_in[17];
    p.out = (float*)d_out; p.ws = (unsigned char*)d_ws;
    static int grid_blocks = 0;
    if (!grid_blocks) {
        int dev = 0, cus = 0, per_cu = 0;
        hipGetDevice(&dev);
        hipDeviceGetAttribute(&cus, hipDeviceAttributeMultiprocessorCount, dev);
        hipOccupancyMaxActiveBlocksPerMultiprocessor(&per_cu, k_mega, NT, 0);
        if (per_cu < 1) { fprintf(stderr, "kernel_launch: occupancy query says %d blocks per CU\n", per_cu); per_cu = 1; }
        if (per_cu > 1) per_cu = 1;
        grid_blocks = cus * per_cu;
    }
    void* args[] = {&p};
    hipError_t e = hipLaunchCooperativeKernel((void*)k_mega, dim3(grid_blocks), dim3(NT), args, 0, stream);
    if (e != hipSuccess) fprintf(stderr, "cooperative launch failed: %s (grid %d)\n", hipGetErrorString(e), grid_blocks);
}
```

```cpp
#include <hip/hip_runtime.h>
#include <hip/hip_cooperative_groups.h>
#include <cstdint>
#include <cstdio>

typedef unsigned short bf16_t;
typedef short bf16x8 __attribute__((ext_vector_type(8)));
typedef float f32x4 __attribute__((ext_vector_type(4)));
typedef unsigned u32x4 __attribute__((ext_vector_type(4)));
typedef unsigned u32x2 __attribute__((ext_vector_type(2)));

#define DUP 0
namespace cg = cooperative_groups;
namespace {
constexpr int NB = 8, NS = 2048, ND = 1024, NL = 256, GW = 64, NROWS = 32;
constexpr int MT = NB * NS;
constexpr int MC = NB * NL;
constexpr int MA = MT + MC;
constexpr int NIN = 4096;
constexpr int NT = 512;
constexpr float EPS = 1e-6f;

constexpr size_t MiB = 1ull << 20;
constexpr size_t WS_CTL = 0;
constexpr size_t WS_MOD = 64 * 1024;
constexpr size_t WS_LB = 320 * 1024;
constexpr size_t WS_KEYS = 512 * 1024;
constexpr size_t WS_WIN = 1 * MiB;
constexpr size_t WS_WOUT = 9 * MiB;
constexpr size_t WS_WQ = 11 * MiB;
constexpr size_t WS_U = 15 * MiB;
constexpr size_t WS_V = 47 * MiB;
constexpr size_t WS_XN = 79 * MiB;
constexpr size_t WS_NAQ = 115 * MiB;
constexpr size_t WS_NAK = 131 * MiB;
constexpr size_t WS_NAV = 149 * MiB;
constexpr size_t WS_HQ = 167 * MiB;
constexpr size_t WS_ZF = 183 * MiB;
constexpr size_t WS_ZB = 201 * MiB;
constexpr size_t WS_HI = 219 * MiB;
constexpr size_t WS_HG = 237 * MiB;
constexpr size_t WS_END = 253 * MiB;
constexpr size_t WS_PQ = 115 * MiB;
constexpr size_t WS_PIDX = 179 * MiB;
constexpr size_t WS_PG = 187 * MiB;

struct Params {
    const float* x; const float* c; const float* ctx; const float* c_ctx; const float* w_mod; const float* b_mod;
    const float* norm1; const float* norm2; const float* w_in; const float* w_out; const float* rpb; const float* hg_lb;
    const float* hg_norm; const float* wq; const float* keys; const float* pu; const float* pv; const float* norm_f;
    float* out; unsigned char* ws;
};

__device__ __forceinline__ bf16_t f2bf(float f) { unsigned u = __float_as_uint(f); u += 0x7fffu + ((u >> 16) & 1u); return (bf16_t)(u >> 16); }
__device__ __forceinline__ float bf2f(bf16_t h) { return __uint_as_float(((unsigned)h) << 16); }
__device__ __forceinline__ unsigned pack2(float lo, float hi) { return (unsigned)f2bf(lo) | ((unsigned)f2bf(hi) << 16); }
__device__ __forceinline__ float bflo(unsigned w) { return __uint_as_float(w << 16); }
__device__ __forceinline__ float bfhi(unsigned w) { return __uint_as_float(w & 0xffff0000u); }
__device__ __forceinline__ float silu_f(float v) { return v / (1.f + __expf(-v)); }
__device__ __forceinline__ float sigmoid_f(float v) { return 1.f / (1.f + __expf(-v)); }
__device__ __forceinline__ float wave_sum(float v) {
#pragma unroll
    for (int o = 32; o >= 1; o >>= 1) v += __shfl_xor(v, o);
    return v;
}

__device__ __forceinline__ void mod_phase(const Params& p, float* lds) {
    float* sc = lds;
    float* red = lds + 9 * 1024;
    const int tid = threadIdx.x;
    float* mod = (float*)(p.ws + WS_MOD);
    for (int i = tid; i < 9 * 1024; i += NT) {
        const int r = i >> 10, k = i & 1023;
        const float v = (r < 8) ? p.c[r * 1024 + k] : p.c_ctx[k];
        sc[i] = silu_f(v);
    }
    __syncthreads();
    const int col = tid & 63, ks = tid >> 6;
    for (int unit = blockIdx.x; unit < 6144 / 64; unit += gridDim.x) {
        const int j = unit * 64 + col;
        float acc[9];
#pragma unroll
        for (int r = 0; r < 9; ++r) acc[r] = 0.f;
        for (int k = ks * 128; k < ks * 128 + 128; ++k) {
            const float w = p.w_mod[(size_t)k * 6144 + j];
#pragma unroll
            for (int r = 0; r < 9; ++r) acc[r] += sc[r * 1024 + k] * w;
        }
#pragma unroll
        for (int r = 0; r < 9; ++r) red[(ks * 9 + r) * 64 + col] = acc[r];
        __syncthreads();
        for (int i = tid; i < 9 * 64; i += NT) {
            const int r = i >> 6, cc = i & 63;
            float s = 0.f;
#pragma unroll
            for (int q = 0; q < 8; ++q) s += red[(q * 9 + r) * 64 + cc];
            mod[r * 6144 + unit * 64 + cc] = s + p.b_mod[unit * 64 + cc];
        }
        __syncthreads();
    }
    float* lb = (float*)(p.ws + WS_LB);
    for (int i = blockIdx.x * NT + tid; i < 1024; i += gridDim.x * NT) {
        const float a0 = p.hg_lb[i], a1 = p.hg_lb[1024 + i];
        lb[i] = 1.f / (1.f + __expf(a1 - a0));
    }
}

__device__ __forceinline__ void transpose_convert(const float* W, bf16_t* Wt, int K, int N, float* lds) {
    const int tid = threadIdx.x;
    const int tk = K / 64, tn = N / 64;
    for (int unit = blockIdx.x; unit < tk * tn; unit += gridDim.x) {
        const int k0 = (unit / tn) * 64, n0 = (unit % tn) * 64;
        for (int i = tid; i < 64 * 64; i += NT) { const int r = i >> 6, cc = i & 63; lds[r * 65 + cc] = W[(size_t)(k0 + r) * N + n0 + cc]; }
        __syncthreads();
        for (int i = tid; i < 64 * 64; i += NT) { const int n = i >> 6, k = i & 63; Wt[(size_t)(n0 + n) * K + k0 + k] = f2bf(lds[k * 65 + n]); }
        __syncthreads();
    }
}
__device__ __forceinline__ void convert_flat(const float* src, bf16_t* dst, size_t n) {
    const size_t stride = (size_t)gridDim.x * NT * 4;
    for (size_t i = ((size_t)blockIdx.x * NT + threadIdx.x) * 4; i < n; i += stride) {
        const f32x4 v = *(const f32x4*)(src + i);
        u32x2 o; o.x = pack2(v[0], v[1]); o.y = pack2(v[2], v[3]);
        *(u32x2*)(dst + i) = o;
    }
}

__device__ __forceinline__ void prep_phase(const Params& p, int which) {
    const int tid = threadIdx.x, lane = tid & 63, wave = tid >> 6;
    const float* mod = (const float*)(p.ws + WS_MOD);
    bf16_t* dst = (bf16_t*)(p.ws + WS_XN);
    const int nrows = which == 0 ? MA : MT;
    const float* g = which == 0 ? p.norm1 : p.norm2;
    for (int row = blockIdx.x * 8 + wave; row < nrows; row += gridDim.x * 8) {
        const float* src; int mr;
        if (which == 0) { if (row < MT) { src = p.x + (size_t)row * ND; mr = row / NS; } else { src = p.ctx + (size_t)(row - MT) * ND; mr = 8; } }
        else { src = p.out + (size_t)row * ND; mr = row / NS; }
        const float* sh = mod + mr * 6144 + (which == 0 ? 0 : 3072);
        const float* scl = mod + mr * 6144 + (which == 0 ? 1024 : 4096);
        f32x4 v[4]; float ss = 0.f;
#pragma unroll
        for (int i = 0; i < 4; ++i) { v[i] = *(const f32x4*)(src + i * 256 + lane * 4); ss += v[i][0] * v[i][0] + v[i][1] * v[i][1] + v[i][2] * v[i][2] + v[i][3] * v[i][3]; }
        ss = wave_sum(ss);
        const float rstd = rsqrtf(ss * (1.f / ND) + EPS);
#pragma unroll
        for (int i = 0; i < 4; ++i) {
            const int d = i * 256 + lane * 4;
            const f32x4 gg = *(const f32x4*)(g + d), s1 = *(const f32x4*)(sh + d), s2 = *(const f32x4*)(scl + d);
            float h[4];
#pragma unroll
            for (int e = 0; e < 4; ++e) h[e] = (v[i][e] * rstd * gg[e]) * (1.f + s2[e]) + s1[e];
            u32x2 o; o.x = pack2(h[0], h[1]); o.y = pack2(h[2], h[3]);
            *(u32x2*)(dst + (size_t)row * ND + d) = o;
        }
    }
}

template <class Epi>
__device__ __forceinline__ void gemm_tile(const bf16_t* __restrict__ A, int lda, const bf16_t* __restrict__ Bt, int ldb, int K, int m0, int n0, unsigned char* lds, const Epi& epi) {
    unsigned char* As = lds; unsigned char* Bs = lds + 32768;
    const int tid = threadIdx.x, lane = tid & 63, wave = tid >> 6;
    const int wm = wave >> 1, wn = wave & 1;
    const int lr = tid >> 3, lc = tid & 7;
    const int fr = lane & 15, fq = lane >> 4;
    f32x4 acc[4][4];
#pragma unroll
    for (int i = 0; i < 4; ++i)
#pragma unroll
        for (int j = 0; j < 4; ++j) acc[i][j] = (f32x4){0.f, 0.f, 0.f, 0.f};
    u32x4 ra[4], rb[2];
    const bf16_t* Ap = A + (size_t)(m0 + lr) * lda + lc * 8;
    const bf16_t* Bp = Bt + (size_t)(n0 + lr) * ldb + lc * 8;
#pragma unroll
    for (int i = 0; i < 4; ++i) ra[i] = *(const u32x4*)(Ap + (size_t)(i * 64) * lda);
#pragma unroll
    for (int i = 0; i < 2; ++i) rb[i] = *(const u32x4*)(Bp + (size_t)(i * 64) * ldb);
    const int nkt = K / 64;
    for (int kt = 0; kt < nkt; ++kt) {
#pragma unroll
        for (int i = 0; i < 4; ++i) { const int r = lr + i * 64; *(u32x4*)(As + r * 128 + ((lc ^ (r & 7)) << 4)) = ra[i]; }
#pragma unroll
        for (int i = 0; i < 2; ++i) { const int r = lr + i * 64; *(u32x4*)(Bs + r * 128 + ((lc ^ (r & 7)) << 4)) = rb[i]; }
        __syncthreads();
        if (kt + 1 < nkt) {
            const int k0 = (kt + 1) * 64;
#pragma unroll
            for (int i = 0; i < 4; ++i) ra[i] = *(const u32x4*)(Ap + (size_t)(i * 64) * lda + k0);
#pragma unroll
            for (int i = 0; i < 2; ++i) rb[i] = *(const u32x4*)(Bp + (size_t)(i * 64) * ldb + k0);
        }
#pragma unroll
        for (int kk = 0; kk < 2; ++kk) {
            const int ch = kk * 4 + fq;
            bf16x8 fa[4], fb[4];
#pragma unroll
            for (int i = 0; i < 4; ++i) { const int r = wm * 64 + i * 16 + fr; fa[i] = *(const bf16x8*)(As + r * 128 + ((ch ^ (r & 7)) << 4)); }
#pragma unroll
            for (int j = 0; j < 4; ++j) { const int r = wn * 64 + j * 16 + fr; fb[j] = *(const bf16x8*)(Bs + r * 128 + ((ch ^ (r & 7)) << 4)); }
#pragma unroll
            for (int i = 0; i < 4; ++i)
#pragma unroll
                for (int j = 0; j < 4; ++j) acc[i][j] = __builtin_amdgcn_mfma_f32_16x16x32_bf16(fb[j], fa[i], acc[i][j], 0, 0, 0);
        }
        __syncthreads();
    }
#pragma unroll
    for (int i = 0; i < 4; ++i)
#pragma unroll
        for (int j = 0; j < 4; ++j) epi(m0 + wm * 64 + i * 16 + fr, n0 + wn * 64 + j * 16 + fq * 4, acc[i][j]);
}

__device__ __forceinline__ void store_bf16x4(bf16_t* dst, const f32x4& v) { u32x2 o; o.x = pack2(v[0], v[1]); o.y = pack2(v[2], v[3]); *(u32x2*)dst = o; }

struct EpiInProj {
    unsigned char* ws;
    __device__ __forceinline__ void operator()(int m, int n, const f32x4& v) const {
        const int seg = n >> 9, c = n & 511;
        const size_t o = (size_t)m * 512 + c;
        switch (seg) {
            case 0: { f32x4 s = v * 0.125f; store_bf16x4((bf16_t*)(ws + WS_NAQ) + o, s); break; }
            case 1: store_bf16x4((bf16_t*)(ws + WS_NAK) + o, v); break;
            case 2: {
                bf16_t* vt = (bf16_t*)(ws + WS_NAV); const int hh = c >> 6, dim = c & 63;
                if (m < MT) { const int b = m >> 11, s = m & 2047; bf16_t* q = vt + ((size_t)((b * 8 + hh) * 64 + dim)) * 2048 + s;
                    q[0] = f2bf(v[0]); q[2048] = f2bf(v[1]); q[4096] = f2bf(v[2]); q[6144] = f2bf(v[3]); }
                else { const int mm = m - MT, b = mm >> 8, j = mm & 255; bf16_t* q = vt + (size_t)MT * 512 + ((size_t)((b * 8 + hh) * 64 + dim)) * 256 + j;
                    q[0] = f2bf(v[0]); q[256] = f2bf(v[1]); q[512] = f2bf(v[2]); q[768] = f2bf(v[3]); }
                break; }
            case 3: { f32x4 s; s[0] = silu_f(v[0]); s[1] = silu_f(v[1]); s[2] = silu_f(v[2]); s[3] = silu_f(v[3]); store_bf16x4((bf16_t*)(ws + WS_HQ) + o, s); break; }
            case 4: store_bf16x4((bf16_t*)(ws + WS_ZF) + o, v); break;
            case 5: store_bf16x4((bf16_t*)(ws + WS_ZB) + o, v); break;
            case 6: store_bf16x4((bf16_t*)(ws + WS_HI) + o, v); break;
            default: { f32x4 s; s[0] = silu_f(v[0]); s[1] = silu_f(v[1]); s[2] = silu_f(v[2]); s[3] = silu_f(v[3]); store_bf16x4((bf16_t*)(ws + WS_HG) + o, s); break; }
        }
    }
};
__device__ __forceinline__ void inproj_phase(const Params& p, unsigned char* lds) {
    const bf16_t* A = (const bf16_t*)(p.ws + WS_XN); const bf16_t* Bt = (const bf16_t*)(p.ws + WS_WIN);
    EpiInProj epi{p.ws};
    const int nlat = 64 * 32, nctx = 8 * 20;
    for (int unit = blockIdx.x; unit < nlat + nctx; unit += gridDim.x) {
        int mt, nt;
        if (unit < nlat) { mt = unit >> 5; nt = unit & 31; }
        else { const int u = unit - nlat; mt = 64 + u / 20; const int q = u % 20; nt = q < 8 ? 4 + q : 16 + (q - 8); }
        gemm_tile(A, ND, Bt, ND, ND, mt * 256, nt * 128, lds, epi);
    }
}

struct EpiOutProj {
    const float* x; const float* mod; float* out;
    __device__ __forceinline__ void operator()(int m, int n, const f32x4& v) const {
        const int b = m / NS;
        const f32x4 xv = *(const f32x4*)(x + (size_t)m * ND + n), g = *(const f32x4*)(mod + b * 6144 + 2048 + n);
        *(f32x4*)(out + (size_t)m * ND + n) = xv + g * v;
    }
};
__device__ __forceinline__ void outproj_phase(const Params& p, unsigned char* lds) {
    const bf16_t* A = (const bf16_t*)(p.ws + WS_XN); const bf16_t* Bt = (const bf16_t*)(p.ws + WS_WOUT);
    EpiOutProj epi{p.x, (const float*)(p.ws + WS_MOD), p.out};
    for (int unit = blockIdx.x; unit < 64 * 8; unit += gridDim.x) gemm_tile(A, ND, Bt, ND, ND, (unit >> 3) * 256, (unit & 7) * 128, lds, epi);
}
struct EpiPq { bf16_t* pq; __device__ __forceinline__ void operator()(int m, int n, const f32x4& v) const { store_bf16x4(pq + (size_t)m * 2048 + n, v); } };
__device__ __forceinline__ void pq_phase(const Params& p, unsigned char* lds) {
    const bf16_t* A = (const bf16_t*)(p.ws + WS_XN); const bf16_t* Bt = (const bf16_t*)(p.ws + WS_WQ);
    EpiPq epi{(bf16_t*)(p.ws + WS_PQ)};
    for (int unit = blockIdx.x; unit < 64 * 16; unit += gridDim.x) gemm_tile(A, ND, Bt, ND, ND, (unit >> 4) * 256, (unit & 15) * 128, lds, epi);
}

__device__ __forceinline__ void na_naive_phase(const Params& p) {
    const bf16_t* Q = (const bf16_t*)(p.ws + WS_NAQ); const bf16_t* Kk = (const bf16_t*)(p.ws + WS_NAK); const bf16_t* V = (const bf16_t*)(p.ws + WS_NAV);
    bf16_t* mix = (bf16_t*)(p.ws + WS_XN);
    const int tid = threadIdx.x;
    for (int unit = blockIdx.x; unit < MT / 64; unit += gridDim.x) {
        const int tok = unit * 64 + (tid >> 3), h = tid & 7;
        const int b = tok / NS, s = tok % NS, r = s >> 6, qc = s & 63;
        const int rs = min(max(r - 4, 0), NROWS - 8), cs = min(max(qc - 8, 0), GW - 16);
        float q[64], o[64];
        {
            const u32x4* qp = (const u32x4*)(Q + (size_t)tok * 512 + h * 64);
#pragma unroll
            for (int i = 0; i < 8; ++i) { const u32x4 w = qp[i];
#pragma unroll
                for (int e = 0; e < 4; ++e) { q[i * 8 + e * 2] = bflo(w[e]); q[i * 8 + e * 2 + 1] = bfhi(w[e]); } }
        }
#pragma unroll
        for (int i = 0; i < 64; ++i) o[i] = 0.f;
        float mx = -1e30f, l = 0.f;
        for (int it = 0; it < 128 + 256; ++it) {
            int kt; float bias = 0.f;
            if (it < 128) { const int kr = it >> 4, kc = it & 15; kt = b * NS + (rs + kr) * 64 + cs + kc; bias = p.rpb[h * 15 * 31 + (rs + kr - r + 7) * 31 + (cs + kc - qc + 15)]; }
            else kt = MT + b * NL + (it - 128);
            const u32x4* kp = (const u32x4*)(Kk + (size_t)kt * 512 + h * 64);
            float d = 0.f;
#pragma unroll
            for (int i = 0; i < 8; ++i) { const u32x4 w = kp[i];
#pragma unroll
                for (int e = 0; e < 4; ++e) { d += q[i * 8 + e * 2] * bflo(w[e]); d += q[i * 8 + e * 2 + 1] * bfhi(w[e]); } }
            d += bias;
            const float mn = fmaxf(mx, d), sc = __expf(mx - mn), pe = __expf(d - mn);
            l = l * sc + pe; mx = mn;
            const u32x4* vp = (const u32x4*)(V + (size_t)kt * 512 + h * 64);
#pragma unroll
            for (int i = 0; i < 8; ++i) { const u32x4 w = vp[i];
#pragma unroll
                for (int e = 0; e < 4; ++e) { o[i * 8 + e * 2] = o[i * 8 + e * 2] * sc + pe * bflo(w[e]); o[i * 8 + e * 2 + 1] = o[i * 8 + e * 2 + 1] * sc + pe * bfhi(w[e]); } }
        }
        const float inv = 1.f / l;
        u32x4* op = (u32x4*)(mix + (size_t)tok * ND + h * 64);
#pragma unroll
        for (int i = 0; i < 8; ++i) { u32x4 w;
#pragma unroll
            for (int e = 0; e < 4; ++e) w[e] = pack2(o[i * 8 + e * 2] * inv, o[i * 8 + e * 2 + 1] * inv);
            op[i] = w; }
    }
}

__device__ __forceinline__ void na_mfma_phase(const Params& p, float* rpbL, int blk, int nblk) {
    const bf16_t* Q = (const bf16_t*)(p.ws + WS_NAQ); const bf16_t* Kk = (const bf16_t*)(p.ws + WS_NAK); const bf16_t* VT = (const bf16_t*)(p.ws + WS_NAV);
    bf16_t* mix = (bf16_t*)(p.ws + WS_XN);
    const int tid = threadIdx.x, lane = tid & 63, wave = tid >> 6, fr = lane & 15, fq = lane >> 4;
    for (int i = tid; i < 8 * 15 * 31; i += NT) rpbL[i] = p.rpb[i];
    __syncthreads();
    for (int bu = blk; bu < 1024; bu += nblk) {
        const int u = bu * 8 + wave;
        const int cb = u & 3, r = (u >> 2) & 31, h = (u >> 7) & 7, b = u >> 10;
        const int rs = min(max(r - 4, 0), NROWS - 8), kc0 = min(max(cb * 16 - 8, 0), GW - 32);
        const int qc = cb * 16 + fr, cs = min(max(qc - 8, 0), GW - 16);
        const size_t qtok = (size_t)b * NS + r * 64 + qc;
        const bf16x8 q0 = *(const bf16x8*)(Q + qtok * 512 + h * 64 + fq * 8), q1 = *(const bf16x8*)(Q + qtok * 512 + h * 64 + 32 + fq * 8);
        f32x4 o[4];
#pragma unroll
        for (int mt = 0; mt < 4; ++mt) o[mt] = (f32x4){0.f, 0.f, 0.f, 0.f};
        float mx = -1e30f, l = 0.f;
#pragma unroll 1
        for (int g = 0; g < 4; ++g) {
            const bool win = g < 2;
            f32x4 s[8];
#pragma unroll
            for (int tl = 0; tl < 8; ++tl) {
                const size_t kt = win ? (size_t)b * NS + (rs + g * 4 + (tl >> 1)) * 64 + kc0 + (tl & 1) * 16 + fr : (size_t)MT + b * NL + ((g - 2) * 8 + tl) * 16 + fr;
                const bf16x8 k0 = *(const bf16x8*)(Kk + kt * 512 + h * 64 + fq * 8), k1 = *(const bf16x8*)(Kk + kt * 512 + h * 64 + 32 + fq * 8);
                f32x4 acc = (f32x4){0.f, 0.f, 0.f, 0.f};
                acc = __builtin_amdgcn_mfma_f32_16x16x32_bf16(k0, q0, acc, 0, 0, 0);
                acc = __builtin_amdgcn_mfma_f32_16x16x32_bf16(k1, q1, acc, 0, 0, 0);
                s[tl] = acc;
            }
            if (win) {
#pragma unroll
                for (int tl = 0; tl < 8; ++tl) {
                    const int dr = rs + g * 4 + (tl >> 1) - r + 7;
#pragma unroll
                    for (int e = 0; e < 4; ++e) {
                        const int kcol = kc0 + (tl & 1) * 16 + fq * 4 + e;
                        const bool ok = (kcol >= cs) && (kcol < cs + 16);
                        const int dc = min(max(kcol - qc + 15, 0), 30);
                        s[tl][e] = ok ? s[tl][e] + rpbL[h * 465 + dr * 31 + dc] : -1e30f;
                    }
                }
            }
            float gm = -1e30f;
#pragma unroll
            for (int tl = 0; tl < 8; ++tl) gm = fmaxf(gm, fmaxf(fmaxf(s[tl][0], s[tl][1]), fmaxf(s[tl][2], s[tl][3])));
            gm = fmaxf(gm, __shfl_xor(gm, 16)); gm = fmaxf(gm, __shfl_xor(gm, 32));
            const float mn = fmaxf(mx, gm), sc = __expf(mx - mn);
            mx = mn;
            float ls = 0.f;
#pragma unroll
            for (int tl = 0; tl < 8; ++tl)
#pragma unroll
                for (int e = 0; e < 4; ++e) { const float pe = __expf(s[tl][e] - mn); s[tl][e] = pe; ls += pe; }
            l = l * sc + ls;
#pragma unroll
            for (int mt = 0; mt < 4; ++mt) o[mt] = o[mt] * sc;
#pragma unroll
            for (int pl = 0; pl < 4; ++pl) {
                u32x4 pw; pw[0] = pack2(s[2 * pl][0], s[2 * pl][1]); pw[1] = pack2(s[2 * pl][2], s[2 * pl][3]); pw[2] = pack2(s[2 * pl + 1][0], s[2 * pl + 1][1]); pw[3] = pack2(s[2 * pl + 1][2], s[2 * pl + 1][3]);
                const bf16x8 pf = __builtin_bit_cast(bf16x8, pw);
#pragma unroll
                for (int mt = 0; mt < 4; ++mt) {
                    const size_t drow = (size_t)((b * 8 + h) * 64 + mt * 16 + fr);
                    const bf16_t* vp = win ? VT + drow * 2048 + (rs + g * 4 + pl) * 64 + kc0 + fq * 4 : VT + (size_t)MT * 512 + drow * 256 + ((g - 2) * 4 + pl) * 32 + fq * 4;
                    const u32x2 va = *(const u32x2*)vp, vb = *(const u32x2*)(vp + 16);
                    u32x4 vw; vw[0] = va[0]; vw[1] = va[1]; vw[2] = vb[0]; vw[3] = vb[1];
                    o[mt] = __builtin_amdgcn_mfma_f32_16x16x32_bf16(__builtin_bit_cast(bf16x8, vw), pf, o[mt], 0, 0, 0);
                }
            }
        }
        l += __shfl_xor(l, 16); l += __shfl_xor(l, 32);
        const float inv = 1.f / l;
#pragma unroll
        for (int mt = 0; mt < 4; ++mt)
            *(u32x2*)(mix + qtok * ND + h * 64 + mt * 16 + fq * 4) = (u32x2){pack2(o[mt][0] * inv, o[mt][1] * inv), pack2(o[mt][2] * inv, o[mt][3] * inv)};
    }
}

__device__ __forceinline__ void hg_naive_phase(const Params& p) {
    const bf16_t* HQ = (const bf16_t*)(p.ws + WS_HQ); const bf16_t* HI = (const bf16_t*)(p.ws + WS_HI);
    const float* lbp = (const float*)(p.ws + WS_LB);
    const int tid = threadIdx.x, vl = tid >> 4, dsl = tid & 15;
    for (int unit = blockIdx.x; unit < NB * 4 * 2 * 4; unit += gridDim.x) {
        const int vs = unit & 3, dir = (unit >> 2) & 1, h = (unit >> 3) & 3, b = unit >> 5;
        const bf16_t* Z = (const bf16_t*)(p.ws + (dir ? WS_ZB : WS_ZF));
        float* O = p.out + (size_t)dir * MT * 512;
        const int v = vs * 32 + vl, d0 = dsl * 8;
        float lb[8], S[8];
#pragma unroll
        for (int e = 0; e < 8; ++e) { lb[e] = lbp[dir * 512 + h * 128 + d0 + e]; S[e] = 0.f; }
        for (int step = 0; step < NL + NS; ++step) {
            const bool isctx = step < NL;
            int t = isctx ? step : step - NL;
            if (dir) t = (isctx ? NL : NS) - 1 - t;
            const size_t row = isctx ? (size_t)MT + b * NL + t : (size_t)b * NS + t;
            const u32x4 zw = *(const u32x4*)(Z + row * 512 + h * 128 + d0);
            const float vv = bf2f(HI[row * 512 + h * 128 + v]);
            float z[8];
#pragma unroll
            for (int e = 0; e < 4; ++e) { z[e * 2] = bflo(zw[e]); z[e * 2 + 1] = bfhi(zw[e]); }
#pragma unroll
            for (int e = 0; e < 8; ++e) { const float f = lb[e] + (1.f - lb[e]) * sigmoid_f(z[e]); S[e] = f * S[e] + (1.f - f) * vv; }
            if (!isctx) {
                const u32x4 qw = *(const u32x4*)(HQ + row * 512 + h * 128 + d0);
                float acc = 0.f;
#pragma unroll
                for (int e = 0; e < 4; ++e) { acc += bflo(qw[e]) * S[e * 2]; acc += bfhi(qw[e]) * S[e * 2 + 1]; }
                acc += __shfl_xor(acc, 1); acc += __shfl_xor(acc, 2); acc += __shfl_xor(acc, 4); acc += __shfl_xor(acc, 8);
                if (dsl == 0) O[row * 512 + h * 128 + v] = acc;
            }
        }
    }
}

__device__ __forceinline__ int swz8(int row) { return ((row >> 3) ^ row) & 7; }
__device__ __forceinline__ bf16x8 ld256(const unsigned char* base, int row, int ch) { return *(const bf16x8*)(base + row * 256 + (((ch ^ row) & 15) << 4)); }
__device__ __forceinline__ bf16x8 ld128(const unsigned char* base, int row, int ch) { return *(const bf16x8*)(base + row * 128 + ((ch ^ swz8(row)) << 4)); }
constexpr int HG_LDS = 157696;
__device__ __forceinline__ size_t hg_row(int ci, int t, int b, int dir) {
    const bool isctx = ci < 4; const int lc = isctx ? ci : ci - 4, T = isctx ? NL : NS; const size_t base = isctx ? (size_t)MT + b * NL : (size_t)b * NS;
    const int pos = lc * 64 + t; return dir ? base + T - 1 - pos : base + pos;
}
__device__ __forceinline__ void hg_chain(const Params& p, unsigned char* lds, int unit) {
    const int tid = threadIdx.x, lane = tid & 63, wave = tid >> 6, fr = lane & 15, fq = lane >> 4;
    const int dir = unit & 1, h = (unit >> 1) & 3, b = unit >> 3;
    float* BF = (float*)lds;
    unsigned char* QT = lds + 32768;
    unsigned char* QH = lds + 49152;
    unsigned char* KT = lds + 65536;
    unsigned char* KBT = lds + 81920;
    unsigned char* VT = lds + 98304;
    unsigned char* PP = lds + 114688;
    unsigned char* SB = lds + 122880;
    float* TOT = (float*)(lds + 155648);
    const bf16_t* HQ = (const bf16_t*)(p.ws + WS_HQ); const bf16_t* HI = (const bf16_t*)(p.ws + WS_HI);
    const bf16_t* Z = (const bf16_t*)(p.ws + (dir ? WS_ZB : WS_ZF));
    const float* lbp = (const float*)(p.ws + WS_LB) + dir * 512 + h * 128;
    float* O = p.out + (size_t)dir * MT * 512;
    const int bt = tid >> 3, bg = tid & 7;
    float lbv[16];
#pragma unroll
    for (int e = 0; e < 8; ++e) { lbv[e] = lbp[bg * 8 + e]; lbv[8 + e] = lbp[64 + bg * 8 + e]; }
    for (int i = tid; i < (8192 + 32768) / 16; i += NT) *(u32x4*)(PP + i * 16) = (u32x4){0u, 0u, 0u, 0u};
    f32x4 accS[8];
#pragma unroll
    for (int i = 0; i < 8; ++i) accS[i] = (f32x4){0.f, 0.f, 0.f, 0.f};
    u32x4 zr[2], qr[2], vr[2];
    {
        const size_t r = hg_row(0, bt, b, dir);
#pragma unroll
        for (int g = 0; g < 2; ++g) { const size_t o = r * 512 + h * 128 + g * 64 + bg * 8; zr[g] = *(const u32x4*)(Z + o); vr[g] = *(const u32x4*)(HI + o); qr[g] = (u32x4){0u, 0u, 0u, 0u}; }
    }
    __syncthreads();
    for (int ci = 0; ci < 36; ++ci) {
        const bool isctx = ci < 4;
        float kf[16], qf[16];
#pragma unroll
        for (int g = 0; g < 2; ++g) {
            float lf[8];
#pragma unroll
            for (int e = 0; e < 8; ++e) {
                const unsigned zw = zr[g][e >> 1], qw = qr[g][e >> 1], vw = vr[g][e >> 1];
                const float z = (e & 1) ? bfhi(zw) : bflo(zw);
                const float l = lbv[g * 8 + e], f = l + (1.f - l) * sigmoid_f(z);
                lf[e] = __logf(f); kf[g * 8 + e] = 1.f - f;
                qf[g * 8 + e] = (e & 1) ? bfhi(qw) : bflo(qw);
                const int vd = g * 64 + bg * 8 + e;
                *(bf16_t*)(VT + vd * 128 + ((((bt >> 3) ^ swz8(vd)) & 7) << 4) + (bt & 7) * 2) = (bf16_t)((e & 1) ? (vw >> 16) : (vw & 0xffffu));
            }
            *(f32x4*)(BF + bt * 128 + g * 64 + bg * 8) = (f32x4){lf[0], lf[1], lf[2], lf[3]};
            *(f32x4*)(BF + bt * 128 + g * 64 + bg * 8 + 4) = (f32x4){lf[4], lf[5], lf[6], lf[7]};
        }
        __syncthreads();
        {
            const int d = tid & 127, I = tid >> 7;
            float s = 0.f;
#pragma unroll
            for (int j = 0; j < 16; ++j) { s += BF[(I * 16 + j) * 128 + d]; BF[(I * 16 + j) * 128 + d] = s; }
            TOT[I * 128 + d] = s;
        }
        __syncthreads();
#pragma unroll
        for (int g = 0; g < 2; ++g) {
            const int d0 = g * 64 + bg * 8;
            float bl[8], t0[8], t1[8], t2[8], b31[8];
#pragma unroll
            for (int q4 = 0; q4 < 2; ++q4) {
                const f32x4 a = *(const f32x4*)(BF + bt * 128 + d0 + q4 * 4), x0 = *(const f32x4*)(TOT + d0 + q4 * 4), x1 = *(const f32x4*)(TOT + 128 + d0 + q4 * 4),
                            x2 = *(const f32x4*)(TOT + 256 + d0 + q4 * 4), m = *(const f32x4*)(BF + 31 * 128 + d0 + q4 * 4);
#pragma unroll
                for (int e = 0; e < 4; ++e) { bl[q4 * 4 + e] = a[e]; t0[q4 * 4 + e] = x0[e]; t1[q4 * 4 + e] = x1[e]; t2[q4 * 4 + e] = x2[e]; b31[q4 * 4 + e] = m[e]; }
            }
            const int I = bt >> 4;
            float vq[8], vh[8], vk[8];
#pragma unroll
            for (int e = 0; e < 8; ++e) {
                const float off = (I > 0 ? t0[e] : 0.f) + (I > 1 ? t1[e] : 0.f) + (I > 2 ? t2[e] : 0.f);
                const float bte = bl[e] + off, bmid = b31[e] + t0[e];
                const float x = fminf(fmaxf(bte - bmid, -80.f), 80.f);
                const float E = __expf(x), Ei = __expf(-x);
                vq[e] = qf[g * 8 + e] * E; vh[e] = qf[g * 8 + e] * __expf(bte); vk[e] = kf[g * 8 + e] * Ei;
            }
            const int so = bt * 256 + ((((d0 >> 3) ^ bt) & 15) << 4);
            *(u32x4*)(QT + so) = (u32x4){pack2(vq[0], vq[1]), pack2(vq[2], vq[3]), pack2(vq[4], vq[5]), pack2(vq[6], vq[7])};
            *(u32x4*)(QH + so) = (u32x4){pack2(vh[0], vh[1]), pack2(vh[2], vh[3]), pack2(vh[4], vh[5]), pack2(vh[6], vh[7])};
            *(u32x4*)(KT + so) = (u32x4){pack2(vk[0], vk[1]), pack2(vk[2], vk[3]), pack2(vk[4], vk[5]), pack2(vk[6], vk[7])};
        }
        if (ci + 1 < 36) {
            const size_t r = hg_row(ci + 1, bt, b, dir); const bool nctx = (ci + 1) < 4;
#pragma unroll
            for (int g = 0; g < 2; ++g) { const size_t o = r * 512 + h * 128 + g * 64 + bg * 8; zr[g] = *(const u32x4*)(Z + o); vr[g] = *(const u32x4*)(HI + o);
                qr[g] = nctx ? (u32x4){0u, 0u, 0u, 0u} : *(const u32x4*)(HQ + o); }
        }
        __syncthreads();
        if (!isctx) {
            int frA = fr, fqA = fq; asm volatile("" : "+v"(frA), "+v"(fqA));
            for (int n = wave; n < 10; n += 8) {
                const int I = n >= 6 ? 3 : n >= 3 ? 2 : n >= 1 ? 1 : 0, J = n - (I * (I + 1)) / 2;
                f32x4 acc = (f32x4){0.f, 0.f, 0.f, 0.f};
#pragma unroll
                for (int kd = 0; kd < 4; ++kd) acc = __builtin_amdgcn_mfma_f32_16x16x32_bf16(ld256(KT, J * 16 + frA, kd * 4 + fqA), ld256(QT, I * 16 + frA, kd * 4 + fqA), acc, 0, 0, 0);
                if (I == J) {
#pragma unroll
                    for (int e = 0; e < 4; ++e) if (fqA * 4 + e > frA) acc[e] = 0.f;
                }
                const int t = I * 16 + frA;
                *(u32x2*)(PP + t * 128 + ((((J * 2 + (fqA >> 1)) ^ swz8(t)) & 7) << 4) + (fqA & 1) * 8) = (u32x2){pack2(acc[0], acc[1]), pack2(acc[2], acc[3])};
            }
        }
        {
            const int d = tid & 127, sg = tid >> 7;
            const float c2 = __expf(BF[63 * 128 + d] + TOT[128 + d] + TOT[256 + d] - BF[31 * 128 + d]);
            float kv[16];
#pragma unroll
            for (int j = 0; j < 16; ++j) { const int s = sg * 16 + j; kv[j] = bf2f(*(const bf16_t*)(KT + s * 256 + ((((d >> 3) ^ s) & 15) << 4) + (d & 7) * 2)) * c2; }
            const int sw = swz8(d);
            *(u32x4*)(KBT + d * 128 + ((((sg * 2) ^ sw) & 7) << 4)) = (u32x4){pack2(kv[0], kv[1]), pack2(kv[2], kv[3]), pack2(kv[4], kv[5]), pack2(kv[6], kv[7])};
            *(u32x4*)(KBT + d * 128 + ((((sg * 2 + 1) ^ sw) & 7) << 4)) = (u32x4){pack2(kv[8], kv[9]), pack2(kv[10], kv[11]), pack2(kv[12], kv[13]), pack2(kv[14], kv[15])};
        }
        __syncthreads();
        if (!isctx) {
            int frB = fr, fqB = fq; asm volatile("" : "+v"(frB), "+v"(fqB));
            f32x4 acc[4];
#pragma unroll
            for (int tt = 0; tt < 4; ++tt) acc[tt] = (f32x4){0.f, 0.f, 0.f, 0.f};
#pragma unroll
            for (int kd = 0; kd < 4; ++kd) {
                const bf16x8 a = ld256(SB, wave * 16 + frB, kd * 4 + fqB);
#pragma unroll
                for (int tt = 0; tt < 4; ++tt) acc[tt] = __builtin_amdgcn_mfma_f32_16x16x32_bf16(a, ld256(QH, tt * 16 + frB, kd * 4 + fqB), acc[tt], 0, 0, 0);
            }
#pragma unroll
            for (int ks = 0; ks < 2; ++ks) {
                const bf16x8 a = ld128(VT, wave * 16 + frB, ks * 4 + fqB);
#pragma unroll
                for (int tt = 0; tt < 4; ++tt) acc[tt] = __builtin_amdgcn_mfma_f32_16x16x32_bf16(a, ld128(PP, tt * 16 + frB, ks * 4 + fqB), acc[tt], 0, 0, 0);
            }
#pragma unroll
            for (int tt = 0; tt < 4; ++tt) *(f32x4*)(O + hg_row(ci, tt * 16 + frB, b, dir) * 512 + h * 128 + wave * 16 + fqB * 4) = acc[tt];
        }
        int frC = fr, fqC = fq; asm volatile("" : "+v"(frC), "+v"(fqC));
        {
            const int d4 = wave * 16 + fqC * 4;
            const f32x4 l63 = *(const f32x4*)(BF + 63 * 128 + d4), x0 = *(const f32x4*)(TOT + d4), x1 = *(const f32x4*)(TOT + 128 + d4), x2 = *(const f32x4*)(TOT + 256 + d4);
            f32x4 c3;
#pragma unroll
            for (int e = 0; e < 4; ++e) c3[e] = __expf(l63[e] + x0[e] + x1[e] + x2[e]);
            const bf16x8 a0 = ld128(KBT, wave * 16 + frC, fqC), a1 = ld128(KBT, wave * 16 + frC, 4 + fqC);
#pragma unroll
            for (int vt = 0; vt < 8; ++vt) {
                accS[vt] = accS[vt] * c3;
                accS[vt] = __builtin_amdgcn_mfma_f32_16x16x32_bf16(a0, ld128(VT, vt * 16 + frC, fqC), accS[vt], 0, 0, 0);
                accS[vt] = __builtin_amdgcn_mfma_f32_16x16x32_bf16(a1, ld128(VT, vt * 16 + frC, 4 + fqC), accS[vt], 0, 0, 0);
            }
        }
        __syncthreads();
#pragma unroll
        for (int vt = 0; vt < 8; ++vt) {
            const int row = vt * 16 + frC;
            *(u32x2*)(SB + row * 256 + ((((wave * 2 + (fqC >> 1)) ^ row) & 15) << 4) + (fqC & 1) * 8) = (u32x2){pack2(accS[vt][0], accS[vt][1]), pack2(accS[vt][2], accS[vt][3])};
        }
    }
    __syncthreads();
}
__device__ __forceinline__ void hg_chunk_phase(const Params& p, unsigned char* lds) {
    for (int unit = blockIdx.x; unit < 64; unit += gridDim.x) hg_chain(p, lds, unit);
}

__device__ __forceinline__ void hgmix_phase(const Params& p) {
    const float* OF = p.out; const float* OB = p.out + (size_t)MT * 512;
    const bf16_t* HG = (const bf16_t*)(p.ws + WS_HG);
    bf16_t* mix = (bf16_t*)(p.ws + WS_XN);
    const int tid = threadIdx.x, lane = tid & 63, wave = tid >> 6;
    for (int row = blockIdx.x * 8 + wave; row < MT; row += gridDim.x * 8) {
        const int c0 = lane * 8;
        float o[8]; float ss = 0.f;
        const f32x4 a0 = *(const f32x4*)(OF + (size_t)row * 512 + c0), a1 = *(const f32x4*)(OF + (size_t)row * 512 + c0 + 4);
        const f32x4 b0 = *(const f32x4*)(OB + (size_t)row * 512 + c0), b1 = *(const f32x4*)(OB + (size_t)row * 512 + c0 + 4);
#pragma unroll
        for (int e = 0; e < 4; ++e) { o[e] = a0[e] + b0[e]; o[4 + e] = a1[e] + b1[e]; }
#pragma unroll
        for (int e = 0; e < 8; ++e) ss += o[e] * o[e];
        ss += __shfl_xor(ss, 1); ss += __shfl_xor(ss, 2); ss += __shfl_xor(ss, 4); ss += __shfl_xor(ss, 8);
        const float rstd = rsqrtf(ss * (1.f / 128.f) + EPS);
        const u32x4 gw = *(const u32x4*)(HG + (size_t)row * 512 + c0);
        float r[8];
#pragma unroll
        for (int e = 0; e < 4; ++e) { r[e * 2] = o[e * 2] * rstd * p.hg_norm[c0 + e * 2] * bflo(gw[e]); r[e * 2 + 1] = o[e * 2 + 1] * rstd * p.hg_norm[c0 + e * 2 + 1] * bfhi(gw[e]); }
        u32x4 w; w[0] = pack2(r[0], r[1]); w[1] = pack2(r[2], r[3]); w[2] = pack2(r[4], r[5]); w[3] = pack2(r[6], r[7]);
        *(u32x4*)(mix + (size_t)row * ND + 512 + c0) = w;
    }
}

__device__ __forceinline__ void wave_argmax(float& v, int& i) {
#pragma unroll
    for (int o = 32; o >= 1; o >>= 1) { const float ov = __shfl_xor(v, o); const int oi = __shfl_xor(i, o); if (ov > v || (ov == v && oi < i)) { v = ov; i = oi; } }
}
__device__ __forceinline__ unsigned ukey(float f) { const unsigned u = __float_as_uint(f); return (u & 0x80000000u) ? ~u : (u | 0x80000000u); }
__device__ __forceinline__ float ukey_inv(unsigned u) { return __uint_as_float((u & 0x80000000u) ? (u & 0x7fffffffu) : ~u); }
__device__ __forceinline__ int mbcnt64(unsigned long long m) { return (int)__builtin_amdgcn_mbcnt_hi((unsigned)(m >> 32), __builtin_amdgcn_mbcnt_lo((unsigned)m, 0u)); }
__device__ __forceinline__ void topk_phase(const Params& p, float* lds) {
    constexpr int LDW = 260;
    float* wsv = lds + 64 * LDW + (threadIdx.x >> 6) * 64;
    int* wsi = (int*)(wsv + 32);
    const bf16_t* PQ = (const bf16_t*)(p.ws + WS_PQ); const bf16_t* KEYS = (const bf16_t*)(p.ws + WS_KEYS);
    int* PIDX = (int*)(p.ws + WS_PIDX); float* PG = (float*)(p.ws + WS_PG);
    const int tid = threadIdx.x, lane = tid & 63, wave = tid >> 6, fr = lane & 15, fq = lane >> 4;
    for (int unit = blockIdx.x; unit < (MT / 64) * 8; unit += gridDim.x) {
        const int hp = unit & 7, t0 = (unit >> 3) * 64;
        {
            const int c = wave >> 2, kb = (wave & 3) * 32;
            f32x4 acc[4][2];
#pragma unroll
            for (int i = 0; i < 4; ++i) { acc[i][0] = (f32x4){0.f, 0.f, 0.f, 0.f}; acc[i][1] = (f32x4){0.f, 0.f, 0.f, 0.f}; }
#pragma unroll
            for (int ks = 0; ks < 4; ++ks) {
                bf16x8 fa[4], fb[2];
#pragma unroll
                for (int i = 0; i < 4; ++i) fa[i] = *(const bf16x8*)(PQ + (size_t)(t0 + i * 16 + fr) * 2048 + hp * 256 + c * 128 + ks * 32 + fq * 8);
#pragma unroll
                for (int j = 0; j < 2; ++j) fb[j] = *(const bf16x8*)(KEYS + (size_t)((hp * 2 + c) * 128 + kb + j * 16 + fr) * 128 + ks * 32 + fq * 8);
#pragma unroll
                for (int i = 0; i < 4; ++i)
#pragma unroll
                    for (int j = 0; j < 2; ++j) acc[i][j] = __builtin_amdgcn_mfma_f32_16x16x32_bf16(fa[i], fb[j], acc[i][j], 0, 0, 0);
            }
#pragma unroll
            for (int i = 0; i < 4; ++i)
#pragma unroll
                for (int j = 0; j < 2; ++j)
#pragma unroll
                    for (int e = 0; e < 4; ++e) lds[(i * 16 + fq * 4 + e) * LDW + c * 128 + kb + j * 16 + fr] = acc[i][j][e];
        }
        __syncthreads();
        for (int tt = 0; tt < 8; ++tt) {
            const int tl = wave * 8 + tt;
            const float* row = lds + tl * LDW;
            float a[2][2]; unsigned k[2][2];
#pragma unroll
            for (int c = 0; c < 2; ++c) {
                a[c][0] = row[c * 128 + lane]; a[c][1] = row[c * 128 + 64 + lane];
                k[c][0] = (ukey(a[c][0]) & ~127u) | (unsigned)(127 - lane);
                k[c][1] = (ukey(a[c][1]) & ~127u) | (unsigned)(63 - lane);
            }
            unsigned lo0 = 0u, hi0 = 0xffffffffu, lo1 = 0u, hi1 = 0xffffffffu, T0 = 0u, T1 = 0u; bool d0 = false, d1 = false;
            for (int it = 0; it < 40; ++it) {
                const unsigned m0 = lo0 + ((hi0 - lo0) >> 1), m1 = lo1 + ((hi1 - lo1) >> 1);
                const int c0 = __popcll(__ballot(k[0][0] >= m0)) + __popcll(__ballot(k[0][1] >= m0));
                const int c1 = __popcll(__ballot(k[1][0] >= m1)) + __popcll(__ballot(k[1][1] >= m1));
                if (!d0) { if (c0 == 16) { d0 = true; T0 = m0; } else if (c0 > 16) lo0 = m0; else hi0 = m0; }
                if (!d1) { if (c1 == 16) { d1 = true; T1 = m1; } else if (c1 > 16) lo1 = m1; else hi1 = m1; }
                if (d0 && d1) break;
            }
            if (!d0) T0 = hi0;
            if (!d1) T1 = hi1;
#pragma unroll
            for (int c = 0; c < 2; ++c) {
                const unsigned T = c ? T1 : T0;
                const bool f0 = k[c][0] >= T, f1 = k[c][1] >= T;
                const unsigned long long b0 = __ballot(f0), b1 = __ballot(f1);
                const int s0 = mbcnt64(b0), s1 = __popcll(b0) + mbcnt64(b1);
                if (f0 && s0 < 16) { wsv[c * 16 + s0] = a[c][0]; wsi[c * 16 + s0] = lane; }
                if (f1 && s1 < 16) { wsv[c * 16 + s1] = a[c][1]; wsi[c * 16 + s1] = lane + 64; }
            }
            const float s1v = wsv[lane >> 2]; const int i1 = wsi[lane >> 2];
            const f32x4 s2v = *(const f32x4*)(wsv + 16 + (lane & 3) * 4);
            float cv[4]; unsigned ck[4];
#pragma unroll
            for (int e = 0; e < 4; ++e) { cv[e] = s1v + s2v[e]; ck[e] = (ukey(cv[e]) & ~255u) | (unsigned)(255 - (lane * 4 + e)); }
            unsigned lo = 0u, hi = 0xffffffffu, T = 0u; bool dn = false;
            for (int it = 0; it < 40; ++it) {
                const unsigned m = lo + ((hi - lo) >> 1);
                int c = 0;
#pragma unroll
                for (int e = 0; e < 4; ++e) c += __popcll(__ballot(ck[e] >= m));
                if (c == 16) { dn = true; T = m; break; } else if (c > 16) lo = m; else hi = m;
            }
            if (!dn) T = hi;
            const float Tf = ukey_inv(T & ~255u);
            float ex[4]; float es = 0.f;
#pragma unroll
            for (int e = 0; e < 4; ++e) { ex[e] = (ck[e] >= T) ? __expf(cv[e] - Tf) : 0.f; es += ex[e]; }
            const float inv = 1.f / wave_sum(es);
            const size_t o = ((size_t)(t0 + tl) * 8 + hp) * 16;
            int base = 0;
#pragma unroll
            for (int e = 0; e < 4; ++e) {
                const bool f = ck[e] >= T;
                const unsigned long long bm = __ballot(f);
                const int slot = base + mbcnt64(bm);
                if (f && slot < 16) { PIDX[o + slot] = i1 * 128 + wsi[16 + (lane & 3) * 4 + e]; PG[o + slot] = ex[e] * inv; }
                base += __popcll(bm);
            }
        }
        __syncthreads();
    }
}

__device__ __forceinline__ void gather_phase(const Params& p, float* lds) {
    const bf16_t* H2 = (const bf16_t*)(p.ws + WS_XN); const bf16_t* U = (const bf16_t*)(p.ws + WS_U); const bf16_t* V = (const bf16_t*)(p.ws + WS_V);
    const int* PIDX = (const int*)(p.ws + WS_PIDX); const float* PG = (const float*)(p.ws + WS_PG);
    const float* mod = (const float*)(p.ws + WS_MOD);
    const int tid = threadIdx.x, lane = tid & 63, wave = tid >> 6;
    float* part = lds;
    float* red = lds + 8 * 1024;
    for (int tok = blockIdx.x; tok < MT; tok += gridDim.x) {
        const int b = tok / NS;
        float hv[16];
        {
            const u32x4 w0 = *(const u32x4*)(H2 + (size_t)tok * ND + lane * 8), w1 = *(const u32x4*)(H2 + (size_t)tok * ND + 512 + lane * 8);
#pragma unroll
            for (int e = 0; e < 4; ++e) { hv[e * 2] = bflo(w0[e]); hv[e * 2 + 1] = bfhi(w0[e]); hv[8 + e * 2] = bflo(w1[e]); hv[8 + e * 2 + 1] = bfhi(w1[e]); }
        }
        float acc[16];
#pragma unroll
        for (int e = 0; e < 16; ++e) acc[e] = 0.f;
        for (int k = 0; k < 16; ++k) {
            const size_t o = ((size_t)tok * 8 + wave) * 16 + k;
            const int idx = PIDX[o]; const float g = PG[o];
            const u32x4 u0 = *(const u32x4*)(U + (size_t)idx * ND + lane * 8), u1 = *(const u32x4*)(U + (size_t)idx * ND + 512 + lane * 8);
            float d = 0.f;
#pragma unroll
            for (int e = 0; e < 4; ++e) { d += hv[e * 2] * bflo(u0[e]) + hv[e * 2 + 1] * bfhi(u0[e]); d += hv[8 + e * 2] * bflo(u1[e]) + hv[8 + e * 2 + 1] * bfhi(u1[e]); }
            d = wave_sum(d);
            const float a = 0.5f * d * (1.f + erff(d * 0.70710678118654752f));
            const float w = g * a;
            const u32x4 v0 = *(const u32x4*)(V + (size_t)idx * ND + lane * 8), v1 = *(const u32x4*)(V + (size_t)idx * ND + 512 + lane * 8);
#pragma unroll
            for (int e = 0; e < 4; ++e) { acc[e * 2] += w * bflo(v0[e]); acc[e * 2 + 1] += w * bfhi(v0[e]); acc[8 + e * 2] += w * bflo(v1[e]); acc[8 + e * 2 + 1] += w * bfhi(v1[e]); }
        }
#pragma unroll
        for (int e = 0; e < 8; ++e) { part[wave * 1024 + lane * 8 + e] = acc[e]; part[wave * 1024 + 512 + lane * 8 + e] = acc[8 + e]; }
        __syncthreads();
        float y[2]; float ss = 0.f;
#pragma unroll
        for (int q = 0; q < 2; ++q) {
            const int d = tid + q * NT;
            float s = 0.f;
#pragma unroll
            for (int w = 0; w < 8; ++w) s += part[w * 1024 + d];
            y[q] = p.out[(size_t)tok * ND + d] + mod[b * 6144 + 5120 + d] * s;
            ss += y[q] * y[q];
        }
        ss = wave_sum(ss);
        if (lane == 0) red[wave] = ss;
        __syncthreads();
        float tot = 0.f;
#pragma unroll
        for (int w = 0; w < 8; ++w) tot += red[w];
        const float rstd = rsqrtf(tot * (1.f / ND) + EPS);
#pragma unroll
        for (int q = 0; q < 2; ++q) { const int d = tid + q * NT; p.out[(size_t)tok * ND + d] = y[q] * rstd * p.norm_f[d]; }
        __syncthreads();
    }
}

constexpr int LDS_BYTES = 157696;
__global__ void __launch_bounds__(NT) k_mega(Params p) {
    __shared__ __attribute__((aligned(16))) unsigned char lds[LDS_BYTES];
    cg::grid_group grid = cg::this_grid();
    mod_phase(p, (float*)lds);
    transpose_convert(p.w_in, (bf16_t*)(p.ws + WS_WIN), ND, NIN, (float*)lds);
    transpose_convert(p.w_out, (bf16_t*)(p.ws + WS_WOUT), ND, ND, (float*)lds);
    transpose_convert(p.wq, (bf16_t*)(p.ws + WS_WQ), ND, 2048, (float*)lds);
    convert_flat(p.keys, (bf16_t*)(p.ws + WS_KEYS), (size_t)8 * 2 * 128 * 128);
    convert_flat(p.pu, (bf16_t*)(p.ws + WS_U), (size_t)16384 * 1024);
    convert_flat(p.pv, (bf16_t*)(p.ws + WS_V), (size_t)16384 * 1024);
    grid.sync();
    prep_phase(p, 0);
    grid.sync();
    inproj_phase(p, lds);
#if DUP == 4
    inproj_phase(p, lds);
#endif
    grid.sync();
    {
        const bool split = gridDim.x >= 128;
        if (!split || blockIdx.x < 64) hg_chunk_phase(p, lds);
        if (!split || blockIdx.x >= 64) na_mfma_phase(p, (float*)lds, split ? blockIdx.x - 64 : blockIdx.x, split ? gridDim.x - 64 : gridDim.x);
    }
    grid.sync();
    hgmix_phase(p);
    grid.sync();
    outproj_phase(p, lds);
#if DUP == 4
    outproj_phase(p, lds);
#endif
    grid.sync();
    prep_phase(p, 1);
    grid.sync();
    pq_phase(p, lds);
#if DUP == 4
    pq_phase(p, lds);
#endif
    grid.sync();
    topk_phase(p, (float*)lds);
#if DUP == 3
    topk_phase(p, (float*)lds);
#endif
    grid.sync();
    gather_phase(p, (float*)lds);
}
}

extern "C" void kernel_launch(void* const* d_in, const int* in_sizes, int n_in, void* d_out, int out_size, void* d_ws, size_t ws_size, hipStream_t stream) {
    if (n_in != 18 || ws_size < WS_END) { fprintf(stderr, "kernel_launch: unexpected n_in %d / ws_size %zu\n", n_in, ws_size); return; }
    Params p{};
    p.x = (const float*)d_in[0]; p.c = (const float*)d_in[1]; p.ctx = (const float*)d_in[2]; p.c_ctx = (const float*)d_in[3];
    p.w_mod = (const float*)d_in[4]; p.b_mod = (const float*)d_in[5]; p.norm1 = (const float*)d_in[6]; p.norm2 = (const float*)d_in[7];
    p.w_in = (const float*)d_in[8]; p.w_out = (const float*)d_in[9]; p.rpb = (const float*)d_in[10]; p.hg_lb = (const float*)d_in[11];
    p.hg_norm = (const float*)d_in[12]; p.wq = (const float*)d_in[13]; p.keys = (const float*)d_in[14]; p.pu = (const float*)d_in[15];
    p.pv = (const float*)d_in[16]; p.norm_f = (const float*)d_in[17];
    p.out = (float*)d_out; p.ws = (unsigned char*)d_ws;
    static int grid_blocks = 0;
    if (!grid_blocks) {
        int dev = 0, cus = 0, per_cu = 0;
        hipGetDevice(&dev);
        hipDeviceGetAttribute(&cus, hipDeviceAttributeMultiprocessorCount, dev);
        hipOccupancyMaxActiveBlocksPerMultiprocessor(&per_cu, k_mega, NT, 0);
        if (per_cu < 1) { fprintf(stderr, "kernel_launch: occupancy query says %d blocks per CU\n", per_cu); per_cu = 1; }
        if (per_cu > 1) per_cu = 1;
        grid_blocks = cus * per_cu;
    }
    void* args[] = {&p};
    hipError_t e = hipLaunchCooperativeKernel((void*)k_mega, dim3(grid_blocks), dim3(NT), args, 0, stream);
    if (e != hipSuccess) fprintf(stderr, "cooperative launch failed: %s (grid %d)\n", hipGetErrorString(e), grid_blocks);
}
```

```cpp
#include <hip/hip_runtime.h>
#include <hip/hip_cooperative_groups.h>
#include <cstdint>
#include <cstdio>

typedef unsigned short bf16_t;
typedef short bf16x8 __attribute__((ext_vector_type(8)));
typedef float f32x4 __attribute__((ext_vector_type(4)));
typedef unsigned u32x4 __attribute__((ext_vector_type(4)));
typedef unsigned u32x2 __attribute__((ext_vector_type(2)));

namespace pg8 {
#define PG8_LAS __attribute__((address_space(3)))
typedef unsigned short bf16_t;
typedef short bf16x8 __attribute__((ext_vector_type(8)));
typedef float f32x4 __attribute__((ext_vector_type(4)));
typedef unsigned u32x4 __attribute__((ext_vector_type(4)));
constexpr int BM = 256, BK = 64, HALF = 128, HTB = HALF * BK * 2  , STAGE_BYTES = 8 * HTB, NXCD = 8, WGM = 8;

__host__ __device__ __forceinline__ int lds_byte(int r, int c) { const int st = (r >> 4) * 2 + (c >> 5), rr = r & 15, cc = c & 31, ob = rr * 64 + cc * 2; return st * 1024 + (ob ^ (((ob >> 9) & 1) << 5)); }
__host__ __device__ __forceinline__ void stage_rc(int b, int& R, int& C) { const int st = b / 1024, sb = b % 1024, swz = sb ^ (((sb >> 9) & 1) << 5); R = (st >> 1) * 16 + swz / 64; C = (st & 1) * 32 + (swz % 64) / 2; }
__host__ __device__ __forceinline__ int perm32(int rho) { const int n = rho >> 4, i = rho & 15; return 8 * (i >> 2) + 4 * n + (i & 3); }

struct Unit { int pm, pn; };
struct Gemm { const bf16_t* A; const bf16_t* Bt; int M, N, K; };

struct StaticOrder {
    int nM, nN, nwg, G, c;
    __host__ __device__ void init(int M, int N, int G_, int c_) { nM = M / BM; nN = N / BM; nwg = nM * nN; G = G_; c = c_; }
    __host__ __device__ bool next(int i, Unit& u) const {
        const long L = (long)i * G + c; if (L >= nwg) return false;
        int wgid = (int)L; { const int q = nwg / NXCD, r = nwg % NXCD, xcd = wgid % NXCD, off = wgid / NXCD; wgid = (xcd < r ? xcd * (q + 1) : r * (q + 1) + (xcd - r) * q) + off; }
        const int nig = WGM * nN, gid = wgid / nig, fm = gid * WGM, gsz = (nM - fm) < WGM ? (nM - fm) : WGM;
        u.pm = fm + ((wgid % nig) % gsz); u.pn = (wgid % nig) / gsz; return true;
    }
    __device__ __forceinline__ void a_ready(const Unit&) const {}
    __device__ __forceinline__ void done(const Unit&) const {}
};
__device__ __forceinline__ unsigned cvt_pk_bf16(float lo, float hi) { unsigned r; asm volatile("v_cvt_pk_bf16_f32 %0, %1, %2" : "=v"(r) : "v"(lo), "v"(hi)); return r; }
template <class Epi, class Sched, bool STAMP = false>
__device__ __forceinline__ void gemm_phase(PG8_LAS unsigned char* lds, const Gemm g, const Sched& S, const Epi& E, unsigned long long* stamps) {
    int tid_ = threadIdx.x; asm volatile("" : "+v"(tid_));
    const int tid = tid_, wid = __builtin_amdgcn_readfirstlane(tid >> 6), lane = tid & 63, wr = wid >> 2, wc = wid & 3, fr = lane & 15, fq = lane >> 4;
    const int K = g.K, nt = K / BK;
    int ts_lo = 0, ts_hi = 0, nts = 0; const unsigned long long rt_entry = STAMP ? (unsigned long long)wall_clock64() : 0ull;
#define PG8_STAMP() do { if (STAMP && wid == 0 && nts < 64) { const unsigned long long _c = (unsigned long long)clock64(); \
        ts_lo = (lane == nts) ? (int)(unsigned)_c : ts_lo; ts_hi = (lane == nts) ? (int)(unsigned)(_c >> 32) : ts_hi; ++nts; } } while (0)
    PG8_STAMP();
    unsigned voffA[2], voffB[2];
#pragma unroll
    for (int i = 0; i < 2; ++i) { int R, C; stage_rc(tid * 16 + i * 8192, R, C); const int Rb = Epi::PERM ? ((R & ~31) + perm32(R & 31)) : R;
        voffA[i] = (unsigned)(R * K + C) * 2u; voffB[i] = (unsigned)(Rb * K + C) * 2u; }
    const size_t kstep = (size_t)(BK * 2);
    const size_t hstep = (size_t)HALF * K * 2;
    const size_t tstep = 2 * hstep;
    const unsigned ldsw = (unsigned)wid * 1024u;
    const int aoff = lds_byte(wr * 64 + fr, fq * 8), boff = lds_byte(wc * 32 + fr, fq * 8);
#define PG8_SA(b, h) (((b) * 2 + (h)) * HTB)
#define PG8_SB(b, h) ((4 + (b) * 2 + (h)) * HTB)
#define PG8_STAGE(bufoff, gbase, voff) do { _Pragma("unroll") for (int _i = 0; _i < 2; ++_i) \
        __builtin_amdgcn_global_load_lds((const unsigned*)((const char*)(gbase) + (voff)[_i]), (PG8_LAS unsigned*)(lds + (bufoff) + ldsw + _i * 8192), 16, 0, 0); } while (0)
#define PG8_LDA(dst, b, h) do { _Pragma("unroll") for (int m = 0; m < 4; ++m) _Pragma("unroll") for (int k = 0; k < 2; ++k) dst[m][k] = *(const PG8_LAS bf16x8*)(lds + PG8_SA(b, h) + aoff + m * 2048 + k * 1024); } while (0)
#define PG8_LDB(dst, b, h) do { _Pragma("unroll") for (int n = 0; n < 2; ++n) _Pragma("unroll") for (int k = 0; k < 2; ++k) dst[n][k] = *(const PG8_LAS bf16x8*)(lds + PG8_SB(b, h) + boff + n * 2048 + k * 1024); } while (0)
#define PG8_MMA(ai, bj, At, Bt) do { __builtin_amdgcn_s_setprio(1); _Pragma("unroll") for (int m = 0; m < 4; ++m) _Pragma("unroll") for (int n = 0; n < 2; ++n) _Pragma("unroll") for (int k = 0; k < 2; ++k) \
        acc[ai][bj][m][n] = __builtin_amdgcn_mfma_f32_16x16x32_bf16(Bt[n][k], At[m][k], acc[ai][bj][m][n], 0, 0, 0); __builtin_amdgcn_s_setprio(0); } while (0)
#define PG8_WAIT_V(n) asm volatile("s_waitcnt vmcnt(" #n ")" ::: "memory")
#define PG8_WAIT_L(n) asm volatile("s_waitcnt lgkmcnt(" #n ")" ::: "memory")
#define PG8_BAR __builtin_amdgcn_s_barrier()
#define PG8_SCHED __builtin_amdgcn_sched_barrier(0)
    Unit cur, nxt; int ui = 0;
    if (!S.next(0, cur)) return;
    f32x4 acc[2][2][4][2];
#pragma unroll
    for (int a = 0; a < 2; ++a)
#pragma unroll
        for (int b = 0; b < 2; ++b)
#pragma unroll
            for (int m = 0; m < 4; ++m)
#pragma unroll
                for (int n = 0; n < 2; ++n) acc[a][b][m][n] = (f32x4){0.f, 0.f, 0.f, 0.f};
    bf16x8 At[4][2], B0[2][2], B1[2][2];
    const char* cA = (const char*)g.A + (size_t)cur.pm * tstep; const char* cB = (const char*)g.Bt + (size_t)cur.pn * tstep;
    S.a_ready(cur);
    PG8_STAGE(PG8_SB(0, 0), cB, voffB); PG8_STAGE(PG8_SA(0, 0), cA, voffA); PG8_STAGE(PG8_SB(0, 1), cB + hstep, voffB); PG8_STAGE(PG8_SA(0, 1), cA + hstep, voffA);
    if (wr == 1) PG8_BAR;
    PG8_WAIT_V(4); PG8_BAR;
    PG8_STAGE(PG8_SB(1, 0), cB + kstep, voffB); PG8_STAGE(PG8_SA(1, 0), cA + kstep, voffA); PG8_STAGE(PG8_SB(1, 1), cB + hstep + kstep, voffB);
    PG8_WAIT_V(6); PG8_BAR;
    PG8_STAMP();
    for (;;) {
        const bool has_next = S.next(ui + 1, nxt);
        const char* nA = has_next ? (const char*)g.A + (size_t)nxt.pm * tstep : cA; const char* nB = has_next ? (const char*)g.Bt + (size_t)nxt.pn * tstep : cB;
        for (int t = 0; t < nt; t += 2) {
            const bool last = (t == nt - 2);
            const char* a1 = cA + (size_t)(t + 1) * kstep;
            const char* a2 = last ? nA : cA + (size_t)(t + 2) * kstep; const char* b2 = last ? nB : cB + (size_t)(t + 2) * kstep;
            const char* a3 = a2 + kstep; const char* b3 = b2 + kstep;
            if (last && has_next) S.a_ready(nxt);
            PG8_LDB(B0, 0, 0); PG8_SCHED; PG8_LDA(At, 0, 0); PG8_STAGE(PG8_SA(1, 1), a1 + hstep, voffA);
            PG8_WAIT_L(8); PG8_BAR; PG8_WAIT_L(0); PG8_MMA(0, 0, At, B0); PG8_BAR; PG8_SCHED;
            PG8_LDB(B1, 0, 1); PG8_STAGE(PG8_SB(0, 0), b2, voffB);
            PG8_BAR; PG8_WAIT_L(0); PG8_MMA(0, 1, At, B1); PG8_BAR;
            PG8_LDA(At, 0, 1); PG8_STAGE(PG8_SA(0, 0), a2, voffA);
            PG8_BAR; PG8_WAIT_L(0); PG8_MMA(1, 0, At, B0); PG8_BAR; PG8_SCHED;
            PG8_STAGE(PG8_SB(0, 1), b2 + hstep, voffB);
            PG8_WAIT_V(6); PG8_BAR; PG8_MMA(1, 1, At, B1); PG8_BAR;
            PG8_LDB(B0, 1, 0); PG8_SCHED; PG8_LDA(At, 1, 0); PG8_STAGE(PG8_SA(0, 1), a2 + hstep, voffA);
            PG8_WAIT_L(8); PG8_BAR; PG8_WAIT_L(0); PG8_MMA(0, 0, At, B0); PG8_BAR; PG8_SCHED;
            PG8_LDB(B1, 1, 1); PG8_STAGE(PG8_SB(1, 0), b3, voffB);
            PG8_BAR; PG8_WAIT_L(0); PG8_MMA(0, 1, At, B1); PG8_BAR;
            PG8_LDA(At, 1, 1); PG8_STAGE(PG8_SA(1, 0), a3, voffA);
            PG8_BAR; PG8_WAIT_L(0); PG8_MMA(1, 0, At, B0); PG8_BAR; PG8_SCHED;
            PG8_STAGE(PG8_SB(1, 1), b3 + hstep, voffB);
            PG8_WAIT_V(6); PG8_BAR; PG8_MMA(1, 1, At, B1); PG8_BAR;
        }
        PG8_STAMP();
        if constexpr (!Epi::AFTER_DRAIN) { E(acc, cur, wr, wc, fr, fq); S.done(cur); }
        PG8_STAMP();
        if (!has_next) break;
#pragma unroll
        for (int a = 0; a < 2; ++a)
#pragma unroll
            for (int b = 0; b < 2; ++b)
#pragma unroll
                for (int m = 0; m < 4; ++m)
#pragma unroll
                    for (int n = 0; n < 2; ++n) acc[a][b][m][n] = (f32x4){0.f, 0.f, 0.f, 0.f};
        cur = nxt; cA = nA; cB = nB; ++ui;
    }
    PG8_WAIT_V(0);
    if (wr == 0) PG8_BAR;
    PG8_BAR;
    if constexpr (Epi::AFTER_DRAIN) { E.fused(acc, cur, wr, wc, fr, fq, lds, wid, lane); S.done(cur); }
    PG8_STAMP();
    if (STAMP && wid == 0) { stamps[lane] = lane < nts ? (((unsigned long long)(unsigned)ts_hi << 32) | (unsigned)ts_lo) : 0ull;
        if (lane == 62) stamps[62] = rt_entry; if (lane == 63) stamps[63] = (unsigned long long)wall_clock64(); }
#undef PG8_STAMP
#undef PG8_SA
#undef PG8_SB
#undef PG8_STAGE
#undef PG8_LDA
#undef PG8_LDB
#undef PG8_MMA
#undef PG8_WAIT_V
#undef PG8_WAIT_L
#undef PG8_BAR
#undef PG8_SCHED
}
}

#ifndef DUP
#define DUP 0
#endif
namespace cg = cooperative_groups;
namespace {
constexpr int NB = 8, NS = 2048, ND = 1024, NL = 256, GW = 64, NROWS = 32;
constexpr int MT = NB * NS;
constexpr int MC = NB * NL;
constexpr int MA = MT + MC;
constexpr int NIN = 4096;
constexpr int NT = 512;
constexpr float EPS = 1e-6f;

constexpr size_t MiB = 1ull << 20;
constexpr size_t WS_CTL = 0;
constexpr size_t WS_MOD = 64 * 1024;
constexpr size_t WS_LB = 320 * 1024;
constexpr size_t WS_KEYS = 512 * 1024;
constexpr size_t WS_WIN = 1 * MiB;
constexpr size_t WS_WOUT = 9 * MiB;
constexpr size_t WS_WQ = 11 * MiB;
constexpr size_t WS_U = 15 * MiB;
constexpr size_t WS_V = 47 * MiB;
constexpr size_t WS_XN = 79 * MiB;
constexpr size_t WS_NAQ = 115 * MiB;
constexpr size_t WS_NAK = 131 * MiB;
constexpr size_t WS_NAV = 149 * MiB;
constexpr size_t WS_HQ = 167 * MiB;
constexpr size_t WS_ZF = 183 * MiB;
constexpr size_t WS_ZB = 201 * MiB;
constexpr size_t WS_HI = 219 * MiB;
constexpr size_t WS_HG = 237 * MiB;
constexpr size_t WS_END = 253 * MiB;
constexpr size_t WS_PQ = 115 * MiB;
constexpr size_t WS_PIDX = 179 * MiB;
constexpr size_t WS_PG = 187 * MiB;

struct Params {
    const float* x; const float* c; const float* ctx; const float* c_ctx; const float* w_mod; const float* b_mod;
    const float* norm1; const float* norm2; const float* w_in; const float* w_out; const float* rpb; const float* hg_lb;
    const float* hg_norm; const float* wq; const float* keys; const float* pu; const float* pv; const float* norm_f;
    float* out; unsigned char* ws;
};

__device__ __forceinline__ bf16_t f2bf(float f) { unsigned u = __float_as_uint(f); u += 0x7fffu + ((u >> 16) & 1u); return (bf16_t)(u >> 16); }
__device__ __forceinline__ float bf2f(bf16_t h) { return __uint_as_float(((unsigned)h) << 16); }
__device__ __forceinline__ unsigned pack2(float lo, float hi) { return (unsigned)f2bf(lo) | ((unsigned)f2bf(hi) << 16); }
__device__ __forceinline__ float bflo(unsigned w) { return __uint_as_float(w << 16); }
__device__ __forceinline__ float bfhi(unsigned w) { return __uint_as_float(w & 0xffff0000u); }
__device__ __forceinline__ float silu_f(float v) { return v / (1.f + __expf(-v)); }
__device__ __forceinline__ float sigmoid_f(float v) { return 1.f / (1.f + __expf(-v)); }
__device__ __forceinline__ float wave_sum(float v) {
#pragma unroll
    for (int o = 32; o >= 1; o >>= 1) v += __shfl_xor(v, o);
    return v;
}

__device__ __forceinline__ void mod_phase(const Params& p, float* lds) {
    float* sc = lds;
    float* red = lds + 9 * 1024;
    const int tid = threadIdx.x;
    float* mod = (float*)(p.ws + WS_MOD);
    for (int i = tid; i < 9 * 1024; i += NT) {
        const int r = i >> 10, k = i & 1023;
        const float v = (r < 8) ? p.c[r * 1024 + k] : p.c_ctx[k];
        sc[i] = silu_f(v);
    }
    __syncthreads();
    const int col = tid & 63, ks = tid >> 6;
    for (int unit = blockIdx.x; unit < 6144 / 64; unit += gridDim.x) {
        const int j = unit * 64 + col;
        float acc[9];
#pragma unroll
        for (int r = 0; r < 9; ++r) acc[r] = 0.f;
        for (int k = ks * 128; k < ks * 128 + 128; ++k) {
            const float w = p.w_mod[(size_t)k * 6144 + j];
#pragma unroll
            for (int r = 0; r < 9; ++r) acc[r] += sc[r * 1024 + k] * w;
        }
#pragma unroll
        for (int r = 0; r < 9; ++r) red[(ks * 9 + r) * 64 + col] = acc[r];
        __syncthreads();
        for (int i = tid; i < 9 * 64; i += NT) {
            const int r = i >> 6, cc = i & 63;
            float s = 0.f;
#pragma unroll
            for (int q = 0; q < 8; ++q) s += red[(q * 9 + r) * 64 + cc];
            mod[r * 6144 + unit * 64 + cc] = s + p.b_mod[unit * 64 + cc];
        }
        __syncthreads();
    }
    float* lb = (float*)(p.ws + WS_LB);
    for (int i = blockIdx.x * NT + tid; i < 1024; i += gridDim.x * NT) {
        const float a0 = p.hg_lb[i], a1 = p.hg_lb[1024 + i];
        lb[i] = 1.f / (1.f + __expf(a1 - a0));
    }
}

__device__ __forceinline__ void transpose_convert(const float* W, bf16_t* Wt, int K, int N, float* lds) {
    const int tid = threadIdx.x;
    const int tk = K / 64, tn = N / 64;
    for (int unit = blockIdx.x; unit < tk * tn; unit += gridDim.x) {
        const int k0 = (unit / tn) * 64, n0 = (unit % tn) * 64;
        for (int i = tid; i < 64 * 64; i += NT) { const int r = i >> 6, cc = i & 63; lds[r * 65 + cc] = W[(size_t)(k0 + r) * N + n0 + cc]; }
        __syncthreads();
        for (int i = tid; i < 64 * 64; i += NT) { const int n = i >> 6, k = i & 63; Wt[(size_t)(n0 + n) * K + k0 + k] = f2bf(lds[k * 65 + n]); }
        __syncthreads();
    }
}
__device__ __forceinline__ void convert_flat(const float* src, bf16_t* dst, size_t n) {
    const size_t stride = (size_t)gridDim.x * NT * 4;
    for (size_t i = ((size_t)blockIdx.x * NT + threadIdx.x) * 4; i < n; i += stride) {
        const f32x4 v = *(const f32x4*)(src + i);
        u32x2 o; o.x = pack2(v[0], v[1]); o.y = pack2(v[2], v[3]);
        *(u32x2*)(dst + i) = o;
    }
}

__device__ __forceinline__ void convert_uv_fp8(const float* u, const float* v, unsigned char* uv) {
    const size_t nq = (size_t)16384 * 256;
    const size_t stride = (size_t)gridDim.x * NT;
    for (size_t i = (size_t)blockIdx.x * NT + threadIdx.x; i < 2 * nq; i += stride) {
        const bool isv = i >= nq; const size_t q = isv ? i - nq : i;
        const size_t e = q >> 8, c = q & 255;
        const f32x4 x = *(const f32x4*)((isv ? v : u) + q * 4) * (isv ? 8.f : 64.f);
        int w = 0;
        w = __builtin_amdgcn_cvt_pk_fp8_f32(x[0], x[1], w, false);
        w = __builtin_amdgcn_cvt_pk_fp8_f32(x[2], x[3], w, true);
        *(int*)(uv + e * 2048 + (isv ? 1024 : 0) + c * 4) = w;
    }
}

__device__ __forceinline__ void prep_phase(const Params& p, int which) {
    const int tid = threadIdx.x, lane = tid & 63, wave = tid >> 6;
    const float* mod = (const float*)(p.ws + WS_MOD);
    bf16_t* dst = (bf16_t*)(p.ws + WS_XN);
    const int nrows = which == 0 ? MA : MT;
    const float* g = which == 0 ? p.norm1 : p.norm2;
    for (int row = blockIdx.x * 8 + wave; row < nrows; row += gridDim.x * 8) {
        const float* src; int mr;
        if (which == 0) { if (row < MT) { src = p.x + (size_t)row * ND; mr = row / NS; } else { src = p.ctx + (size_t)(row - MT) * ND; mr = 8; } }
        else { src = p.out + (size_t)row * ND; mr = row / NS; }
        const float* sh = mod + mr * 6144 + (which == 0 ? 0 : 3072);
        const float* scl = mod + mr * 6144 + (which == 0 ? 1024 : 4096);
        f32x4 v[4]; float ss = 0.f;
#pragma unroll
        for (int i = 0; i < 4; ++i) { v[i] = *(const f32x4*)(src + i * 256 + lane * 4); ss += v[i][0] * v[i][0] + v[i][1] * v[i][1] + v[i][2] * v[i][2] + v[i][3] * v[i][3]; }
        ss = wave_sum(ss);
        const float rstd = rsqrtf(ss * (1.f / ND) + EPS);
#pragma unroll
        for (int i = 0; i < 4; ++i) {
            const int d = i * 256 + lane * 4;
            const f32x4 gg = *(const f32x4*)(g + d), s1 = *(const f32x4*)(sh + d), s2 = *(const f32x4*)(scl + d);
            float h[4];
#pragma unroll
            for (int e = 0; e < 4; ++e) h[e] = (v[i][e] * rstd * gg[e]) * (1.f + s2[e]) + s1[e];
            u32x2 o; o.x = pack2(h[0], h[1]); o.y = pack2(h[2], h[3]);
            *(u32x2*)(dst + (size_t)row * ND + d) = o;
        }
    }
}


struct InProjOrder {
    pg8::StaticOrder so; int G, c;
    __device__ void init(int G_, int c_) { so.init(MT, NIN, G_, c_); G = G_; c = c_; }
    __device__ bool next(int i, pg8::Unit& u) const {
        const long L = (long)i * G + c;
        if (L < 1024) return so.next(i, u);
        const int j = (int)(L - 1024); if (j >= 80) return false;
        const int q = j % 10; u.pm = 64 + j / 10; u.pn = q < 4 ? 2 + q : 4 + q;
        return true;
    }
    __device__ __forceinline__ void a_ready(const pg8::Unit&) const {}
    __device__ __forceinline__ void done(const pg8::Unit&) const {}
};
struct EpiInProj8 {
    static constexpr bool PERM = true, AFTER_DRAIN = false;
    unsigned char* ws;
    __device__ __forceinline__ void operator()(const f32x4 (&acc)[2][2][4][2], const pg8::Unit& u, int wr, int wc, int fr, int fq) const {
#pragma unroll
        for (int bj = 0; bj < 2; ++bj) {
            const int c0 = u.pn * 256 + bj * 128 + wc * 32 + 8 * fq, seg = c0 >> 9, c = c0 & 511;
#pragma unroll
            for (int ai = 0; ai < 2; ++ai)
#pragma unroll
                for (int m = 0; m < 4; ++m) {
                    const int row = u.pm * 256 + ai * 128 + wr * 64 + m * 16 + fr;
                    f32x4 v0 = acc[ai][bj][m][0], v1 = acc[ai][bj][m][1];
                    if (seg == 2) {
                        bf16_t* vt = (bf16_t*)(ws + WS_NAV); const int hh = c >> 6, dim = c & 63;
                        bf16_t* q; size_t st;
                        if (row < MT) { const int b = row >> 11, s = row & 2047; q = vt + ((size_t)((b * 8 + hh) * 64 + dim)) * 2048 + s; st = 2048; }
                        else { const int mm = row - MT, b = mm >> 8, j = mm & 255; q = vt + (size_t)MT * 512 + ((size_t)((b * 8 + hh) * 64 + dim)) * 256 + j; st = 256; }
#pragma unroll
                        for (int e = 0; e < 4; ++e) { q[e * st] = f2bf(v0[e]); q[(4 + e) * st] = f2bf(v1[e]); }
                    } else {
                        if (seg == 0) { v0 = v0 * 0.125f; v1 = v1 * 0.125f; }
                        if (seg == 3 || seg == 7) {
#pragma unroll
                            for (int e = 0; e < 4; ++e) { v0[e] = silu_f(v0[e]); v1[e] = silu_f(v1[e]); }
                        }
                        const size_t wsoff = seg == 0 ? WS_NAQ : seg == 1 ? WS_NAK : seg == 3 ? WS_HQ : seg == 4 ? WS_ZF : seg == 5 ? WS_ZB : seg == 6 ? WS_HI : WS_HG;
                        u32x4 w; w[0] = pack2(v0[0], v0[1]); w[1] = pack2(v0[2], v0[3]); w[2] = pack2(v1[0], v1[1]); w[3] = pack2(v1[2], v1[3]);
                        *(u32x4*)((bf16_t*)(ws + wsoff) + (size_t)row * 512 + c) = w;
                    }
                }
        }
    }
};
struct EpiOutProj8 {
    static constexpr bool PERM = false, AFTER_DRAIN = false;
    const float* x; const float* mod; float* out;
    __device__ __forceinline__ void operator()(const f32x4 (&acc)[2][2][4][2], const pg8::Unit& u, int wr, int wc, int fr, int fq) const {
        const int row0 = u.pm * 256 + wr * 64 + fr, col0 = u.pn * 256 + wc * 32 + 4 * fq;
        const int b = (u.pm * 256) / NS;
        f32x4 gv[2][2];
#pragma unroll
        for (int bj = 0; bj < 2; ++bj)
#pragma unroll
            for (int n = 0; n < 2; ++n) gv[bj][n] = *(const f32x4*)(mod + b * 6144 + 2048 + col0 + bj * 128 + n * 16);
#pragma unroll
        for (int ai = 0; ai < 2; ++ai)
#pragma unroll
            for (int m = 0; m < 4; ++m) {
                const size_t ro = (size_t)(row0 + ai * 128 + m * 16) * ND + col0;
#pragma unroll
                for (int bj = 0; bj < 2; ++bj)
#pragma unroll
                    for (int n = 0; n < 2; ++n) *(f32x4*)(out + ro + bj * 128 + n * 16) = *(const f32x4*)(x + ro + bj * 128 + n * 16) + gv[bj][n] * acc[ai][bj][m][n];
            }
    }
};
struct EpiPq8 {
    static constexpr bool PERM = true, AFTER_DRAIN = false;
    bf16_t* pq;
    __device__ __forceinline__ void operator()(const f32x4 (&acc)[2][2][4][2], const pg8::Unit& u, int wr, int wc, int fr, int fq) const {
#pragma unroll
        for (int ai = 0; ai < 2; ++ai)
#pragma unroll
            for (int m = 0; m < 4; ++m)
#pragma unroll
                for (int bj = 0; bj < 2; ++bj) {
                    const f32x4 v0 = acc[ai][bj][m][0], v1 = acc[ai][bj][m][1];
                    u32x4 w; w[0] = pack2(v0[0], v0[1]); w[1] = pack2(v0[2], v0[3]); w[2] = pack2(v1[0], v1[1]); w[3] = pack2(v1[2], v1[3]);
                    *(u32x4*)(pq + (size_t)(u.pm * 256 + ai * 128 + wr * 64 + m * 16 + fr) * 2048 + u.pn * 256 + bj * 128 + wc * 32 + 8 * fq) = w;
                }
    }
};
__device__ __forceinline__ void inproj8_phase(const Params& p, unsigned char* lds) {
    pg8::Gemm g{(const bf16_t*)(p.ws + WS_XN), (const bf16_t*)(p.ws + WS_WIN), MA, NIN, ND};
    InProjOrder S; S.init((int)gridDim.x, (int)blockIdx.x);
    EpiInProj8 E{p.ws};
    pg8::gemm_phase<EpiInProj8, InProjOrder>((PG8_LAS unsigned char*)lds, g, S, E, nullptr);
}
__device__ __forceinline__ void outproj8_phase(const Params& p, unsigned char* lds) {
    pg8::Gemm g{(const bf16_t*)(p.ws + WS_XN), (const bf16_t*)(p.ws + WS_WOUT), MT, ND, ND};
    pg8::StaticOrder S; S.init(MT, ND, (int)gridDim.x, (int)blockIdx.x);
    EpiOutProj8 E{p.x, (const float*)(p.ws + WS_MOD), p.out};
    pg8::gemm_phase<EpiOutProj8, pg8::StaticOrder>((PG8_LAS unsigned char*)lds, g, S, E, nullptr);
}
__device__ __forceinline__ void pq8_phase(const Params& p, unsigned char* lds) {
    pg8::Gemm g{(const bf16_t*)(p.ws + WS_XN), (const bf16_t*)(p.ws + WS_WQ), MT, 2048, ND};
    pg8::StaticOrder S; S.init(MT, 2048, (int)gridDim.x, (int)blockIdx.x);
    EpiPq8 E{(bf16_t*)(p.ws + WS_PQ)};
    pg8::gemm_phase<EpiPq8, pg8::StaticOrder>((PG8_LAS unsigned char*)lds, g, S, E, nullptr);
}

template <class Epi>
__device__ __forceinline__ void gemm_tile(const bf16_t* __restrict__ A, int lda, const bf16_t* __restrict__ Bt, int ldb, int K, int m0, int n0, unsigned char* lds, const Epi& epi) {
    unsigned char* As = lds; unsigned char* Bs = lds + 32768;
    const int tid = threadIdx.x, lane = tid & 63, wave = tid >> 6;
    const int wm = wave >> 1, wn = wave & 1;
    const int lr = tid >> 3, lc = tid & 7;
    const int fr = lane & 15, fq = lane >> 4;
    f32x4 acc[4][4];
#pragma unroll
    for (int i = 0; i < 4; ++i)
#pragma unroll
        for (int j = 0; j < 4; ++j) acc[i][j] = (f32x4){0.f, 0.f, 0.f, 0.f};
    u32x4 ra[4], rb[2];
    const bf16_t* Ap = A + (size_t)(m0 + lr) * lda + lc * 8;
    const bf16_t* Bp = Bt + (size_t)(n0 + lr) * ldb + lc * 8;
#pragma unroll
    for (int i = 0; i < 4; ++i) ra[i] = *(const u32x4*)(Ap + (size_t)(i * 64) * lda);
#pragma unroll
    for (int i = 0; i < 2; ++i) rb[i] = *(const u32x4*)(Bp + (size_t)(i * 64) * ldb);
    const int nkt = K / 64;
    for (int kt = 0; kt < nkt; ++kt) {
#pragma unroll
        for (int i = 0; i < 4; ++i) { const int r = lr + i * 64; *(u32x4*)(As + r * 128 + ((lc ^ (r & 7)) << 4)) = ra[i]; }
#pragma unroll
        for (int i = 0; i < 2; ++i) { const int r = lr + i * 64; *(u32x4*)(Bs + r * 128 + ((lc ^ (r & 7)) << 4)) = rb[i]; }
        __syncthreads();
        if (kt + 1 < nkt) {
            const int k0 = (kt + 1) * 64;
#pragma unroll
            for (int i = 0; i < 4; ++i) ra[i] = *(const u32x4*)(Ap + (size_t)(i * 64) * lda + k0);
#pragma unroll
            for (int i = 0; i < 2; ++i) rb[i] = *(const u32x4*)(Bp + (size_t)(i * 64) * ldb + k0);
        }
#pragma unroll
        for (int kk = 0; kk < 2; ++kk) {
            const int ch = kk * 4 + fq;
            bf16x8 fa[4], fb[4];
#pragma unroll
            for (int i = 0; i < 4; ++i) { const int r = wm * 64 + i * 16 + fr; fa[i] = *(const bf16x8*)(As + r * 128 + ((ch ^ (r & 7)) << 4)); }
#pragma unroll
            for (int j = 0; j < 4; ++j) { const int r = wn * 64 + j * 16 + fr; fb[j] = *(const bf16x8*)(Bs + r * 128 + ((ch ^ (r & 7)) << 4)); }
#pragma unroll
            for (int i = 0; i < 4; ++i)
#pragma unroll
                for (int j = 0; j < 4; ++j) acc[i][j] = __builtin_amdgcn_mfma_f32_16x16x32_bf16(fb[j], fa[i], acc[i][j], 0, 0, 0);
        }
        __syncthreads();
    }
#pragma unroll
    for (int i = 0; i < 4; ++i)
#pragma unroll
        for (int j = 0; j < 4; ++j) epi(m0 + wm * 64 + i * 16 + fr, n0 + wn * 64 + j * 16 + fq * 4, acc[i][j]);
}

__device__ __forceinline__ void store_bf16x4(bf16_t* dst, const f32x4& v) { u32x2 o; o.x = pack2(v[0], v[1]); o.y = pack2(v[2], v[3]); *(u32x2*)dst = o; }

struct EpiInProj {
    unsigned char* ws;
    __device__ __forceinline__ void operator()(int m, int n, const f32x4& v) const {
        const int seg = n >> 9, c = n & 511;
        const size_t o = (size_t)m * 512 + c;
        switch (seg) {
            case 0: { f32x4 s = v * 0.125f; store_bf16x4((bf16_t*)(ws + WS_NAQ) + o, s); break; }
            case 1: store_bf16x4((bf16_t*)(ws + WS_NAK) + o, v); break;
            case 2: {
                bf16_t* vt = (bf16_t*)(ws + WS_NAV); const int hh = c >> 6, dim = c & 63;
                if (m < MT) { const int b = m >> 11, s = m & 2047; bf16_t* q = vt + ((size_t)((b * 8 + hh) * 64 + dim)) * 2048 + s;
                    q[0] = f2bf(v[0]); q[2048] = f2bf(v[1]); q[4096] = f2bf(v[2]); q[6144] = f2bf(v[3]); }
                else { const int mm = m - MT, b = mm >> 8, j = mm & 255; bf16_t* q = vt + (size_t)MT * 512 + ((size_t)((b * 8 + hh) * 64 + dim)) * 256 + j;
                    q[0] = f2bf(v[0]); q[256] = f2bf(v[1]); q[512] = f2bf(v[2]); q[768] = f2bf(v[3]); }
                break; }
            case 3: { f32x4 s; s[0] = silu_f(v[0]); s[1] = silu_f(v[1]); s[2] = silu_f(v[2]); s[3] = silu_f(v[3]); store_bf16x4((bf16_t*)(ws + WS_HQ) + o, s); break; }
            case 4: store_bf16x4((bf16_t*)(ws + WS_ZF) + o, v); break;
            case 5: store_bf16x4((bf16_t*)(ws + WS_ZB) + o, v); break;
            case 6: store_bf16x4((bf16_t*)(ws + WS_HI) + o, v); break;
            default: { f32x4 s; s[0] = silu_f(v[0]); s[1] = silu_f(v[1]); s[2] = silu_f(v[2]); s[3] = silu_f(v[3]); store_bf16x4((bf16_t*)(ws + WS_HG) + o, s); break; }
        }
    }
};
__device__ __forceinline__ void inproj_phase(const Params& p, unsigned char* lds) {
    const bf16_t* A = (const bf16_t*)(p.ws + WS_XN); const bf16_t* Bt = (const bf16_t*)(p.ws + WS_WIN);
    EpiInProj epi{p.ws};
    const int nlat = 64 * 32, nctx = 8 * 20;
    for (int unit = blockIdx.x; unit < nlat + nctx; unit += gridDim.x) {
        int mt, nt;
        if (unit < nlat) { mt = unit >> 5; nt = unit & 31; }
        else { const int u = unit - nlat; mt = 64 + u / 20; const int q = u % 20; nt = q < 8 ? 4 + q : 16 + (q - 8); }
        gemm_tile(A, ND, Bt, ND, ND, mt * 256, nt * 128, lds, epi);
    }
}

struct EpiOutProj {
    const float* x; const float* mod; float* out;
    __device__ __forceinline__ void operator()(int m, int n, const f32x4& v) const {
        const int b = m / NS;
        const f32x4 xv = *(const f32x4*)(x + (size_t)m * ND + n), g = *(const f32x4*)(mod + b * 6144 + 2048 + n);
        *(f32x4*)(out + (size_t)m * ND + n) = xv + g * v;
    }
};
__device__ __forceinline__ void outproj_phase(const Params& p, unsigned char* lds) {
    const bf16_t* A = (const bf16_t*)(p.ws + WS_XN); const bf16_t* Bt = (const bf16_t*)(p.ws + WS_WOUT);
    EpiOutProj epi{p.x, (const float*)(p.ws + WS_MOD), p.out};
    for (int unit = blockIdx.x; unit < 64 * 8; unit += gridDim.x) gemm_tile(A, ND, Bt, ND, ND, (unit >> 3) * 256, (unit & 7) * 128, lds, epi);
}
struct EpiPq { bf16_t* pq; __device__ __forceinline__ void operator()(int m, int n, const f32x4& v) const { store_bf16x4(pq + (size_t)m * 2048 + n, v); } };
__device__ __forceinline__ void pq_phase(const Params& p, unsigned char* lds) {
    const bf16_t* A = (const bf16_t*)(p.ws + WS_XN); const bf16_t* Bt = (const bf16_t*)(p.ws + WS_WQ);
    EpiPq epi{(bf16_t*)(p.ws + WS_PQ)};
    for (int unit = blockIdx.x; unit < 64 * 16; unit += gridDim.x) gemm_tile(A, ND, Bt, ND, ND, (unit >> 4) * 256, (unit & 15) * 128, lds, epi);
}

__device__ __forceinline__ void na_naive_phase(const Params& p) {
    const bf16_t* Q = (const bf16_t*)(p.ws + WS_NAQ); const bf16_t* Kk = (const bf16_t*)(p.ws + WS_NAK); const bf16_t* V = (const bf16_t*)(p.ws + WS_NAV);
    bf16_t* mix = (bf16_t*)(p.ws + WS_XN);
    const int tid = threadIdx.x;
    for (int unit = blockIdx.x; unit < MT / 64; unit += gridDim.x) {
        const int tok = unit * 64 + (tid >> 3), h = tid & 7;
        const int b = tok / NS, s = tok % NS, r = s >> 6, qc = s & 63;
        const int rs = min(max(r - 4, 0), NROWS - 8), cs = min(max(qc - 8, 0), GW - 16);
        float q[64], o[64];
        {
            const u32x4* qp = (const u32x4*)(Q + (size_t)tok * 512 + h * 64);
#pragma unroll
            for (int i = 0; i < 8; ++i) { const u32x4 w = qp[i];
#pragma unroll
                for (int e = 0; e < 4; ++e) { q[i * 8 + e * 2] = bflo(w[e]); q[i * 8 + e * 2 + 1] = bfhi(w[e]); } }
        }
#pragma unroll
        for (int i = 0; i < 64; ++i) o[i] = 0.f;
        float mx = -1e30f, l = 0.f;
        for (int it = 0; it < 128 + 256; ++it) {
            int kt; float bias = 0.f;
            if (it < 128) { const int kr = it >> 4, kc = it & 15; kt = b * NS + (rs + kr) * 64 + cs + kc; bias = p.rpb[h * 15 * 31 + (rs + kr - r + 7) * 31 + (cs + kc - qc + 15)]; }
            else kt = MT + b * NL + (it - 128);
            const u32x4* kp = (const u32x4*)(Kk + (size_t)kt * 512 + h * 64);
            float d = 0.f;
#pragma unroll
            for (int i = 0; i < 8; ++i) { const u32x4 w = kp[i];
#pragma unroll
                for (int e = 0; e < 4; ++e) { d += q[i * 8 + e * 2] * bflo(w[e]); d += q[i * 8 + e * 2 + 1] * bfhi(w[e]); } }
            d += bias;
            const float mn = fmaxf(mx, d), sc = __expf(mx - mn), pe = __expf(d - mn);
            l = l * sc + pe; mx = mn;
            const u32x4* vp = (const u32x4*)(V + (size_t)kt * 512 + h * 64);
#pragma unroll
            for (int i = 0; i < 8; ++i) { const u32x4 w = vp[i];
#pragma unroll
                for (int e = 0; e < 4; ++e) { o[i * 8 + e * 2] = o[i * 8 + e * 2] * sc + pe * bflo(w[e]); o[i * 8 + e * 2 + 1] = o[i * 8 + e * 2 + 1] * sc + pe * bfhi(w[e]); } }
        }
        const float inv = 1.f / l;
        u32x4* op = (u32x4*)(mix + (size_t)tok * ND + h * 64);
#pragma unroll
        for (int i = 0; i < 8; ++i) { u32x4 w;
#pragma unroll
            for (int e = 0; e < 4; ++e) w[e] = pack2(o[i * 8 + e * 2] * inv, o[i * 8 + e * 2 + 1] * inv);
            op[i] = w; }
    }
}

__device__ __forceinline__ void na_mfma_phase(const Params& p, float* rpbL, int blk, int nblk) {
    const bf16_t* Q = (const bf16_t*)(p.ws + WS_NAQ); const bf16_t* Kk = (const bf16_t*)(p.ws + WS_NAK); const bf16_t* VT = (const bf16_t*)(p.ws + WS_NAV);
    bf16_t* mix = (bf16_t*)(p.ws + WS_XN);
    const int tid = threadIdx.x, lane = tid & 63, wave = tid >> 6, fr = lane & 15, fq = lane >> 4;
    for (int i = tid; i < 8 * 15 * 31; i += NT) rpbL[i] = p.rpb[i];
    __syncthreads();
    for (int bu = blk; bu < 1024; bu += nblk) {
        const int u = bu * 8 + wave;
        const int cb = u & 3, r = (u >> 2) & 31, h = (u >> 7) & 7, b = u >> 10;
        const int rs = min(max(r - 4, 0), NROWS - 8), kc0 = min(max(cb * 16 - 8, 0), GW - 32);
        const int qc = cb * 16 + fr, cs = min(max(qc - 8, 0), GW - 16);
        const size_t qtok = (size_t)b * NS + r * 64 + qc;
        const bf16x8 q0 = *(const bf16x8*)(Q + qtok * 512 + h * 64 + fq * 8), q1 = *(const bf16x8*)(Q + qtok * 512 + h * 64 + 32 + fq * 8);
        f32x4 o[4];
#pragma unroll
        for (int mt = 0; mt < 4; ++mt) o[mt] = (f32x4){0.f, 0.f, 0.f, 0.f};
        float mx = -1e30f, l = 0.f;
#pragma unroll 1
        for (int g = 0; g < 4; ++g) {
            const bool win = g < 2;
            f32x4 s[8];
#pragma unroll
            for (int tl = 0; tl < 8; ++tl) {
                const size_t kt = win ? (size_t)b * NS + (rs + g * 4 + (tl >> 1)) * 64 + kc0 + (tl & 1) * 16 + fr : (size_t)MT + b * NL + ((g - 2) * 8 + tl) * 16 + fr;
                const bf16x8 k0 = *(const bf16x8*)(Kk + kt * 512 + h * 64 + fq * 8), k1 = *(const bf16x8*)(Kk + kt * 512 + h * 64 + 32 + fq * 8);
                f32x4 acc = (f32x4){0.f, 0.f, 0.f, 0.f};
                acc = __builtin_amdgcn_mfma_f32_16x16x32_bf16(k0, q0, acc, 0, 0, 0);
                acc = __builtin_amdgcn_mfma_f32_16x16x32_bf16(k1, q1, acc, 0, 0, 0);
                s[tl] = acc;
            }
            if (win) {
#pragma unroll
                for (int tl = 0; tl < 8; ++tl) {
                    const int dr = rs + g * 4 + (tl >> 1) - r + 7;
#pragma unroll
                    for (int e = 0; e < 4; ++e) {
                        const int kcol = kc0 + (tl & 1) * 16 + fq * 4 + e;
                        const bool ok = (kcol >= cs) && (kcol < cs + 16);
                        const int dc = min(max(kcol - qc + 15, 0), 30);
                        s[tl][e] = ok ? s[tl][e] + rpbL[h * 465 + dr * 31 + dc] : -1e30f;
                    }
                }
            }
            float gm = -1e30f;
#pragma unroll
            for (int tl = 0; tl < 8; ++tl) gm = fmaxf(gm, fmaxf(fmaxf(s[tl][0], s[tl][1]), fmaxf(s[tl][2], s[tl][3])));
            gm = fmaxf(gm, __shfl_xor(gm, 16)); gm = fmaxf(gm, __shfl_xor(gm, 32));
            const float mn = fmaxf(mx, gm), sc = __expf(mx - mn);
            mx = mn;
            float ls = 0.f;
#pragma unroll
            for (int tl = 0; tl < 8; ++tl)
#pragma unroll
                for (int e = 0; e < 4; ++e) { const float pe = __expf(s[tl][e] - mn); s[tl][e] = pe; ls += pe; }
            l = l * sc + ls;
#pragma unroll
            for (int mt = 0; mt < 4; ++mt) o[mt] = o[mt] * sc;
#pragma unroll
            for (int pl = 0; pl < 4; ++pl) {
                u32x4 pw; pw[0] = pack2(s[2 * pl][0], s[2 * pl][1]); pw[1] = pack2(s[2 * pl][2], s[2 * pl][3]); pw[2] = pack2(s[2 * pl + 1][0], s[2 * pl + 1][1]); pw[3] = pack2(s[2 * pl + 1][2], s[2 * pl + 1][3]);
                const bf16x8 pf = __builtin_bit_cast(bf16x8, pw);
#pragma unroll
                for (int mt = 0; mt < 4; ++mt) {
                    const size_t drow = (size_t)((b * 8 + h) * 64 + mt * 16 + fr);
                    const bf16_t* vp = win ? VT + drow * 2048 + (rs + g * 4 + pl) * 64 + kc0 + fq * 4 : VT + (size_t)MT * 512 + drow * 256 + ((g - 2) * 4 + pl) * 32 + fq * 4;
                    const u32x2 va = *(const u32x2*)vp, vb = *(const u32x2*)(vp + 16);
                    u32x4 vw; vw[0] = va[0]; vw[1] = va[1]; vw[2] = vb[0]; vw[3] = vb[1];
                    o[mt] = __builtin_amdgcn_mfma_f32_16x16x32_bf16(__builtin_bit_cast(bf16x8, vw), pf, o[mt], 0, 0, 0);
                }
            }
        }
        l += __shfl_xor(l, 16); l += __shfl_xor(l, 32);
        const float inv = 1.f / l;
#pragma unroll
        for (int mt = 0; mt < 4; ++mt)
            *(u32x2*)(mix + qtok * ND + h * 64 + mt * 16 + fq * 4) = (u32x2){pack2(o[mt][0] * inv, o[mt][1] * inv), pack2(o[mt][2] * inv, o[mt][3] * inv)};
    }
}

__device__ __forceinline__ void hg_naive_phase(const Params& p) {
    const bf16_t* HQ = (const bf16_t*)(p.ws + WS_HQ); const bf16_t* HI = (const bf16_t*)(p.ws + WS_HI);
    const float* lbp = (const float*)(p.ws + WS_LB);
    const int tid = threadIdx.x, vl = tid >> 4, dsl = tid & 15;
    for (int unit = blockIdx.x; unit < NB * 4 * 2 * 4; unit += gridDim.x) {
        const int vs = unit & 3, dir = (unit >> 2) & 1, h = (unit >> 3) & 3, b = unit >> 5;
        const bf16_t* Z = (const bf16_t*)(p.ws + (dir ? WS_ZB : WS_ZF));
        float* O = p.out + (size_t)dir * MT * 512;
        const int v = vs * 32 + vl, d0 = dsl * 8;
        float lb[8], S[8];
#pragma unroll
        for (int e = 0; e < 8; ++e) { lb[e] = lbp[dir * 512 + h * 128 + d0 + e]; S[e] = 0.f; }
        for (int step = 0; step < NL + NS; ++step) {
            const bool isctx = step < NL;
            int t = isctx ? step : step - NL;
            if (dir) t = (isctx ? NL : NS) - 1 - t;
            const size_t row = isctx ? (size_t)MT + b * NL + t : (size_t)b * NS + t;
            const u32x4 zw = *(const u32x4*)(Z + row * 512 + h * 128 + d0);
            const float vv = bf2f(HI[row * 512 + h * 128 + v]);
            float z[8];
#pragma unroll
            for (int e = 0; e < 4; ++e) { z[e * 2] = bflo(zw[e]); z[e * 2 + 1] = bfhi(zw[e]); }
#pragma unroll
            for (int e = 0; e < 8; ++e) { const float f = lb[e] + (1.f - lb[e]) * sigmoid_f(z[e]); S[e] = f * S[e] + (1.f - f) * vv; }
            if (!isctx) {
                const u32x4 qw = *(const u32x4*)(HQ + row * 512 + h * 128 + d0);
                float acc = 0.f;
#pragma unroll
                for (int e = 0; e < 4; ++e) { acc += bflo(qw[e]) * S[e * 2]; acc += bfhi(qw[e]) * S[e * 2 + 1]; }
                acc += __shfl_xor(acc, 1); acc += __shfl_xor(acc, 2); acc += __shfl_xor(acc, 4); acc += __shfl_xor(acc, 8);
                if (dsl == 0) O[row * 512 + h * 128 + v] = acc;
            }
        }
    }
}

__device__ __forceinline__ int swz8(int row) { return ((row >> 3) ^ row) & 7; }
__device__ __forceinline__ bf16x8 ld256(const unsigned char* base, int row, int ch) { return *(const bf16x8*)(base + row * 256 + (((ch ^ row) & 15) << 4)); }
__device__ __forceinline__ bf16x8 ld128(const unsigned char* base, int row, int ch) { return *(const bf16x8*)(base + row * 128 + ((ch ^ swz8(row)) << 4)); }
constexpr int HG_LDS = 157696;
__device__ __forceinline__ size_t hg_row(int ci, int t, int b, int dir) {
    const bool isctx = ci < 4; const int lc = isctx ? ci : ci - 4, T = isctx ? NL : NS; const size_t base = isctx ? (size_t)MT + b * NL : (size_t)b * NS;
    const int pos = lc * 64 + t; return dir ? base + T - 1 - pos : base + pos;
}
__device__ __forceinline__ void hg_chain(const Params& p, unsigned char* lds, int unit) {
    const int tid = threadIdx.x, lane = tid & 63, wave = tid >> 6, fr = lane & 15, fq = lane >> 4;
    const int dir = unit & 1, h = (unit >> 1) & 3, b = unit >> 3;
    float* BF = (float*)lds;
    unsigned char* QT = lds + 32768;
    unsigned char* QH = lds + 49152;
    unsigned char* KT = lds + 65536;
    unsigned char* KBT = lds + 81920;
    unsigned char* VT = lds + 98304;
    unsigned char* PP = lds + 114688;
    unsigned char* SB = lds + 122880;
    float* TOT = (float*)(lds + 155648);
    const bf16_t* HQ = (const bf16_t*)(p.ws + WS_HQ); const bf16_t* HI = (const bf16_t*)(p.ws + WS_HI);
    const bf16_t* Z = (const bf16_t*)(p.ws + (dir ? WS_ZB : WS_ZF));
    const float* lbp = (const float*)(p.ws + WS_LB) + dir * 512 + h * 128;
    float* O = p.out + (size_t)dir * MT * 512;
    const int bt = tid >> 3, bg = tid & 7;
    float lbv[16];
#pragma unroll
    for (int e = 0; e < 8; ++e) { lbv[e] = lbp[bg * 8 + e]; lbv[8 + e] = lbp[64 + bg * 8 + e]; }
    for (int i = tid; i < (8192 + 32768) / 16; i += NT) *(u32x4*)(PP + i * 16) = (u32x4){0u, 0u, 0u, 0u};
    f32x4 accS[8];
#pragma unroll
    for (int i = 0; i < 8; ++i) accS[i] = (f32x4){0.f, 0.f, 0.f, 0.f};
    u32x4 zr[2], qr[2], vr[2];
    {
        const size_t r = hg_row(0, bt, b, dir);
#pragma unroll
        for (int g = 0; g < 2; ++g) { const size_t o = r * 512 + h * 128 + g * 64 + bg * 8; zr[g] = *(const u32x4*)(Z + o); vr[g] = *(const u32x4*)(HI + o); qr[g] = (u32x4){0u, 0u, 0u, 0u}; }
    }
    __syncthreads();
    for (int ci = 0; ci < 36; ++ci) {
        const bool isctx = ci < 4;
        float kf[16], qf[16];
#pragma unroll
        for (int g = 0; g < 2; ++g) {
            float lf[8];
#pragma unroll
            for (int e = 0; e < 8; ++e) {
                const unsigned zw = zr[g][e >> 1], qw = qr[g][e >> 1], vw = vr[g][e >> 1];
                const float z = (e & 1) ? bfhi(zw) : bflo(zw);
                const float l = lbv[g * 8 + e], f = l + (1.f - l) * sigmoid_f(z);
                lf[e] = __logf(f); kf[g * 8 + e] = 1.f - f;
                qf[g * 8 + e] = (e & 1) ? bfhi(qw) : bflo(qw);
                const int vd = g * 64 + bg * 8 + e;
                *(bf16_t*)(VT + vd * 128 + ((((bt >> 3) ^ swz8(vd)) & 7) << 4) + (bt & 7) * 2) = (bf16_t)((e & 1) ? (vw >> 16) : (vw & 0xffffu));
            }
            *(f32x4*)(BF + bt * 128 + g * 64 + bg * 8) = (f32x4){lf[0], lf[1], lf[2], lf[3]};
            *(f32x4*)(BF + bt * 128 + g * 64 + bg * 8 + 4) = (f32x4){lf[4], lf[5], lf[6], lf[7]};
        }
        __syncthreads();
        {
            const int d = tid & 127, I = tid >> 7;
            float s = 0.f;
#pragma unroll
            for (int j = 0; j < 16; ++j) { s += BF[(I * 16 + j) * 128 + d]; BF[(I * 16 + j) * 128 + d] = s; }
            TOT[I * 128 + d] = s;
        }
        __syncthreads();
#pragma unroll
        for (int g = 0; g < 2; ++g) {
            const int d0 = g * 64 + bg * 8;
            float bl[8], t0[8], t1[8], t2[8], b31[8];
#pragma unroll
            for (int q4 = 0; q4 < 2; ++q4) {
                const f32x4 a = *(const f32x4*)(BF + bt * 128 + d0 + q4 * 4), x0 = *(const f32x4*)(TOT + d0 + q4 * 4), x1 = *(const f32x4*)(TOT + 128 + d0 + q4 * 4),
                            x2 = *(const f32x4*)(TOT + 256 + d0 + q4 * 4), m = *(const f32x4*)(BF + 31 * 128 + d0 + q4 * 4);
#pragma unroll
                for (int e = 0; e < 4; ++e) { bl[q4 * 4 + e] = a[e]; t0[q4 * 4 + e] = x0[e]; t1[q4 * 4 + e] = x1[e]; t2[q4 * 4 + e] = x2[e]; b31[q4 * 4 + e] = m[e]; }
            }
            const int I = bt >> 4;
            float vq[8], vh[8], vk[8];
#pragma unroll
            for (int e = 0; e < 8; ++e) {
                const float off = (I > 0 ? t0[e] : 0.f) + (I > 1 ? t1[e] : 0.f) + (I > 2 ? t2[e] : 0.f);
                const float bte = bl[e] + off, bmid = b31[e] + t0[e];
                const float x = fminf(fmaxf(bte - bmid, -80.f), 80.f);
                const float E = __expf(x), Ei = __expf(-x);
                vq[e] = qf[g * 8 + e] * E; vh[e] = qf[g * 8 + e] * __expf(bte); vk[e] = kf[g * 8 + e] * Ei;
            }
            const int so = bt * 256 + ((((d0 >> 3) ^ bt) & 15) << 4);
            *(u32x4*)(QT + so) = (u32x4){pack2(vq[0], vq[1]), pack2(vq[2], vq[3]), pack2(vq[4], vq[5]), pack2(vq[6], vq[7])};
            *(u32x4*)(QH + so) = (u32x4){pack2(vh[0], vh[1]), pack2(vh[2], vh[3]), pack2(vh[4], vh[5]), pack2(vh[6], vh[7])};
            *(u32x4*)(KT + so) = (u32x4){pack2(vk[0], vk[1]), pack2(vk[2], vk[3]), pack2(vk[4], vk[5]), pack2(vk[6], vk[7])};
        }
        if (ci + 1 < 36) {
            const size_t r = hg_row(ci + 1, bt, b, dir); const bool nctx = (ci + 1) < 4;
#pragma unroll
            for (int g = 0; g < 2; ++g) { const size_t o = r * 512 + h * 128 + g * 64 + bg * 8; zr[g] = *(const u32x4*)(Z + o); vr[g] = *(const u32x4*)(HI + o);
                qr[g] = nctx ? (u32x4){0u, 0u, 0u, 0u} : *(const u32x4*)(HQ + o); }
        }
        __syncthreads();
        if (!isctx) {
            int frA = fr, fqA = fq; asm volatile("" : "+v"(frA), "+v"(fqA));
            for (int n = wave; n < 10; n += 8) {
                const int I = n >= 6 ? 3 : n >= 3 ? 2 : n >= 1 ? 1 : 0, J = n - (I * (I + 1)) / 2;
                f32x4 acc = (f32x4){0.f, 0.f, 0.f, 0.f};
#pragma unroll
                for (int kd = 0; kd < 4; ++kd) acc = __builtin_amdgcn_mfma_f32_16x16x32_bf16(ld256(KT, J * 16 + frA, kd * 4 + fqA), ld256(QT, I * 16 + frA, kd * 4 + fqA), acc, 0, 0, 0);
                if (I == J) {
#pragma unroll
                    for (int e = 0; e < 4; ++e) if (fqA * 4 + e > frA) acc[e] = 0.f;
                }
                const int t = I * 16 + frA;
                *(u32x2*)(PP + t * 128 + ((((J * 2 + (fqA >> 1)) ^ swz8(t)) & 7) << 4) + (fqA & 1) * 8) = (u32x2){pack2(acc[0], acc[1]), pack2(acc[2], acc[3])};
            }
        }
        {
            const int d = tid & 127, sg = tid >> 7;
            const float c2 = __expf(BF[63 * 128 + d] + TOT[128 + d] + TOT[256 + d] - BF[31 * 128 + d]);
            float kv[16];
#pragma unroll
            for (int j = 0; j < 16; ++j) { const int s = sg * 16 + j; kv[j] = bf2f(*(const bf16_t*)(KT + s * 256 + ((((d >> 3) ^ s) & 15) << 4) + (d & 7) * 2)) * c2; }
            const int sw = swz8(d);
            *(u32x4*)(KBT + d * 128 + ((((sg * 2) ^ sw) & 7) << 4)) = (u32x4){pack2(kv[0], kv[1]), pack2(kv[2], kv[3]), pack2(kv[4], kv[5]), pack2(kv[6], kv[7])};
            *(u32x4*)(KBT + d * 128 + ((((sg * 2 + 1) ^ sw) & 7) << 4)) = (u32x4){pack2(kv[8], kv[9]), pack2(kv[10], kv[11]), pack2(kv[12], kv[13]), pack2(kv[14], kv[15])};
        }
        __syncthreads();
        if (!isctx) {
            int frB = fr, fqB = fq; asm volatile("" : "+v"(frB), "+v"(fqB));
            f32x4 acc[4];
#pragma unroll
            for (int tt = 0; tt < 4; ++tt) acc[tt] = (f32x4){0.f, 0.f, 0.f, 0.f};
#pragma unroll
            for (int kd = 0; kd < 4; ++kd) {
                const bf16x8 a = ld256(SB, wave * 16 + frB, kd * 4 + fqB);
#pragma unroll
                for (int tt = 0; tt < 4; ++tt) acc[tt] = __builtin_amdgcn_mfma_f32_16x16x32_bf16(a, ld256(QH, tt * 16 + frB, kd * 4 + fqB), acc[tt], 0, 0, 0);
            }
#pragma unroll
            for (int ks = 0; ks < 2; ++ks) {
                const bf16x8 a = ld128(VT, wave * 16 + frB, ks * 4 + fqB);
#pragma unroll
                for (int tt = 0; tt < 4; ++tt) acc[tt] = __builtin_amdgcn_mfma_f32_16x16x32_bf16(a, ld128(PP, tt * 16 + frB, ks * 4 + fqB), acc[tt], 0, 0, 0);
            }
#pragma unroll
            for (int tt = 0; tt < 4; ++tt) *(f32x4*)(O + hg_row(ci, tt * 16 + frB, b, dir) * 512 + h * 128 + wave * 16 + fqB * 4) = acc[tt];
        }
        int frC = fr, fqC = fq; asm volatile("" : "+v"(frC), "+v"(fqC));
        {
            const int d4 = wave * 16 + fqC * 4;
            const f32x4 l63 = *(const f32x4*)(BF + 63 * 128 + d4), x0 = *(const f32x4*)(TOT + d4), x1 = *(const f32x4*)(TOT + 128 + d4), x2 = *(const f32x4*)(TOT + 256 + d4);
            f32x4 c3;
#pragma unroll
            for (int e = 0; e < 4; ++e) c3[e] = __expf(l63[e] + x0[e] + x1[e] + x2[e]);
            const bf16x8 a0 = ld128(KBT, wave * 16 + frC, fqC), a1 = ld128(KBT, wave * 16 + frC, 4 + fqC);
#pragma unroll
            for (int vt = 0; vt < 8; ++vt) {
                accS[vt] = accS[vt] * c3;
                accS[vt] = __builtin_amdgcn_mfma_f32_16x16x32_bf16(a0, ld128(VT, vt * 16 + frC, fqC), accS[vt], 0, 0, 0);
                accS[vt] = __builtin_amdgcn_mfma_f32_16x16x32_bf16(a1, ld128(VT, vt * 16 + frC, 4 + fqC), accS[vt], 0, 0, 0);
            }
        }
        __syncthreads();
#pragma unroll
        for (int vt = 0; vt < 8; ++vt) {
            const int row = vt * 16 + frC;
            *(u32x2*)(SB + row * 256 + ((((wave * 2 + (fqC >> 1)) ^ row) & 15) << 4) + (fqC & 1) * 8) = (u32x2){pack2(accS[vt][0], accS[vt][1]), pack2(accS[vt][2], accS[vt][3])};
        }
    }
    __syncthreads();
}
__device__ __forceinline__ void hg_chunk_phase(const Params& p, unsigned char* lds) {
    for (int unit = blockIdx.x; unit < 64; unit += gridDim.x) hg_chain(p, lds, unit);
}

__device__ __forceinline__ void hgmix_phase(const Params& p) {
    const float* OF = p.out; const float* OB = p.out + (size_t)MT * 512;
    const bf16_t* HG = (const bf16_t*)(p.ws + WS_HG);
    bf16_t* mix = (bf16_t*)(p.ws + WS_XN);
    const int tid = threadIdx.x, lane = tid & 63, wave = tid >> 6;
    for (int row = blockIdx.x * 8 + wave; row < MT; row += gridDim.x * 8) {
        const int c0 = lane * 8;
        float o[8]; float ss = 0.f;
        const f32x4 a0 = *(const f32x4*)(OF + (size_t)row * 512 + c0), a1 = *(const f32x4*)(OF + (size_t)row * 512 + c0 + 4);
        const f32x4 b0 = *(const f32x4*)(OB + (size_t)row * 512 + c0), b1 = *(const f32x4*)(OB + (size_t)row * 512 + c0 + 4);
#pragma unroll
        for (int e = 0; e < 4; ++e) { o[e] = a0[e] + b0[e]; o[4 + e] = a1[e] + b1[e]; }
#pragma unroll
        for (int e = 0; e < 8; ++e) ss += o[e] * o[e];
        ss += __shfl_xor(ss, 1); ss += __shfl_xor(ss, 2); ss += __shfl_xor(ss, 4); ss += __shfl_xor(ss, 8);
        const float rstd = rsqrtf(ss * (1.f / 128.f) + EPS);
        const u32x4 gw = *(const u32x4*)(HG + (size_t)row * 512 + c0);
        float r[8];
#pragma unroll
        for (int e = 0; e < 4; ++e) { r[e * 2] = o[e * 2] * rstd * p.hg_norm[c0 + e * 2] * bflo(gw[e]); r[e * 2 + 1] = o[e * 2 + 1] * rstd * p.hg_norm[c0 + e * 2 + 1] * bfhi(gw[e]); }
        u32x4 w; w[0] = pack2(r[0], r[1]); w[1] = pack2(r[2], r[3]); w[2] = pack2(r[4], r[5]); w[3] = pack2(r[6], r[7]);
        *(u32x4*)(mix + (size_t)row * ND + 512 + c0) = w;
    }
}

__device__ __forceinline__ void wave_argmax(float& v, int& i) {
#pragma unroll
    for (int o = 32; o >= 1; o >>= 1) { const float ov = __shfl_xor(v, o); const int oi = __shfl_xor(i, o); if (ov > v || (ov == v && oi < i)) { v = ov; i = oi; } }
}
__device__ __forceinline__ unsigned ukey(float f) { const unsigned u = __float_as_uint(f); return (u & 0x80000000u) ? ~u : (u | 0x80000000u); }
__device__ __forceinline__ float ukey_inv(unsigned u) { return __uint_as_float((u & 0x80000000u) ? (u & 0x7fffffffu) : ~u); }
__device__ __forceinline__ int mbcnt64(unsigned long long m) { return (int)__builtin_amdgcn_mbcnt_hi((unsigned)(m >> 32), __builtin_amdgcn_mbcnt_lo((unsigned)m, 0u)); }
__device__ __forceinline__ void topk_phase(const Params& p, float* lds) {
    constexpr int LDW = 260;
    float* wsv = lds + 64 * LDW + (threadIdx.x >> 6) * 64;
    int* wsi = (int*)(wsv + 32);
    const bf16_t* PQ = (const bf16_t*)(p.ws + WS_PQ); const bf16_t* KEYS = (const bf16_t*)(p.ws + WS_KEYS);
    int* PIDX = (int*)(p.ws + WS_PIDX); float* PG = (float*)(p.ws + WS_PG);
    const int tid = threadIdx.x, lane = tid & 63, wave = tid >> 6, fr = lane & 15, fq = lane >> 4;
    for (int unit = blockIdx.x; unit < (MT / 64) * 8; unit += gridDim.x) {
        const int hp = unit & 7, t0 = (unit >> 3) * 64;
        {
            const int c = wave >> 2, kb = (wave & 3) * 32;
            f32x4 acc[4][2];
#pragma unroll
            for (int i = 0; i < 4; ++i) { acc[i][0] = (f32x4){0.f, 0.f, 0.f, 0.f}; acc[i][1] = (f32x4){0.f, 0.f, 0.f, 0.f}; }
#pragma unroll
            for (int ks = 0; ks < 4; ++ks) {
                bf16x8 fa[4], fb[2];
#pragma unroll
                for (int i = 0; i < 4; ++i) fa[i] = *(const bf16x8*)(PQ + (size_t)(t0 + i * 16 + fr) * 2048 + hp * 256 + c * 128 + ks * 32 + fq * 8);
#pragma unroll
                for (int j = 0; j < 2; ++j) fb[j] = *(const bf16x8*)(KEYS + (size_t)((hp * 2 + c) * 128 + kb + j * 16 + fr) * 128 + ks * 32 + fq * 8);
#pragma unroll
                for (int i = 0; i < 4; ++i)
#pragma unroll
                    for (int j = 0; j < 2; ++j) acc[i][j] = __builtin_amdgcn_mfma_f32_16x16x32_bf16(fa[i], fb[j], acc[i][j], 0, 0, 0);
            }
#pragma unroll
            for (int i = 0; i < 4; ++i)
#pragma unroll
                for (int j = 0; j < 2; ++j)
#pragma unroll
                    for (int e = 0; e < 4; ++e) lds[(i * 16 + fq * 4 + e) * LDW + c * 128 + kb + j * 16 + fr] = acc[i][j][e];
        }
        __syncthreads();
        for (int tt = 0; tt < 8; ++tt) {
            const int tl = wave * 8 + tt;
            const float* row = lds + tl * LDW;
            float a[2][2]; unsigned k[2][2];
#pragma unroll
            for (int c = 0; c < 2; ++c) {
                a[c][0] = row[c * 128 + lane]; a[c][1] = row[c * 128 + 64 + lane];
                k[c][0] = (ukey(a[c][0]) & ~127u) | (unsigned)(127 - lane);
                k[c][1] = (ukey(a[c][1]) & ~127u) | (unsigned)(63 - lane);
            }
            unsigned lo0 = 0u, hi0 = 0xffffffffu, lo1 = 0u, hi1 = 0xffffffffu, T0 = 0u, T1 = 0u; bool d0 = false, d1 = false;
            for (int it = 0; it < 40; ++it) {
                const unsigned m0 = lo0 + ((hi0 - lo0) >> 1), m1 = lo1 + ((hi1 - lo1) >> 1);
                const int c0 = __popcll(__ballot(k[0][0] >= m0)) + __popcll(__ballot(k[0][1] >= m0));
                const int c1 = __popcll(__ballot(k[1][0] >= m1)) + __popcll(__ballot(k[1][1] >= m1));
                if (!d0) { if (c0 == 16) { d0 = true; T0 = m0; } else if (c0 > 16) lo0 = m0; else hi0 = m0; }
                if (!d1) { if (c1 == 16) { d1 = true; T1 = m1; } else if (c1 > 16) lo1 = m1; else hi1 = m1; }
                if (d0 && d1) break;
            }
            if (!d0) T0 = hi0;
            if (!d1) T1 = hi1;
#pragma unroll
            for (int c = 0; c < 2; ++c) {
                const unsigned T = c ? T1 : T0;
                const bool f0 = k[c][0] >= T, f1 = k[c][1] >= T;
                const unsigned long long b0 = __ballot(f0), b1 = __ballot(f1);
                const int s0 = mbcnt64(b0), s1 = __popcll(b0) + mbcnt64(b1);
                if (f0 && s0 < 16) { wsv[c * 16 + s0] = a[c][0]; wsi[c * 16 + s0] = lane; }
                if (f1 && s1 < 16) { wsv[c * 16 + s1] = a[c][1]; wsi[c * 16 + s1] = lane + 64; }
            }
            const float s1v = wsv[lane >> 2]; const int i1 = wsi[lane >> 2];
            const f32x4 s2v = *(const f32x4*)(wsv + 16 + (lane & 3) * 4);
            float cv[4]; unsigned ck[4];
#pragma unroll
            for (int e = 0; e < 4; ++e) { cv[e] = s1v + s2v[e]; ck[e] = (ukey(cv[e]) & ~255u) | (unsigned)(255 - (lane * 4 + e)); }
            unsigned lo = 0u, hi = 0xffffffffu, T = 0u; bool dn = false;
            for (int it = 0; it < 40; ++it) {
                const unsigned m = lo + ((hi - lo) >> 1);
                int c = 0;
#pragma unroll
                for (int e = 0; e < 4; ++e) c += __popcll(__ballot(ck[e] >= m));
                if (c == 16) { dn = true; T = m; break; } else if (c > 16) lo = m; else hi = m;
            }
            if (!dn) T = hi;
            const float Tf = ukey_inv(T & ~255u);
            float ex[4]; float es = 0.f;
#pragma unroll
            for (int e = 0; e < 4; ++e) { ex[e] = (ck[e] >= T) ? __expf(cv[e] - Tf) : 0.f; es += ex[e]; }
            const float inv = 1.f / wave_sum(es);
            const size_t o = ((size_t)(t0 + tl) * 8 + hp) * 16;
            int base = 0;
#pragma unroll
            for (int e = 0; e < 4; ++e) {
                const bool f = ck[e] >= T;
                const unsigned long long bm = __ballot(f);
                const int slot = base + mbcnt64(bm);
                if (f && slot < 16) { PIDX[o + slot] = i1 * 128 + wsi[16 + (lane & 3) * 4 + e]; PG[o + slot] = ex[e] * inv; }
                base += __popcll(bm);
            }
        }
        __syncthreads();
    }
}

__device__ __forceinline__ void ins16(unsigned (&t)[16], unsigned x) {
#pragma unroll
    for (int k = 0; k < 16; ++k) { const unsigned hi = max(t[k], x); x = min(t[k], x); t[k] = hi; }
}
__device__ __forceinline__ void topk3_phase(const Params& p, float* lds) {
    constexpr int LDW = 260;
    const bf16_t* PQ = (const bf16_t*)(p.ws + WS_PQ); const bf16_t* KEYS = (const bf16_t*)(p.ws + WS_KEYS);
    int* PIDX = (int*)(p.ws + WS_PIDX); float* PG = (float*)(p.ws + WS_PG);
    int* tab = (int*)(lds + 128 * LDW);
    const int tid = threadIdx.x, lane = tid & 63, wave = tid >> 6, fr = lane & 15, fq = lane >> 4;
    for (int unit = blockIdx.x; unit < (MT / 64) * 4; unit += gridDim.x) {
        const int hp2 = unit & 3, t0 = (unit >> 2) * 64;
        {
            const int hs = wave >> 2, c = (wave >> 1) & 1, kb = (wave & 1) * 64, hp = hp2 * 2 + hs;
            f32x4 acc[4][4];
#pragma unroll
            for (int i = 0; i < 4; ++i)
#pragma unroll
                for (int j = 0; j < 4; ++j) acc[i][j] = (f32x4){0.f, 0.f, 0.f, 0.f};
#pragma unroll
            for (int ks = 0; ks < 4; ++ks) {
                bf16x8 fa[4], fb[4];
#pragma unroll
                for (int i = 0; i < 4; ++i) fa[i] = *(const bf16x8*)(PQ + (size_t)(t0 + i * 16 + fr) * 2048 + hp * 256 + c * 128 + ks * 32 + fq * 8);
#pragma unroll
                for (int j = 0; j < 4; ++j) fb[j] = *(const bf16x8*)(KEYS + (size_t)((hp * 2 + c) * 128 + kb + j * 16 + fr) * 128 + ks * 32 + fq * 8);
#pragma unroll
                for (int i = 0; i < 4; ++i)
#pragma unroll
                    for (int j = 0; j < 4; ++j) acc[i][j] = __builtin_amdgcn_mfma_f32_16x16x32_bf16(fa[i], fb[j], acc[i][j], 0, 0, 0);
            }
#pragma unroll
            for (int i = 0; i < 4; ++i)
#pragma unroll
                for (int j = 0; j < 4; ++j)
#pragma unroll
                    for (int e = 0; e < 4; ++e) lds[(hs * 64 + i * 16 + fq * 4 + e) * LDW + (c * 2 + (wave & 1)) * 65 + j * 16 + fr] = acc[i][j][e];
        }
        __syncthreads();
        {
            const int task = tid >> 2, q = tid & 3;
            const float* row = lds + task * LDW + q * 65;
            unsigned t[16];
#pragma unroll
            for (int k = 0; k < 16; ++k) t[k] = 0u;
#pragma unroll 8
            for (int i = 0; i < 64; ++i) ins16(t, (ukey(row[i]) & ~127u) | (unsigned)(127 - ((q & 1) * 64 + i)));
            unsigned o[16];
#pragma unroll
            for (int k = 0; k < 16; ++k) o[k] = (unsigned)__shfl_xor((int)t[k], 1);
#pragma unroll
            for (int k = 0; k < 16; ++k) ins16(t, o[k]);
#pragma unroll
            for (int k = 0; k < 16; ++k) o[k] = (unsigned)__shfl_xor((int)t[k], 2);
            float v1[16], v2[16];
#pragma unroll
            for (int k = 0; k < 16; ++k) {
                const unsigned s1 = (q & 2) ? o[k] : t[k], s2 = (q & 2) ? t[k] : o[k];
                v1[k] = ukey_inv(s1 & ~127u); v2[k] = ukey_inv(s2 & ~127u);
                if ((k & 3) == q) { tab[task * 32 + k] = 127 - (int)(s1 & 127u); tab[task * 32 + 16 + k] = 127 - (int)(s2 & 127u); }
            }
            unsigned cd[16];
#pragma unroll
            for (int k = 0; k < 16; ++k) cd[k] = 0u;
#pragma unroll
            for (int i = 0; i < 16; ++i)
#pragma unroll
                for (int j = 0; j < 16; ++j)
                    if ((i + 1) * (j + 1) <= 16) ins16(cd, (ukey(v1[i] + v2[j]) & ~255u) | (unsigned)(255 - (i * 16 + j)));
            const float vmax = ukey_inv(cd[0] & ~255u);
            float es = 0.f;
#pragma unroll
            for (int k = 0; k < 16; ++k) es += __expf(ukey_inv(cd[k] & ~255u) - vmax);
            const float inv = 1.f / es;
            const size_t ob = ((size_t)(t0 + (task & 63)) * 8 + hp2 * 2 + (task >> 6)) * 16 + q * 4;
#pragma unroll
            for (int e = 0; e < 4; ++e) {
                const unsigned key = q == 0 ? cd[e] : q == 1 ? cd[4 + e] : q == 2 ? cd[8 + e] : cd[12 + e];
                const int pos = 255 - (int)(key & 255u);
                PIDX[ob + e] = tab[task * 32 + (pos >> 4)] * 128 + tab[task * 32 + 16 + (pos & 15)];
                PG[ob + e] = __expf(ukey_inv(key & ~255u) - vmax) * inv;
            }
        }
        __syncthreads();
    }
}

__device__ __forceinline__ void gather_phase(const Params& p, float* lds) {
    const bf16_t* H2 = (const bf16_t*)(p.ws + WS_XN); const bf16_t* U = (const bf16_t*)(p.ws + WS_U); const bf16_t* V = (const bf16_t*)(p.ws + WS_V);
    const int* PIDX = (const int*)(p.ws + WS_PIDX); const float* PG = (const float*)(p.ws + WS_PG);
    const float* mod = (const float*)(p.ws + WS_MOD);
    const int tid = threadIdx.x, lane = tid & 63, wave = tid >> 6;
    float* part = lds;
    float* red = lds + 8 * 1024;
    for (int tok = blockIdx.x; tok < MT; tok += gridDim.x) {
        const int b = tok / NS;
        float hv[16];
        {
            const u32x4 w0 = *(const u32x4*)(H2 + (size_t)tok * ND + lane * 8), w1 = *(const u32x4*)(H2 + (size_t)tok * ND + 512 + lane * 8);
#pragma unroll
            for (int e = 0; e < 4; ++e) { hv[e * 2] = bflo(w0[e]); hv[e * 2 + 1] = bfhi(w0[e]); hv[8 + e * 2] = bflo(w1[e]); hv[8 + e * 2 + 1] = bfhi(w1[e]); }
        }
        float acc[16];
#pragma unroll
        for (int e = 0; e < 16; ++e) acc[e] = 0.f;
        for (int k = 0; k < 16; ++k) {
            const size_t o = ((size_t)tok * 8 + wave) * 16 + k;
            const int idx = PIDX[o]; const float g = PG[o];
            const u32x4 u0 = *(const u32x4*)(U + (size_t)idx * ND + lane * 8), u1 = *(const u32x4*)(U + (size_t)idx * ND + 512 + lane * 8);
            float d = 0.f;
#pragma unroll
            for (int e = 0; e < 4; ++e) { d += hv[e * 2] * bflo(u0[e]) + hv[e * 2 + 1] * bfhi(u0[e]); d += hv[8 + e * 2] * bflo(u1[e]) + hv[8 + e * 2 + 1] * bfhi(u1[e]); }
            d = wave_sum(d);
            const float a = 0.5f * d * (1.f + erff(d * 0.70710678118654752f));
            const float w = g * a;
            const u32x4 v0 = *(const u32x4*)(V + (size_t)idx * ND + lane * 8), v1 = *(const u32x4*)(V + (size_t)idx * ND + 512 + lane * 8);
#pragma unroll
            for (int e = 0; e < 4; ++e) { acc[e * 2] += w * bflo(v0[e]); acc[e * 2 + 1] += w * bfhi(v0[e]); acc[8 + e * 2] += w * bflo(v1[e]); acc[8 + e * 2 + 1] += w * bfhi(v1[e]); }
        }
#pragma unroll
        for (int e = 0; e < 8; ++e) { part[wave * 1024 + lane * 8 + e] = acc[e]; part[wave * 1024 + 512 + lane * 8 + e] = acc[8 + e]; }
        __syncthreads();
        float y[2]; float ss = 0.f;
#pragma unroll
        for (int q = 0; q < 2; ++q) {
            const int d = tid + q * NT;
            float s = 0.f;
#pragma unroll
            for (int w = 0; w < 8; ++w) s += part[w * 1024 + d];
            y[q] = p.out[(size_t)tok * ND + d] + mod[b * 6144 + 5120 + d] * s;
            ss += y[q] * y[q];
        }
        ss = wave_sum(ss);
        if (lane == 0) red[wave] = ss;
        __syncthreads();
        float tot = 0.f;
#pragma unroll
        for (int w = 0; w < 8; ++w) tot += red[w];
        const float rstd = rsqrtf(tot * (1.f / ND) + EPS);
#pragma unroll
        for (int q = 0; q < 2; ++q) { const int d = tid + q * NT; p.out[(size_t)tok * ND + d] = y[q] * rstd * p.norm_f[d]; }
        __syncthreads();
    }
}

typedef float f32x2 __attribute__((ext_vector_type(2)));
__device__ __forceinline__ int rfl(int v) { return __builtin_amdgcn_readfirstlane(v); }
__device__ __forceinline__ void gather2_phase(const Params& p, unsigned char* lds) {
    const unsigned char* UV = p.ws + WS_U; const bf16_t* H2 = (const bf16_t*)(p.ws + WS_XN);
    const int* PIDX = (const int*)(p.ws + WS_PIDX); const float* PG = (const float*)(p.ws + WS_PG);
    const float* mod = (const float*)(p.ws + WS_MOD);
    const int tid = threadIdx.x, lane = tid & 63, wave = tid >> 6;
    unsigned char* wl = lds + wave * 4608;
    int* Lidx = (int*)wl; float* Lw = (float*)(wl + 2048); int* Loff = (int*)(wl + 4096);
    for (int pass = blockIdx.x; pass < MT / 32; pass += gridDim.x) {
        const int tokbase = pass * 32 + wave * 4;
#pragma unroll
        for (int tk = 0; tk < 4; ++tk) {
            const size_t o = (size_t)(tokbase + tk) * 128;
            const int i0 = PIDX[o + lane], i1 = PIDX[o + 64 + lane]; const float w0 = PG[o + lane], w1 = PG[o + 64 + lane];
            const int r0 = i0 >> 10, r1 = i1 >> 10;
            int pos0 = 0, pos1 = 0, myoff = 0, base = 0;
#pragma unroll
            for (int q = 0; q < 16; ++q) {
                const unsigned long long m0 = __ballot(r0 == q), m1 = __ballot(r1 == q); const int c0 = __popcll(m0);
                if (r0 == q) pos0 = base + mbcnt64(m0);
                if (r1 == q) pos1 = base + c0 + mbcnt64(m1);
                if (lane == q) myoff = base;
                base += c0 + __popcll(m1);
            }
            if (lane == 16) myoff = base;
            Lidx[tk * 128 + pos0] = i0; Lw[tk * 128 + pos0] = w0; Lidx[tk * 128 + pos1] = i1; Lw[tk * 128 + pos1] = w1;
            if (lane < 17) Loff[tk * 32 + lane] = myoff;
        }
        f32x2 h[4][8], acc[4][8];
#pragma unroll
        for (int tk = 0; tk < 4; ++tk) {
            const u32x4 a = *(const u32x4*)(H2 + (size_t)(tokbase + tk) * ND + lane * 16), c = *(const u32x4*)(H2 + (size_t)(tokbase + tk) * ND + lane * 16 + 8);
#pragma unroll
            for (int e = 0; e < 4; ++e) { h[tk][e] = (f32x2){bflo(a[e]), bfhi(a[e])}; h[tk][4 + e] = (f32x2){bflo(c[e]), bfhi(c[e])}; acc[tk][e] = (f32x2){0.f, 0.f}; acc[tk][4 + e] = (f32x2){0.f, 0.f}; }
        }
#pragma unroll 1
        for (int r = 0; r < 16; ++r) {
#pragma unroll
            for (int tk = 0; tk < 4; ++tk) {
                const int beg = rfl(Loff[tk * 32 + r]), end = rfl(Loff[tk * 32 + r + 1]);
                for (int j0 = beg; j0 < end; j0 += 8) {
                    const int n = min(8, end - j0);
                    u32x4 rr[8]; const unsigned char* rowp[8];
#pragma unroll
                    for (int j = 0; j < 8; ++j) if (j < n) { rowp[j] = UV + (size_t)rfl(Lidx[tk * 128 + j0 + j]) * 2048 + lane * 16; rr[j] = *(const u32x4*)rowp[j]; }
                    float d[8];
#pragma unroll
                    for (int j = 0; j < 8; ++j) {
                        d[j] = 0.f;
                        if (j < n) {
                            f32x2 s = (f32x2){0.f, 0.f};
#pragma unroll
                            for (int k = 0; k < 4; ++k) {
                                s = __builtin_elementwise_fma(__builtin_amdgcn_cvt_pk_f32_fp8(rr[j][k], false), h[tk][2 * k], s);
                                s = __builtin_elementwise_fma(__builtin_amdgcn_cvt_pk_f32_fp8(rr[j][k], true), h[tk][2 * k + 1], s);
                            }
                            d[j] = s.x + s.y;
                            rr[j] = *(const u32x4*)(rowp[j] + 1024);
                        }
                    }
                    float r4[4], r2[2], r1;
#pragma unroll
                    for (int j = 0; j < 4; ++j) { const float keep = (lane & 32) ? d[j + 4] : d[j], send = (lane & 32) ? d[j] : d[j + 4]; r4[j] = keep + __shfl_xor(send, 32); }
#pragma unroll
                    for (int j = 0; j < 2; ++j) { const float keep = (lane & 16) ? r4[j + 2] : r4[j], send = (lane & 16) ? r4[j] : r4[j + 2]; r2[j] = keep + __shfl_xor(send, 16); }
                    { const float keep = (lane & 8) ? r2[1] : r2[0], send = (lane & 8) ? r2[0] : r2[1]; r1 = keep + __shfl_xor(send, 8); }
                    r1 += __shfl_xor(r1, 4); r1 += __shfl_xor(r1, 2); r1 += __shfl_xor(r1, 1);
                    float wq = 0.f;
                    if ((lane >> 3) < n) { const float x = r1 * (1.f / 64.f); wq = Lw[tk * 128 + j0 + (lane >> 3)] * (0.5f * x * (1.f + erff(x * 0.70710678118654752f))) * 0.125f; }
#pragma unroll
                    for (int j = 0; j < 8; ++j) if (j < n) {
                        const float wj = __int_as_float(__builtin_amdgcn_readlane(__float_as_int(wq), j * 8));
                        const f32x2 w2 = (f32x2){wj, wj};
#pragma unroll
                        for (int k = 0; k < 4; ++k) {
                            acc[tk][2 * k] = __builtin_elementwise_fma(__builtin_amdgcn_cvt_pk_f32_fp8(rr[j][k], false), w2, acc[tk][2 * k]);
                            acc[tk][2 * k + 1] = __builtin_elementwise_fma(__builtin_amdgcn_cvt_pk_f32_fp8(rr[j][k], true), w2, acc[tk][2 * k + 1]);
                        }
                    }
                }
            }
        }
#pragma unroll
        for (int tk = 0; tk < 4; ++tk) {
            const int tok = tokbase + tk, b = tok / NS;
            float* xo = p.out + (size_t)tok * ND + lane * 16; const float* g2 = mod + b * 6144 + 5120 + lane * 16; const float* nf = p.norm_f + lane * 16;
            f32x4 y[4]; float ss = 0.f;
#pragma unroll
            for (int q = 0; q < 4; ++q) {
                const f32x4 xv = *(const f32x4*)(xo + q * 4), gv = *(const f32x4*)(g2 + q * 4);
                y[q] = xv + gv * (f32x4){acc[tk][2 * q].x, acc[tk][2 * q].y, acc[tk][2 * q + 1].x, acc[tk][2 * q + 1].y};
                ss += y[q][0] * y[q][0] + y[q][1] * y[q][1] + y[q][2] * y[q][2] + y[q][3] * y[q][3];
            }
            ss = wave_sum(ss);
            const float rstd = rsqrtf(ss * (1.f / ND) + EPS);
#pragma unroll
            for (int q = 0; q < 4; ++q) *(f32x4*)(xo + q * 4) = y[q] * rstd * *(const f32x4*)(nf + q * 4);
        }
    }
}

__device__ __forceinline__ void gather3_phase(const Params& p, unsigned char* lds) {
    const unsigned char* UV = p.ws + WS_U; const bf16_t* H2 = (const bf16_t*)(p.ws + WS_XN);
    const int* PIDX = (const int*)(p.ws + WS_PIDX); const float* PG = (const float*)(p.ws + WS_PG);
    const float* mod = (const float*)(p.ws + WS_MOD);
    const int tid = threadIdx.x, lane = tid & 63, wave = tid >> 6;
    unsigned char* wl = lds + wave * 12800;
    int* Lidx = (int*)wl; float* Lw = (float*)(wl + 2048); int* cnt = (int*)(wl + 4096); int* bs = (int*)(wl + 4352); unsigned char* hl = wl + 4608;
    for (int pass = blockIdx.x; pass < MT / 32; pass += gridDim.x) {
        const int tokbase = pass * 32 + wave * 4;
        cnt[lane] = 0;
        int ei[8]; float ew[8]; int pib[8];
#pragma unroll
        for (int tk = 0; tk < 4; ++tk) {
            const size_t o = (size_t)(tokbase + tk) * 128;
            ei[tk * 2] = PIDX[o + lane]; ei[tk * 2 + 1] = PIDX[o + 64 + lane]; ew[tk * 2] = PG[o + lane]; ew[tk * 2 + 1] = PG[o + 64 + lane];
        }
#pragma unroll
        for (int s = 0; s < 8; ++s) pib[s] = atomicAdd(&cnt[ei[s] >> 8], 1);
        {
            const int c = cnt[lane]; int x = c;
#pragma unroll
            for (int off = 1; off < 64; off <<= 1) { const int y = __shfl_up(x, off); if (lane >= off) x += y; }
            bs[lane] = x - c;
        }
#pragma unroll
        for (int s = 0; s < 8; ++s) { const int pos = bs[ei[s] >> 8] + pib[s]; Lidx[pos] = ei[s] | ((s >> 1) << 16); Lw[pos] = ew[s]; }
        f32x2 acc[4][8];
#pragma unroll
        for (int tk = 0; tk < 4; ++tk) {
            *(u32x4*)(hl + tk * 2048 + lane * 32) = *(const u32x4*)(H2 + (size_t)(tokbase + tk) * ND + lane * 16);
            *(u32x4*)(hl + tk * 2048 + lane * 32 + 16) = *(const u32x4*)(H2 + (size_t)(tokbase + tk) * ND + lane * 16 + 8);
#pragma unroll
            for (int e = 0; e < 8; ++e) acc[tk][e] = (f32x2){0.f, 0.f};
        }
#define G3_ACC(T) { asm volatile("; acc slot"); _Pragma("unroll") for (int k = 0; k < 4; ++k) { \
            acc[T][2 * k] = __builtin_elementwise_fma(__builtin_amdgcn_cvt_pk_f32_fp8(rr[j][k], false), w2, acc[T][2 * k]); \
            acc[T][2 * k + 1] = __builtin_elementwise_fma(__builtin_amdgcn_cvt_pk_f32_fp8(rr[j][k], true), w2, acc[T][2 * k + 1]); } }
#pragma unroll 1
        for (int j0 = 0; j0 < 512; j0 += 8) {
            u32x4 rr[8]; const unsigned char* rowp[8]; int tkj[8];
#pragma unroll
            for (int j = 0; j < 8; ++j) { const int e = rfl(Lidx[j0 + j]); tkj[j] = e >> 16; rowp[j] = UV + (size_t)(e & 0xffff) * 2048 + lane * 16; rr[j] = *(const u32x4*)rowp[j]; }
            float d[8];
#pragma unroll
            for (int j = 0; j < 8; ++j) {
                f32x2 s = (f32x2){0.f, 0.f};
                {
                    const unsigned char* hp = hl + tkj[j] * 2048 + lane * 32;
                    const u32x4 ha = *(const u32x4*)hp, hb = *(const u32x4*)(hp + 16);
#pragma unroll
                    for (int k = 0; k < 4; ++k) {
                        const unsigned h0 = k < 2 ? ha[2 * k] : hb[2 * k - 4], h1 = k < 2 ? ha[2 * k + 1] : hb[2 * k - 3];
                        s = __builtin_elementwise_fma(__builtin_amdgcn_cvt_pk_f32_fp8(rr[j][k], false), (f32x2){bflo(h0), bfhi(h0)}, s);
                        s = __builtin_elementwise_fma(__builtin_amdgcn_cvt_pk_f32_fp8(rr[j][k], true), (f32x2){bflo(h1), bfhi(h1)}, s);
                    }
                }
                d[j] = s.x + s.y;
                rr[j] = *(const u32x4*)(rowp[j] + 1024);
            }
            float r4[4], r2[2], r1;
#pragma unroll
            for (int j = 0; j < 4; ++j) { const float keep = (lane & 32) ? d[j + 4] : d[j], send = (lane & 32) ? d[j] : d[j + 4]; r4[j] = keep + __shfl_xor(send, 32); }
#pragma unroll
            for (int j = 0; j < 2; ++j) { const float keep = (lane & 16) ? r4[j + 2] : r4[j], send = (lane & 16) ? r4[j] : r4[j + 2]; r2[j] = keep + __shfl_xor(send, 16); }
            { const float keep = (lane & 8) ? r2[1] : r2[0], send = (lane & 8) ? r2[0] : r2[1]; r1 = keep + __shfl_xor(send, 8); }
            r1 += __shfl_xor(r1, 4); r1 += __shfl_xor(r1, 2); r1 += __shfl_xor(r1, 1);
            const float x = r1 * (1.f / 64.f);
            const float wq = Lw[j0 + (lane >> 3)] * (0.5f * x * (1.f + erff(x * 0.70710678118654752f))) * 0.125f;
#pragma unroll
            for (int j = 0; j < 8; ++j) {
                const float wj = __int_as_float(__builtin_amdgcn_readlane(__float_as_int(wq), j * 8));
                const f32x2 w2 = (f32x2){wj, wj};
                if (tkj[j] == 0) G3_ACC(0) else if (tkj[j] == 1) G3_ACC(1) else if (tkj[j] == 2) G3_ACC(2) else G3_ACC(3)
            }
        }
#undef G3_ACC
#pragma unroll
        for (int tk = 0; tk < 4; ++tk) {
            const int tok = tokbase + tk, b = tok / NS;
            float* xo = p.out + (size_t)tok * ND + lane * 16; const float* g2 = mod + b * 6144 + 5120 + lane * 16; const float* nf = p.norm_f + lane * 16;
            f32x4 y[4]; float ss = 0.f;
#pragma unroll
            for (int q = 0; q < 4; ++q) {
                const f32x4 xv = *(const f32x4*)(xo + q * 4), gv = *(const f32x4*)(g2 + q * 4);
                y[q] = xv + gv * (f32x4){acc[tk][2 * q].x, acc[tk][2 * q].y, acc[tk][2 * q + 1].x, acc[tk][2 * q + 1].y};
                ss += y[q][0] * y[q][0] + y[q][1] * y[q][1] + y[q][2] * y[q][2] + y[q][3] * y[q][3];
            }
            ss = wave_sum(ss);
            const float rstd = rsqrtf(ss * (1.f / ND) + EPS);
#pragma unroll
            for (int q = 0; q < 4; ++q) *(f32x4*)(xo + q * 4) = y[q] * rstd * *(const f32x4*)(nf + q * 4);
        }
    }
}

#define XB_TMO      128
#define XB_XCNT(j)  (256  + 64 * (j))
#define XB_XSUB(j)  (1280 + 64 * (j))
#define XB_XGEN(j)  (2304 + 64 * (j))
#define XB_TOP      3328
#define XB_TOPGEN   3392
#define XCD_BAR_WORDS 3456
#define XB_SPIN_CAP (1u << 18)
#define LAS __attribute__((address_space(3)))
__device__ __forceinline__ unsigned xb_ld(unsigned* p)              { return __hip_atomic_load(p, __ATOMIC_RELAXED, __HIP_MEMORY_SCOPE_AGENT); }
__device__ __forceinline__ unsigned xb_add(unsigned* p, unsigned v) { return __hip_atomic_fetch_add(p, v, __ATOMIC_RELAXED, __HIP_MEMORY_SCOPE_AGENT); }
__device__ __forceinline__ unsigned xb_xcc_id() { return (unsigned)__builtin_amdgcn_s_getreg((3 << 11) | 20) & 0xFu; }
#define XB_SPIN(cond, bar) do { unsigned _sp = 0; while (cond) { __builtin_amdgcn_s_sleep(1); \
    if ((++_sp & 255u) == 0u) { if (xb_ld(&(bar)[XB_TMO])) break; if (_sp > XB_SPIN_CAP) { atomicAdd(&(bar)[XB_TMO], 1u); break; } } } } while (0)
struct XcdBarrier { unsigned* bar; unsigned x; volatile LAS unsigned* st; };
__device__ __forceinline__ XcdBarrier xcd_barrier_post(unsigned* bar, volatile LAS unsigned* st) {
    XcdBarrier b; b.bar = bar; b.x = xb_xcc_id(); b.st = st;
    if (threadIdx.x == 0) (void)xb_add(&bar[XB_XCNT(b.x)], 1u);
    return b;
}
__device__ __forceinline__ void xcd_barrier_complete(unsigned* bar, unsigned x, unsigned& nloc, unsigned& nx) {
    const unsigned G = gridDim.x * gridDim.y * gridDim.z;
    unsigned sum, cnt, mine, sp = 0u;
    for (;;) {
        sum = 0u; cnt = 0u; mine = 0u;
#pragma unroll
        for (unsigned j = 0; j < 16; ++j) { const unsigned c = xb_ld(&bar[XB_XCNT(j)]); sum += c; cnt += (c > 0u) ? 1u : 0u; mine = (j == x) ? c : mine; }
        if (sum == G) break;
        __builtin_amdgcn_s_sleep(1);
        if ((++sp & 255u) == 0u) { if (xb_ld(&bar[XB_TMO])) break; if (sp > XB_SPIN_CAP) { atomicAdd(&bar[XB_TMO], 1u); break; } }
    }
    nloc = mine > 0u ? mine : 1u; nx = cnt > 0u ? cnt : 1u;
}
__device__ __forceinline__ void xcd_barrier(const XcdBarrier& b) {
    asm volatile("s_waitcnt vmcnt(0)" ::: "memory");
    __syncthreads();
    if (threadIdx.x == 0) {
        unsigned* bar = b.bar;
        __builtin_amdgcn_s_waitcnt(0);
        unsigned nloc = b.st[0], nx = b.st[1];
        if (nloc == 0u) { xcd_barrier_complete(bar, b.x, nloc, nx); b.st[0] = nloc; b.st[1] = nx; }
        const unsigned old = xb_add(&bar[XB_XSUB(b.x)], 1u);
        const unsigned gen = old / nloc;
        if (old + 1u == (gen + 1u) * nloc) {
            __builtin_amdgcn_fence(__ATOMIC_RELEASE, "agent");
            asm volatile("s_waitcnt vmcnt(0)" ::: "memory");
            const unsigned og = xb_add(&bar[XB_TOP], 1u);
            const unsigned tg = og / nx;
            if (og + 1u == (tg + 1u) * nx) xb_add(&bar[XB_TOPGEN], 1u);
            else XB_SPIN(xb_ld(&bar[XB_TOPGEN]) == tg, bar);
            __builtin_amdgcn_fence(__ATOMIC_ACQUIRE, "agent");
            xb_add(&bar[XB_XGEN(b.x)], 1u);
            asm volatile("s_waitcnt vmcnt(0)" ::: "memory");
        } else {
            XB_SPIN(xb_ld(&bar[XB_XGEN(b.x)]) == gen, bar);
            __builtin_amdgcn_fence(__ATOMIC_ACQUIRE, "agent");
            asm volatile("s_waitcnt vmcnt(0)" ::: "memory");
        }
    }
    __syncthreads();
}

constexpr int LDS_BYTES = 157696 + 16;
__global__ void __launch_bounds__(NT, 2) k_mega(Params p) {
    __shared__ __attribute__((aligned(16))) unsigned char lds[LDS_BYTES];
    volatile LAS unsigned* xst = (volatile LAS unsigned*)(lds + 157696);
    if (threadIdx.x == 0) { xst[0] = 0u; xst[1] = 0u; }
    __syncthreads();
    (void)xcd_barrier_post((unsigned*)(p.ws + WS_CTL), xst);
#define GRID_BARRIER() do { XcdBarrier xb_; xb_.bar = (unsigned*)(p.ws + WS_CTL); xb_.x = xb_xcc_id(); xb_.st = (volatile LAS unsigned*)(lds + 157696); xcd_barrier(xb_); } while (0)
#define REPS(k) for (int rep_ = 0; rep_ < ((DUP == (k)) ? 2 : 1); ++rep_)
    _Pragma("unroll 1") REPS(1) {
    mod_phase(p, (float*)lds);
    transpose_convert(p.w_in, (bf16_t*)(p.ws + WS_WIN), ND, NIN, (float*)lds);
    transpose_convert(p.w_out, (bf16_t*)(p.ws + WS_WOUT), ND, ND, (float*)lds);
    transpose_convert(p.wq, (bf16_t*)(p.ws + WS_WQ), ND, 2048, (float*)lds);
    convert_flat(p.keys, (bf16_t*)(p.ws + WS_KEYS), (size_t)8 * 2 * 128 * 128);
    convert_uv_fp8(p.pu, p.pv, p.ws + WS_U);
    }
    GRID_BARRIER();
    _Pragma("unroll 1") REPS(2) prep_phase(p, 0);
    GRID_BARRIER();
    _Pragma("unroll 1") REPS(3) inproj8_phase(p, lds);
    GRID_BARRIER();
    _Pragma("unroll 1") REPS(4) {
        const bool split = gridDim.x >= 128;
        if (!split || blockIdx.x < 64) hg_chunk_phase(p, lds);
        if (!split || blockIdx.x >= 64) na_mfma_phase(p, (float*)lds, split ? blockIdx.x - 64 : blockIdx.x, split ? gridDim.x - 64 : gridDim.x);
    }
    GRID_BARRIER();
    _Pragma("unroll 1") REPS(5) hgmix_phase(p);
    GRID_BARRIER();
    _Pragma("unroll 1") REPS(6) outproj8_phase(p, lds);
    GRID_BARRIER();
    _Pragma("unroll 1") REPS(7) prep_phase(p, 1);
    GRID_BARRIER();
    _Pragma("unroll 1") REPS(8) pq8_phase(p, lds);
    GRID_BARRIER();
    _Pragma("unroll 1") REPS(9) topk3_phase(p, (float*)lds);
    GRID_BARRIER();
    gather3_phase(p, lds);
}
}

extern "C" void kernel_launch(void* const* d_in, const int* in_sizes, int n_in, void* d_out, int out_size, void* d_ws, size_t ws_size, hipStream_t stream) {
    if (n_in != 18 || ws_size < WS_END) { fprintf(stderr, "kernel_launch: unexpected n_in %d / ws_size %zu\n", n_in, ws_size); return; }
    Params p{};
    p.x = (const float*)d_in[0]; p.c = (const float*)d_in[1]; p.ctx = (const float*)d_in[2]; p.c_ctx = (const float*)d_in[3];
    p.w_mod = (const float*)d_in[4]; p.b_mod = (const float*)d_in[5]; p.norm1 = (const float*)d_in[6]; p.norm2 = (const float*)d_in[7];
    p.w_in = (const float*)d_in[8]; p.w_out = (const float*)d_in[9]; p.rpb = (const float*)d_in[10]; p.hg_lb = (const float*)d_in[11];
    p.hg_norm = (const float*)d_in[12]; p.wq = (const float*)d_in[13]; p.keys = (const float*)d_in[14]; p.pu = (const float*)d_in[15];
    p.pv = (const float*)d_in[16]; p.norm_f = (const float*)d_in[17];
    p.out = (float*)d_out; p.ws = (unsigned char*)d_ws;
    static int grid_blocks = 0;
    if (!grid_blocks) {
        int dev = 0, cus = 0, per_cu = 0;
        hipGetDevice(&dev);
        hipDeviceGetAttribute(&cus, hipDeviceAttributeMultiprocessorCount, dev);
        hipOccupancyMaxActiveBlocksPerMultiprocessor(&per_cu, k_mega, NT, 0);
        if (per_cu < 1) { fprintf(stderr, "kernel_launch: occupancy query says %d blocks per CU\n", per_cu); per_cu = 1; }
        if (per_cu > 1) per_cu = 1;
        grid_blocks = cus * per_cu;
    }
    if (hipMemsetAsync((char*)d_ws + WS_CTL, 0, XCD_BAR_WORDS * 4, stream) != hipSuccess) { fprintf(stderr, "kernel_launch: memset of the barrier words failed\n"); return; }
    hipLaunchKernelGGL(k_mega, dim3(grid_blocks), dim3(NT), 0, stream, p);
}
```

```cpp
#include <hip/hip_runtime.h>
#include <hip/hip_cooperative_groups.h>
#include <cstdint>
#include <cstdio>

typedef unsigned short bf16_t;
typedef short bf16x8 __attribute__((ext_vector_type(8)));
typedef float f32x4 __attribute__((ext_vector_type(4)));
typedef unsigned u32x4 __attribute__((ext_vector_type(4)));
typedef unsigned u32x2 __attribute__((ext_vector_type(2)));

namespace pg8 {
#define PG8_LAS __attribute__((address_space(3)))
typedef unsigned short bf16_t;
typedef short bf16x8 __attribute__((ext_vector_type(8)));
typedef float f32x4 __attribute__((ext_vector_type(4)));
typedef unsigned u32x4 __attribute__((ext_vector_type(4)));
constexpr int BM = 256, BK = 64, HALF = 128, HTB = HALF * BK * 2  , STAGE_BYTES = 8 * HTB, NXCD = 8, WGM = 8;

__host__ __device__ __forceinline__ int lds_byte(int r, int c) { const int st = (r >> 4) * 2 + (c >> 5), rr = r & 15, cc = c & 31, ob = rr * 64 + cc * 2; return st * 1024 + (ob ^ (((ob >> 9) & 1) << 5)); }
__host__ __device__ __forceinline__ void stage_rc(int b, int& R, int& C) { const int st = b / 1024, sb = b % 1024, swz = sb ^ (((sb >> 9) & 1) << 5); R = (st >> 1) * 16 + swz / 64; C = (st & 1) * 32 + (swz % 64) / 2; }
__host__ __device__ __forceinline__ int perm32(int rho) { const int n = rho >> 4, i = rho & 15; return 8 * (i >> 2) + 4 * n + (i & 3); }

struct Unit { int pm, pn; };
struct Gemm { const bf16_t* A; const bf16_t* Bt; int M, N, K; };

struct StaticOrder {
    int nM, nN, nwg, G, c;
    __host__ __device__ void init(int M, int N, int G_, int c_) { nM = M / BM; nN = N / BM; nwg = nM * nN; G = G_; c = c_; }
    __host__ __device__ bool next(int i, Unit& u) const {
        const long L = (long)i * G + c; if (L >= nwg) return false;
        int wgid = (int)L; { const int q = nwg / NXCD, r = nwg % NXCD, xcd = wgid % NXCD, off = wgid / NXCD; wgid = (xcd < r ? xcd * (q + 1) : r * (q + 1) + (xcd - r) * q) + off; }
        const int nig = WGM * nN, gid = wgid / nig, fm = gid * WGM, gsz = (nM - fm) < WGM ? (nM - fm) : WGM;
        u.pm = fm + ((wgid % nig) % gsz); u.pn = (wgid % nig) / gsz; return true;
    }
    __device__ __forceinline__ void a_ready(const Unit&) const {}
    __device__ __forceinline__ void done(const Unit&) const {}
};
__device__ __forceinline__ unsigned cvt_pk_bf16(float lo, float hi) { unsigned r; asm volatile("v_cvt_pk_bf16_f32 %0, %1, %2" : "=v"(r) : "v"(lo), "v"(hi)); return r; }
template <class Epi, class Sched, bool STAMP = false>
__device__ __forceinline__ void gemm_phase(PG8_LAS unsigned char* lds, const Gemm g, const Sched& S, const Epi& E, unsigned long long* stamps) {
    int tid_ = threadIdx.x; asm volatile("" : "+v"(tid_));
    const int tid = tid_, wid = __builtin_amdgcn_readfirstlane(tid >> 6), lane = tid & 63, wr = wid >> 2, wc = wid & 3, fr = lane & 15, fq = lane >> 4;
    const int K = g.K, nt = K / BK;
    int ts_lo = 0, ts_hi = 0, nts = 0; const unsigned long long rt_entry = STAMP ? (unsigned long long)wall_clock64() : 0ull;
#define PG8_STAMP() do { if (STAMP && wid == 0 && nts < 64) { const unsigned long long _c = (unsigned long long)clock64(); \
        ts_lo = (lane == nts) ? (int)(unsigned)_c : ts_lo; ts_hi = (lane == nts) ? (int)(unsigned)(_c >> 32) : ts_hi; ++nts; } } while (0)
    PG8_STAMP();
    unsigned voffA[2], voffB[2];
#pragma unroll
    for (int i = 0; i < 2; ++i) { int R, C; stage_rc(tid * 16 + i * 8192, R, C); const int Rb = Epi::PERM ? ((R & ~31) + perm32(R & 31)) : R;
        voffA[i] = (unsigned)(R * K + C) * 2u; voffB[i] = (unsigned)(Rb * K + C) * 2u; }
    const size_t kstep = (size_t)(BK * 2);
    const size_t hstep = (size_t)HALF * K * 2;
    const size_t tstep = 2 * hstep;
    const unsigned ldsw = (unsigned)wid * 1024u;
    const int aoff = lds_byte(wr * 64 + fr, fq * 8), boff = lds_byte(wc * 32 + fr, fq * 8);
#define PG8_SA(b, h) (((b) * 2 + (h)) * HTB)
#define PG8_SB(b, h) ((4 + (b) * 2 + (h)) * HTB)
#define PG8_STAGE(bufoff, gbase, voff) do { _Pragma("unroll") for (int _i = 0; _i < 2; ++_i) \
        __builtin_amdgcn_global_load_lds((const unsigned*)((const char*)(gbase) + (voff)[_i]), (PG8_LAS unsigned*)(lds + (bufoff) + ldsw + _i * 8192), 16, 0, 0); } while (0)
#define PG8_LDA(dst, b, h) do { _Pragma("unroll") for (int m = 0; m < 4; ++m) _Pragma("unroll") for (int k = 0; k < 2; ++k) dst[m][k] = *(const PG8_LAS bf16x8*)(lds + PG8_SA(b, h) + aoff + m * 2048 + k * 1024); } while (0)
#define PG8_LDB(dst, b, h) do { _Pragma("unroll") for (int n = 0; n < 2; ++n) _Pragma("unroll") for (int k = 0; k < 2; ++k) dst[n][k] = *(const PG8_LAS bf16x8*)(lds + PG8_SB(b, h) + boff + n * 2048 + k * 1024); } while (0)
#define PG8_MMA(ai, bj, At, Bt) do { __builtin_amdgcn_s_setprio(1); _Pragma("unroll") for (int m = 0; m < 4; ++m) _Pragma("unroll") for (int n = 0; n < 2; ++n) _Pragma("unroll") for (int k = 0; k < 2; ++k) \
        acc[ai][bj][m][n] = __builtin_amdgcn_mfma_f32_16x16x32_bf16(Bt[n][k], At[m][k], acc[ai][bj][m][n], 0, 0, 0); __builtin_amdgcn_s_setprio(0); } while (0)
#define PG8_WAIT_V(n) asm volatile("s_waitcnt vmcnt(" #n ")" ::: "memory")
#define PG8_WAIT_L(n) asm volatile("s_waitcnt lgkmcnt(" #n ")" ::: "memory")
#define PG8_BAR __builtin_amdgcn_s_barrier()
#define PG8_SCHED __builtin_amdgcn_sched_barrier(0)
    Unit cur, nxt; int ui = 0;
    if (!S.next(0, cur)) return;
    f32x4 acc[2][2][4][2];
#pragma unroll
    for (int a = 0; a < 2; ++a)
#pragma unroll
        for (int b = 0; b < 2; ++b)
#pragma unroll
            for (int m = 0; m < 4; ++m)
#pragma unroll
                for (int n = 0; n < 2; ++n) acc[a][b][m][n] = (f32x4){0.f, 0.f, 0.f, 0.f};
    bf16x8 At[4][2], B0[2][2], B1[2][2];
    const char* cA = (const char*)g.A + (size_t)cur.pm * tstep; const char* cB = (const char*)g.Bt + (size_t)cur.pn * tstep;
    S.a_ready(cur);
    PG8_STAGE(PG8_SB(0, 0), cB, voffB); PG8_STAGE(PG8_SA(0, 0), cA, voffA); PG8_STAGE(PG8_SB(0, 1), cB + hstep, voffB); PG8_STAGE(PG8_SA(0, 1), cA + hstep, voffA);
    if (wr == 1) PG8_BAR;
    PG8_WAIT_V(4); PG8_BAR;
    PG8_STAGE(PG8_SB(1, 0), cB + kstep, voffB); PG8_STAGE(PG8_SA(1, 0), cA + kstep, voffA); PG8_STAGE(PG8_SB(1, 1), cB + hstep + kstep, voffB);
    PG8_WAIT_V(6); PG8_BAR;
    PG8_STAMP();
    for (;;) {
        const bool has_next = S.next(ui + 1, nxt);
        const char* nA = has_next ? (const char*)g.A + (size_t)nxt.pm * tstep : cA; const char* nB = has_next ? (const char*)g.Bt + (size_t)nxt.pn * tstep : cB;
        for (int t = 0; t < nt; t += 2) {
            const bool last = (t == nt - 2);
            const char* a1 = cA + (size_t)(t + 1) * kstep;
            const char* a2 = last ? nA : cA + (size_t)(t + 2) * kstep; const char* b2 = last ? nB : cB + (size_t)(t + 2) * kstep;
            const char* a3 = a2 + kstep; const char* b3 = b2 + kstep;
            if (last && has_next) S.a_ready(nxt);
            PG8_LDB(B0, 0, 0); PG8_SCHED; PG8_LDA(At, 0, 0); PG8_STAGE(PG8_SA(1, 1), a1 + hstep, voffA);
            PG8_WAIT_L(8); PG8_BAR; PG8_WAIT_L(0); PG8_MMA(0, 0, At, B0); PG8_BAR; PG8_SCHED;
            PG8_LDB(B1, 0, 1); PG8_STAGE(PG8_SB(0, 0), b2, voffB);
            PG8_BAR; PG8_WAIT_L(0); PG8_MMA(0, 1, At, B1); PG8_BAR;
            PG8_LDA(At, 0, 1); PG8_STAGE(PG8_SA(0, 0), a2, voffA);
            PG8_BAR; PG8_WAIT_L(0); PG8_MMA(1, 0, At, B0); PG8_BAR; PG8_SCHED;
            PG8_STAGE(PG8_SB(0, 1), b2 + hstep, voffB);
            PG8_WAIT_V(6); PG8_BAR; PG8_MMA(1, 1, At, B1); PG8_BAR;
            PG8_LDB(B0, 1, 0); PG8_SCHED; PG8_LDA(At, 1, 0); PG8_STAGE(PG8_SA(0, 1), a2 + hstep, voffA);
            PG8_WAIT_L(8); PG8_BAR; PG8_WAIT_L(0); PG8_MMA(0, 0, At, B0); PG8_BAR; PG8_SCHED;
            PG8_LDB(B1, 1, 1); PG8_STAGE(PG8_SB(1, 0), b3, voffB);
            PG8_BAR; PG8_WAIT_L(0); PG8_MMA(0, 1, At, B1); PG8_BAR;
            PG8_LDA(At, 1, 1); PG8_STAGE(PG8_SA(1, 0), a3, voffA);
            PG8_BAR; PG8_WAIT_L(0); PG8_MMA(1, 0, At, B0); PG8_BAR; PG8_SCHED;
            PG8_STAGE(PG8_SB(1, 1), b3 + hstep, voffB);
            PG8_WAIT_V(6); PG8_BAR; PG8_MMA(1, 1, At, B1); PG8_BAR;
        }
        PG8_STAMP();
        if constexpr (!Epi::AFTER_DRAIN) { E(acc, cur, wr, wc, fr, fq); S.done(cur); }
        PG8_STAMP();
        if (!has_next) break;
#pragma unroll
        for (int a = 0; a < 2; ++a)
#pragma unroll
            for (int b = 0; b < 2; ++b)
#pragma unroll
                for (int m = 0; m < 4; ++m)
#pragma unroll
                    for (int n = 0; n < 2; ++n) acc[a][b][m][n] = (f32x4){0.f, 0.f, 0.f, 0.f};
        cur = nxt; cA = nA; cB = nB; ++ui;
    }
    PG8_WAIT_V(0);
    if (wr == 0) PG8_BAR;
    PG8_BAR;
    if constexpr (Epi::AFTER_DRAIN) { E.fused(acc, cur, wr, wc, fr, fq, lds, wid, lane); S.done(cur); }
    PG8_STAMP();
    if (STAMP && wid == 0) { stamps[lane] = lane < nts ? (((unsigned long long)(unsigned)ts_hi << 32) | (unsigned)ts_lo) : 0ull;
        if (lane == 62) stamps[62] = rt_entry; if (lane == 63) stamps[63] = (unsigned long long)wall_clock64(); }
#undef PG8_STAMP
#undef PG8_SA
#undef PG8_SB
#undef PG8_STAGE
#undef PG8_LDA
#undef PG8_LDB
#undef PG8_MMA
#undef PG8_WAIT_V
#undef PG8_WAIT_L
#undef PG8_BAR
#undef PG8_SCHED
}
}

#ifndef DUP
#define DUP 0
#endif
namespace cg = cooperative_groups;
namespace {
constexpr int NB = 8, NS = 2048, ND = 1024, NL = 256, GW = 64, NROWS = 32;
constexpr int MT = NB * NS;
constexpr int MC = NB * NL;
constexpr int MA = MT + MC;
constexpr int NIN = 4096;
constexpr int NT = 512;
constexpr float EPS = 1e-6f;

constexpr size_t MiB = 1ull << 20;
constexpr size_t WS_CTL = 0;
constexpr size_t WS_MOD = 64 * 1024;
constexpr size_t WS_LB = 320 * 1024;
constexpr size_t WS_KEYS = 512 * 1024;
constexpr size_t WS_WIN = 1 * MiB;
constexpr size_t WS_WOUT = 9 * MiB;
constexpr size_t WS_WQ = 11 * MiB;
constexpr size_t WS_U = 15 * MiB;
constexpr size_t WS_V = 47 * MiB;
constexpr size_t WS_QHC = 47 * MiB;
constexpr size_t WS_S0T = 66 * MiB;
constexpr size_t WS_XN = 79 * MiB;
constexpr size_t WS_NAQ = 115 * MiB;
constexpr size_t WS_NAK = 131 * MiB;
constexpr size_t WS_NAV = 149 * MiB;
constexpr size_t WS_HQ = 167 * MiB;
constexpr size_t WS_ZF = 183 * MiB;
constexpr size_t WS_ZB = 201 * MiB;
constexpr size_t WS_HI = 219 * MiB;
constexpr size_t WS_HG = 237 * MiB;
constexpr size_t WS_END = 253 * MiB;
constexpr size_t WS_PQ = 115 * MiB;
constexpr size_t WS_PIDX = 179 * MiB;
constexpr size_t WS_PG = 187 * MiB;

struct Params {
    const float* x; const float* c; const float* ctx; const float* c_ctx; const float* w_mod; const float* b_mod;
    const float* norm1; const float* norm2; const float* w_in; const float* w_out; const float* rpb; const float* hg_lb;
    const float* hg_norm; const float* wq; const float* keys; const float* pu; const float* pv; const float* norm_f;
    float* out; unsigned char* ws;
};

__device__ __forceinline__ bf16_t f2bf(float f) { unsigned u = __float_as_uint(f); u += 0x7fffu + ((u >> 16) & 1u); return (bf16_t)(u >> 16); }
__device__ __forceinline__ float bf2f(bf16_t h) { return __uint_as_float(((unsigned)h) << 16); }
__device__ __forceinline__ unsigned pack2(float lo, float hi) { return (unsigned)f2bf(lo) | ((unsigned)f2bf(hi) << 16); }
__device__ __forceinline__ float bflo(unsigned w) { return __uint_as_float(w << 16); }
__device__ __forceinline__ float bfhi(unsigned w) { return __uint_as_float(w & 0xffff0000u); }
__device__ __forceinline__ float silu_f(float v) { return v / (1.f + __expf(-v)); }
__device__ __forceinline__ float sigmoid_f(float v) { return 1.f / (1.f + __expf(-v)); }
__device__ __forceinline__ float wave_sum(float v) {
#pragma unroll
    for (int o = 32; o >= 1; o >>= 1) v += __shfl_xor(v, o);
    return v;
}

__device__ __forceinline__ void mod_phase(const Params& p, float* lds) {
    float* sc = lds;
    float* red = lds + 9 * 1024;
    const int tid = threadIdx.x;
    float* mod = (float*)(p.ws + WS_MOD);
    for (int i = tid; i < 9 * 1024; i += NT) {
        const int r = i >> 10, k = i & 1023;
        const float v = (r < 8) ? p.c[r * 1024 + k] : p.c_ctx[k];
        sc[i] = silu_f(v);
    }
    __syncthreads();
    const int c4 = tid & 15, ks = tid >> 4, lane = tid & 63, wave = tid >> 6;
    for (int unit = blockIdx.x; unit < 6144 / 64; unit += gridDim.x) {
        const int j0 = unit * 64 + c4 * 4;
        f32x4 acc[9];
#pragma unroll
        for (int r = 0; r < 9; ++r) acc[r] = (f32x4){0.f, 0.f, 0.f, 0.f};
#pragma unroll 1
        for (int kb = ks * 32; kb < ks * 32 + 32; kb += 8) {
            f32x4 w[8];
#pragma unroll
            for (int i = 0; i < 8; ++i) w[i] = *(const f32x4*)(p.w_mod + (size_t)(kb + i) * 6144 + j0);
#pragma unroll
            for (int i = 0; i < 8; ++i)
#pragma unroll
                for (int r = 0; r < 9; ++r) acc[r] += w[i] * sc[r * 1024 + kb + i];
        }
#pragma unroll
        for (int r = 0; r < 9; ++r)
#pragma unroll
            for (int e = 0; e < 4; ++e) { float v = acc[r][e]; v += __shfl_xor(v, 16); v += __shfl_xor(v, 32); acc[r][e] = v; }
        if (lane < 16) {
#pragma unroll
            for (int r = 0; r < 9; ++r) *(f32x4*)(red + (wave * 9 + r) * 64 + c4 * 4) = acc[r];
        }
        __syncthreads();
        for (int i = tid; i < 9 * 64; i += NT) {
            const int r = i >> 6, cc = i & 63;
            float s = 0.f;
#pragma unroll
            for (int q = 0; q < 8; ++q) s += red[(q * 9 + r) * 64 + cc];
            mod[r * 6144 + unit * 64 + cc] = s + p.b_mod[unit * 64 + cc];
        }
        __syncthreads();
    }
    float* lb = (float*)(p.ws + WS_LB);
    for (int i = blockIdx.x * NT + tid; i < 1024; i += gridDim.x * NT) {
        const float a0 = p.hg_lb[i], a1 = p.hg_lb[1024 + i];
        lb[i] = 1.f / (1.f + __expf(a1 - a0));
    }
}

__device__ __forceinline__ void transpose_convert(const float* W, bf16_t* Wt, int K, int N, float* lds) {
    const int tid = threadIdx.x;
    const int tk = K / 64, tn = N / 64;
    for (int unit = blockIdx.x; unit < tk * tn; unit += gridDim.x) {
        const int k0 = (unit / tn) * 64, n0 = (unit % tn) * 64;
        for (int i = tid; i < 64 * 64; i += NT) { const int r = i >> 6, cc = i & 63; lds[r * 65 + cc] = W[(size_t)(k0 + r) * N + n0 + cc]; }
        __syncthreads();
        for (int i = tid; i < 64 * 64; i += NT) { const int n = i >> 6, k = i & 63; Wt[(size_t)(n0 + n) * K + k0 + k] = f2bf(lds[k * 65 + n]); }
        __syncthreads();
    }
}
__device__ __forceinline__ void convert_flat(const float* src, bf16_t* dst, size_t n) {
    const size_t stride = (size_t)gridDim.x * NT * 4;
    for (size_t i = ((size_t)blockIdx.x * NT + threadIdx.x) * 4; i < n; i += stride) {
        const f32x4 v = *(const f32x4*)(src + i);
        u32x2 o; o.x = pack2(v[0], v[1]); o.y = pack2(v[2], v[3]);
        *(u32x2*)(dst + i) = o;
    }
}

__device__ __forceinline__ void convert_uv_fp8(const float* u, const float* v, unsigned char* uv, int blk, int nblk) {
    const size_t nq = (size_t)16384 * 256;
    const size_t stride = (size_t)nblk * NT;
    for (size_t i = (size_t)blk * NT + threadIdx.x; i < 2 * nq; i += stride) {
        const bool isv = i >= nq; const size_t q = isv ? i - nq : i;
        const size_t e = q >> 8, c = q & 255;
        const f32x4 x = *(const f32x4*)((isv ? v : u) + q * 4) * (isv ? 8.f : 64.f);
        int w = 0;
        w = __builtin_amdgcn_cvt_pk_fp8_f32(x[0], x[1], w, false);
        w = __builtin_amdgcn_cvt_pk_fp8_f32(x[2], x[3], w, true);
        *(int*)(uv + e * 2048 + (isv ? 1024 : 0) + c * 4) = w;
    }
}

__device__ __forceinline__ unsigned fp6_code(float x) {
    const float a = fminf(fabsf(x), 7.5f);
    float c = a < 2.f ? __builtin_rintf(a * 8.f) : (a < 4.f ? 16.f + __builtin_rintf((a - 2.f) * 4.f) : 24.f + __builtin_rintf((a - 4.f) * 2.f));
    return (unsigned)c | (x < 0.f ? 32u : 0u);
}
__device__ __forceinline__ void convert_uv_fp6(const float* u, const float* v, unsigned char* uv, int blk, int nblk) {
    const size_t ng = (size_t)16384 * 32;
    const size_t stride = (size_t)nblk * NT;
    for (size_t i = (size_t)blk * NT + threadIdx.x; i < 2 * ng; i += stride) {
        const bool isv = i >= ng; const size_t q = isv ? i - ng : i;
        const size_t e = q >> 5, grp = q & 31;
        const float* src = (isv ? v : u) + q * 32; const float sc = isv ? 5.5f : 64.f;
        unsigned w[6] = {0u, 0u, 0u, 0u, 0u, 0u};
#pragma unroll
        for (int j = 0; j < 8; ++j) {
            const f32x4 x = *(const f32x4*)(src + j * 4) * sc;
#pragma unroll
            for (int k = 0; k < 4; ++k) {
                const int idx = j * 4 + k, bit = idx * 6, dw = bit >> 5, off = bit & 31;
                const unsigned code = fp6_code(x[k]);
                w[dw] |= code << off;
                if (off > 26) w[dw + 1] |= code >> (32 - off);
            }
        }
        unsigned* dst = (unsigned*)(uv + e * 1536 + (isv ? 768 : 0) + grp * 24);
        *(u32x2*)dst = (u32x2){w[0], w[1]}; *(u32x2*)(dst + 2) = (u32x2){w[2], w[3]}; *(u32x2*)(dst + 4) = (u32x2){w[4], w[5]};
    }
}

__device__ __forceinline__ void prep_phase(const Params& p, int which) {
    const int tid = threadIdx.x, lane = tid & 63, wave = tid >> 6;
    const float* mod = (const float*)(p.ws + WS_MOD);
    bf16_t* dst = (bf16_t*)(p.ws + WS_XN);
    const int nrows = which == 0 ? MA : MT;
    const float* g = which == 0 ? p.norm1 : p.norm2;
    for (int row = blockIdx.x * 8 + wave; row < nrows; row += gridDim.x * 8) {
        const float* src; int mr;
        if (which == 0) { if (row < MT) { src = p.x + (size_t)row * ND; mr = row / NS; } else { src = p.ctx + (size_t)(row - MT) * ND; mr = 8; } }
        else { src = p.out + (size_t)row * ND; mr = row / NS; }
        const float* sh = mod + mr * 6144 + (which == 0 ? 0 : 3072);
        const float* scl = mod + mr * 6144 + (which == 0 ? 1024 : 4096);
        f32x4 v[4]; float ss = 0.f;
#pragma unroll
        for (int i = 0; i < 4; ++i) { v[i] = *(const f32x4*)(src + i * 256 + lane * 4); ss += v[i][0] * v[i][0] + v[i][1] * v[i][1] + v[i][2] * v[i][2] + v[i][3] * v[i][3]; }
        ss = wave_sum(ss);
        const float rstd = rsqrtf(ss * (1.f / ND) + EPS);
#pragma unroll
        for (int i = 0; i < 4; ++i) {
            const int d = i * 256 + lane * 4;
            const f32x4 gg = *(const f32x4*)(g + d), s1 = *(const f32x4*)(sh + d), s2 = *(const f32x4*)(scl + d);
            float h[4];
#pragma unroll
            for (int e = 0; e < 4; ++e) h[e] = (v[i][e] * rstd * gg[e]) * (1.f + s2[e]) + s1[e];
            u32x2 o; o.x = pack2(h[0], h[1]); o.y = pack2(h[2], h[3]);
            *(u32x2*)(dst + (size_t)row * ND + d) = o;
        }
    }
}


struct InProjOrder {
    pg8::StaticOrder so; int G, c;
    __device__ void init(int G_, int c_) { so.init(MT, NIN, G_, c_); G = G_; c = c_; }
    __device__ bool next(int i, pg8::Unit& u) const {
        const long L = (long)i * G + c;
        if (L < 1024) return so.next(i, u);
        const int j = (int)(L - 1024); if (j >= 80) return false;
        const int q = j % 10; u.pm = 64 + j / 10; u.pn = q < 4 ? 2 + q : 4 + q;
        return true;
    }
    __device__ __forceinline__ void a_ready(const pg8::Unit&) const {}
    __device__ __forceinline__ void done(const pg8::Unit&) const {}
};
struct EpiInProj8 {
    static constexpr bool PERM = true, AFTER_DRAIN = false;
    unsigned char* ws;
    __device__ __forceinline__ void operator()(const f32x4 (&acc)[2][2][4][2], const pg8::Unit& u, int wr, int wc, int fr, int fq) const {
#pragma unroll
        for (int bj = 0; bj < 2; ++bj) {
            const int c0 = u.pn * 256 + bj * 128 + wc * 32 + 8 * fq, seg = c0 >> 9, c = c0 & 511;
#pragma unroll
            for (int ai = 0; ai < 2; ++ai)
#pragma unroll
                for (int m = 0; m < 4; ++m) {
                    const int row = u.pm * 256 + ai * 128 + wr * 64 + m * 16 + fr;
                    f32x4 v0 = acc[ai][bj][m][0], v1 = acc[ai][bj][m][1];
                    if (seg == 2 || seg == 6) {
                        bf16_t* vt = (bf16_t*)(ws + (seg == 2 ? WS_NAV : WS_HI));
                        const int hd = seg == 2 ? 64 : 128, nh = 512 / hd, hh = c / hd, dim = c % hd;
                        bf16_t* q; size_t st;
                        if (row < MT) { const int b = row >> 11, s = row & 2047; q = vt + ((size_t)((b * nh + hh) * hd + dim)) * 2048 + s; st = 2048; }
                        else { const int mm = row - MT, b = mm >> 8, j = mm & 255; q = vt + (size_t)MT * 512 + ((size_t)((b * nh + hh) * hd + dim)) * 256 + j; st = 256; }
#pragma unroll
                        for (int e = 0; e < 4; ++e) { q[e * st] = f2bf(v0[e]); q[(4 + e) * st] = f2bf(v1[e]); }
                    } else {
                        if (seg == 0) { v0 = v0 * 0.125f; v1 = v1 * 0.125f; }
                        if (seg == 4 || seg == 5) {
                            const float* lbp = (const float*)(ws + WS_LB) + (seg - 4) * 512 + c;
                            const f32x4 l0 = *(const f32x4*)lbp, l1 = *(const f32x4*)(lbp + 4);
#pragma unroll
                            for (int e = 0; e < 4; ++e) {
                                v0[e] = __builtin_amdgcn_logf(l0[e] + (1.f - l0[e]) * __builtin_amdgcn_rcpf(1.f + __builtin_amdgcn_exp2f(-1.44269504f * v0[e])));
                                v1[e] = __builtin_amdgcn_logf(l1[e] + (1.f - l1[e]) * __builtin_amdgcn_rcpf(1.f + __builtin_amdgcn_exp2f(-1.44269504f * v1[e])));
                            }
                        }
                        if (seg == 3 || seg == 7) {
#pragma unroll
                            for (int e = 0; e < 4; ++e) { v0[e] = silu_f(v0[e]); v1[e] = silu_f(v1[e]); }
                        }
                        const size_t wsoff = seg == 0 ? WS_NAQ : seg == 1 ? WS_NAK : seg == 3 ? WS_HQ : seg == 4 ? WS_ZF : seg == 5 ? WS_ZB : seg == 6 ? WS_HI : WS_HG;
                        u32x4 w; w[0] = pack2(v0[0], v0[1]); w[1] = pack2(v0[2], v0[3]); w[2] = pack2(v1[0], v1[1]); w[3] = pack2(v1[2], v1[3]);
                        *(u32x4*)((bf16_t*)(ws + wsoff) + (size_t)row * 512 + c) = w;
                    }
                }
        }
    }
};
struct EpiOutProj8 {
    static constexpr bool PERM = false, AFTER_DRAIN = false;
    const float* x; const float* mod; float* out;
    __device__ __forceinline__ void operator()(const f32x4 (&acc)[2][2][4][2], const pg8::Unit& u, int wr, int wc, int fr, int fq) const {
        const int row0 = u.pm * 256 + wr * 64 + fr, col0 = u.pn * 256 + wc * 32 + 4 * fq;
        const int b = (u.pm * 256) / NS;
        f32x4 gv[2][2];
#pragma unroll
        for (int bj = 0; bj < 2; ++bj)
#pragma unroll
            for (int n = 0; n < 2; ++n) gv[bj][n] = *(const f32x4*)(mod + b * 6144 + 2048 + col0 + bj * 128 + n * 16);
#pragma unroll
        for (int ai = 0; ai < 2; ++ai)
#pragma unroll
            for (int m = 0; m < 4; ++m) {
                const size_t ro = (size_t)(row0 + ai * 128 + m * 16) * ND + col0;
#pragma unroll
                for (int bj = 0; bj < 2; ++bj)
#pragma unroll
                    for (int n = 0; n < 2; ++n) *(f32x4*)(out + ro + bj * 128 + n * 16) = *(const f32x4*)(x + ro + bj * 128 + n * 16) + gv[bj][n] * acc[ai][bj][m][n];
            }
    }
};
struct EpiPq8 {
    static constexpr bool PERM = true, AFTER_DRAIN = false;
    bf16_t* pq;
    __device__ __forceinline__ void operator()(const f32x4 (&acc)[2][2][4][2], const pg8::Unit& u, int wr, int wc, int fr, int fq) const {
#pragma unroll
        for (int ai = 0; ai < 2; ++ai)
#pragma unroll
            for (int m = 0; m < 4; ++m)
#pragma unroll
                for (int bj = 0; bj < 2; ++bj) {
                    const f32x4 v0 = acc[ai][bj][m][0], v1 = acc[ai][bj][m][1];
                    u32x4 w; w[0] = pack2(v0[0], v0[1]); w[1] = pack2(v0[2], v0[3]); w[2] = pack2(v1[0], v1[1]); w[3] = pack2(v1[2], v1[3]);
                    *(u32x4*)(pq + (size_t)(u.pm * 256 + ai * 128 + wr * 64 + m * 16 + fr) * 2048 + u.pn * 256 + bj * 128 + wc * 32 + 8 * fq) = w;
                }
    }
};
__device__ __forceinline__ void inproj8_phase(const Params& p, unsigned char* lds) {
    pg8::Gemm g{(const bf16_t*)(p.ws + WS_XN), (const bf16_t*)(p.ws + WS_WIN), MA, NIN, ND};
    InProjOrder S; S.init((int)gridDim.x, (int)blockIdx.x);
    EpiInProj8 E{p.ws};
    pg8::gemm_phase<EpiInProj8, InProjOrder>((PG8_LAS unsigned char*)lds, g, S, E, nullptr);
    const int G = (int)gridDim.x, nidle = G > 80 ? G - 80 : G;
    if (G <= 80 || (int)blockIdx.x >= 80) convert_uv_fp6(p.pu, p.pv, p.ws + WS_U, G > 80 ? (int)blockIdx.x - 80 : (int)blockIdx.x, nidle);
}
__device__ __forceinline__ void outproj8_phase(const Params& p, unsigned char* lds) {
    pg8::Gemm g{(const bf16_t*)(p.ws + WS_XN), (const bf16_t*)(p.ws + WS_WOUT), MT, ND, ND};
    pg8::StaticOrder S; S.init(MT, ND, (int)gridDim.x, (int)blockIdx.x);
    EpiOutProj8 E{p.x, (const float*)(p.ws + WS_MOD), p.out};
    pg8::gemm_phase<EpiOutProj8, pg8::StaticOrder>((PG8_LAS unsigned char*)lds, g, S, E, nullptr);
}
__device__ __forceinline__ void pq8_phase(const Params& p, unsigned char* lds) {
    pg8::Gemm g{(const bf16_t*)(p.ws + WS_XN), (const bf16_t*)(p.ws + WS_WQ), MT, 2048, ND};
    pg8::StaticOrder S; S.init(MT, 2048, (int)gridDim.x, (int)blockIdx.x);
    EpiPq8 E{(bf16_t*)(p.ws + WS_PQ)};
    pg8::gemm_phase<EpiPq8, pg8::StaticOrder>((PG8_LAS unsigned char*)lds, g, S, E, nullptr);
}

template <class Epi>
__device__ __forceinline__ void gemm_tile(const bf16_t* __restrict__ A, int lda, const bf16_t* __restrict__ Bt, int ldb, int K, int m0, int n0, unsigned char* lds, const Epi& epi) {
    unsigned char* As = lds; unsigned char* Bs = lds + 32768;
    const int tid = threadIdx.x, lane = tid & 63, wave = tid >> 6;
    const int wm = wave >> 1, wn = wave & 1;
    const int lr = tid >> 3, lc = tid & 7;
    const int fr = lane & 15, fq = lane >> 4;
    f32x4 acc[4][4];
#pragma unroll
    for (int i = 0; i < 4; ++i)
#pragma unroll
        for (int j = 0; j < 4; ++j) acc[i][j] = (f32x4){0.f, 0.f, 0.f, 0.f};
    u32x4 ra[4], rb[2];
    const bf16_t* Ap = A + (size_t)(m0 + lr) * lda + lc * 8;
    const bf16_t* Bp = Bt + (size_t)(n0 + lr) * ldb + lc * 8;
#pragma unroll
    for (int i = 0; i < 4; ++i) ra[i] = *(const u32x4*)(Ap + (size_t)(i * 64) * lda);
#pragma unroll
    for (int i = 0; i < 2; ++i) rb[i] = *(const u32x4*)(Bp + (size_t)(i * 64) * ldb);
    const int nkt = K / 64;
    for (int kt = 0; kt < nkt; ++kt) {
#pragma unroll
        for (int i = 0; i < 4; ++i) { const int r = lr + i * 64; *(u32x4*)(As + r * 128 + ((lc ^ (r & 7)) << 4)) = ra[i]; }
#pragma unroll
        for (int i = 0; i < 2; ++i) { const int r = lr + i * 64; *(u32x4*)(Bs + r * 128 + ((lc ^ (r & 7)) << 4)) = rb[i]; }
        __syncthreads();
        if (kt + 1 < nkt) {
            const int k0 = (kt + 1) * 64;
#pragma unroll
            for (int i = 0; i < 4; ++i) ra[i] = *(const u32x4*)(Ap + (size_t)(i * 64) * lda + k0);
#pragma unroll
            for (int i = 0; i < 2; ++i) rb[i] = *(const u32x4*)(Bp + (size_t)(i * 64) * ldb + k0);
        }
#pragma unroll
        for (int kk = 0; kk < 2; ++kk) {
            const int ch = kk * 4 + fq;
            bf16x8 fa[4], fb[4];
#pragma unroll
            for (int i = 0; i < 4; ++i) { const int r = wm * 64 + i * 16 + fr; fa[i] = *(const bf16x8*)(As + r * 128 + ((ch ^ (r & 7)) << 4)); }
#pragma unroll
            for (int j = 0; j < 4; ++j) { const int r = wn * 64 + j * 16 + fr; fb[j] = *(const bf16x8*)(Bs + r * 128 + ((ch ^ (r & 7)) << 4)); }
#pragma unroll
            for (int i = 0; i < 4; ++i)
#pragma unroll
                for (int j = 0; j < 4; ++j) acc[i][j] = __builtin_amdgcn_mfma_f32_16x16x32_bf16(fb[j], fa[i], acc[i][j], 0, 0, 0);
        }
        __syncthreads();
    }
#pragma unroll
    for (int i = 0; i < 4; ++i)
#pragma unroll
        for (int j = 0; j < 4; ++j) epi(m0 + wm * 64 + i * 16 + fr, n0 + wn * 64 + j * 16 + fq * 4, acc[i][j]);
}

__device__ __forceinline__ void store_bf16x4(bf16_t* dst, const f32x4& v) { u32x2 o; o.x = pack2(v[0], v[1]); o.y = pack2(v[2], v[3]); *(u32x2*)dst = o; }

struct EpiInProj {
    unsigned char* ws;
    __device__ __forceinline__ void operator()(int m, int n, const f32x4& v) const {
        const int seg = n >> 9, c = n & 511;
        const size_t o = (size_t)m * 512 + c;
        switch (seg) {
            case 0: { f32x4 s = v * 0.125f; store_bf16x4((bf16_t*)(ws + WS_NAQ) + o, s); break; }
            case 1: store_bf16x4((bf16_t*)(ws + WS_NAK) + o, v); break;
            case 2: {
                bf16_t* vt = (bf16_t*)(ws + WS_NAV); const int hh = c >> 6, dim = c & 63;
                if (m < MT) { const int b = m >> 11, s = m & 2047; bf16_t* q = vt + ((size_t)((b * 8 + hh) * 64 + dim)) * 2048 + s;
                    q[0] = f2bf(v[0]); q[2048] = f2bf(v[1]); q[4096] = f2bf(v[2]); q[6144] = f2bf(v[3]); }
                else { const int mm = m - MT, b = mm >> 8, j = mm & 255; bf16_t* q = vt + (size_t)MT * 512 + ((size_t)((b * 8 + hh) * 64 + dim)) * 256 + j;
                    q[0] = f2bf(v[0]); q[256] = f2bf(v[1]); q[512] = f2bf(v[2]); q[768] = f2bf(v[3]); }
                break; }
            case 3: { f32x4 s; s[0] = silu_f(v[0]); s[1] = silu_f(v[1]); s[2] = silu_f(v[2]); s[3] = silu_f(v[3]); store_bf16x4((bf16_t*)(ws + WS_HQ) + o, s); break; }
            case 4: store_bf16x4((bf16_t*)(ws + WS_ZF) + o, v); break;
            case 5: store_bf16x4((bf16_t*)(ws + WS_ZB) + o, v); break;
            case 6: store_bf16x4((bf16_t*)(ws + WS_HI) + o, v); break;
            default: { f32x4 s; s[0] = silu_f(v[0]); s[1] = silu_f(v[1]); s[2] = silu_f(v[2]); s[3] = silu_f(v[3]); store_bf16x4((bf16_t*)(ws + WS_HG) + o, s); break; }
        }
    }
};
__device__ __forceinline__ void inproj_phase(const Params& p, unsigned char* lds) {
    const bf16_t* A = (const bf16_t*)(p.ws + WS_XN); const bf16_t* Bt = (const bf16_t*)(p.ws + WS_WIN);
    EpiInProj epi{p.ws};
    const int nlat = 64 * 32, nctx = 8 * 20;
    for (int unit = blockIdx.x; unit < nlat + nctx; unit += gridDim.x) {
        int mt, nt;
        if (unit < nlat) { mt = unit >> 5; nt = unit & 31; }
        else { const int u = unit - nlat; mt = 64 + u / 20; const int q = u % 20; nt = q < 8 ? 4 + q : 16 + (q - 8); }
        gemm_tile(A, ND, Bt, ND, ND, mt * 256, nt * 128, lds, epi);
    }
}

struct EpiOutProj {
    const float* x; const float* mod; float* out;
    __device__ __forceinline__ void operator()(int m, int n, const f32x4& v) const {
        const int b = m / NS;
        const f32x4 xv = *(const f32x4*)(x + (size_t)m * ND + n), g = *(const f32x4*)(mod + b * 6144 + 2048 + n);
        *(f32x4*)(out + (size_t)m * ND + n) = xv + g * v;
    }
};
__device__ __forceinline__ void outproj_phase(const Params& p, unsigned char* lds) {
    const bf16_t* A = (const bf16_t*)(p.ws + WS_XN); const bf16_t* Bt = (const bf16_t*)(p.ws + WS_WOUT);
    EpiOutProj epi{p.x, (const float*)(p.ws + WS_MOD), p.out};
    for (int unit = blockIdx.x; unit < 64 * 8; unit += gridDim.x) gemm_tile(A, ND, Bt, ND, ND, (unit >> 3) * 256, (unit & 7) * 128, lds, epi);
}
struct EpiPq { bf16_t* pq; __device__ __forceinline__ void operator()(int m, int n, const f32x4& v) const { store_bf16x4(pq + (size_t)m * 2048 + n, v); } };
__device__ __forceinline__ void pq_phase(const Params& p, unsigned char* lds) {
    const bf16_t* A = (const bf16_t*)(p.ws + WS_XN); const bf16_t* Bt = (const bf16_t*)(p.ws + WS_WQ);
    EpiPq epi{(bf16_t*)(p.ws + WS_PQ)};
    for (int unit = blockIdx.x; unit < 64 * 16; unit += gridDim.x) gemm_tile(A, ND, Bt, ND, ND, (unit >> 4) * 256, (unit & 15) * 128, lds, epi);
}

__device__ __forceinline__ void na_naive_phase(const Params& p) {
    const bf16_t* Q = (const bf16_t*)(p.ws + WS_NAQ); const bf16_t* Kk = (const bf16_t*)(p.ws + WS_NAK); const bf16_t* V = (const bf16_t*)(p.ws + WS_NAV);
    bf16_t* mix = (bf16_t*)(p.ws + WS_XN);
    const int tid = threadIdx.x;
    for (int unit = blockIdx.x; unit < MT / 64; unit += gridDim.x) {
        const int tok = unit * 64 + (tid >> 3), h = tid & 7;
        const int b = tok / NS, s = tok % NS, r = s >> 6, qc = s & 63;
        const int rs = min(max(r - 4, 0), NROWS - 8), cs = min(max(qc - 8, 0), GW - 16);
        float q[64], o[64];
        {
            const u32x4* qp = (const u32x4*)(Q + (size_t)tok * 512 + h * 64);
#pragma unroll
            for (int i = 0; i < 8; ++i) { const u32x4 w = qp[i];
#pragma unroll
                for (int e = 0; e < 4; ++e) { q[i * 8 + e * 2] = bflo(w[e]); q[i * 8 + e * 2 + 1] = bfhi(w[e]); } }
        }
#pragma unroll
        for (int i = 0; i < 64; ++i) o[i] = 0.f;
        float mx = -1e30f, l = 0.f;
        for (int it = 0; it < 128 + 256; ++it) {
            int kt; float bias = 0.f;
            if (it < 128) { const int kr = it >> 4, kc = it & 15; kt = b * NS + (rs + kr) * 64 + cs + kc; bias = p.rpb[h * 15 * 31 + (rs + kr - r + 7) * 31 + (cs + kc - qc + 15)]; }
            else kt = MT + b * NL + (it - 128);
            const u32x4* kp = (const u32x4*)(Kk + (size_t)kt * 512 + h * 64);
            float d = 0.f;
#pragma unroll
            for (int i = 0; i < 8; ++i) { const u32x4 w = kp[i];
#pragma unroll
                for (int e = 0; e < 4; ++e) { d += q[i * 8 + e * 2] * bflo(w[e]); d += q[i * 8 + e * 2 + 1] * bfhi(w[e]); } }
            d += bias;
            const float mn = fmaxf(mx, d), sc = __expf(mx - mn), pe = __expf(d - mn);
            l = l * sc + pe; mx = mn;
            const u32x4* vp = (const u32x4*)(V + (size_t)kt * 512 + h * 64);
#pragma unroll
            for (int i = 0; i < 8; ++i) { const u32x4 w = vp[i];
#pragma unroll
                for (int e = 0; e < 4; ++e) { o[i * 8 + e * 2] = o[i * 8 + e * 2] * sc + pe * bflo(w[e]); o[i * 8 + e * 2 + 1] = o[i * 8 + e * 2 + 1] * sc + pe * bfhi(w[e]); } }
        }
        const float inv = 1.f / l;
        u32x4* op = (u32x4*)(mix + (size_t)tok * ND + h * 64);
#pragma unroll
        for (int i = 0; i < 8; ++i) { u32x4 w;
#pragma unroll
            for (int e = 0; e < 4; ++e) w[e] = pack2(o[i * 8 + e * 2] * inv, o[i * 8 + e * 2 + 1] * inv);
            op[i] = w; }
    }
}

__device__ __forceinline__ void na_mfma_phase(const Params& p, float* rpbL, int blk, int nblk) {
    const bf16_t* Q = (const bf16_t*)(p.ws + WS_NAQ); const bf16_t* Kk = (const bf16_t*)(p.ws + WS_NAK); const bf16_t* VT = (const bf16_t*)(p.ws + WS_NAV);
    bf16_t* mix = (bf16_t*)(p.ws + WS_XN);
    const int tid = threadIdx.x, lane = tid & 63, wave = tid >> 6, fr = lane & 15, fq = lane >> 4;
    for (int i = tid; i < 8 * 15 * 31; i += NT) rpbL[i] = p.rpb[i];
    __syncthreads();
    for (int bu = blk; bu < 1024; bu += nblk) {
        const int u = bu * 8 + wave;
        const int cb = u & 3, r = (u >> 2) & 31, h = (u >> 7) & 7, b = u >> 10;
        const int rs = min(max(r - 4, 0), NROWS - 8), kc0 = min(max(cb * 16 - 8, 0), GW - 32);
        const int qc = cb * 16 + fr, cs = min(max(qc - 8, 0), GW - 16);
        const size_t qtok = (size_t)b * NS + r * 64 + qc;
        const bf16x8 q0 = *(const bf16x8*)(Q + qtok * 512 + h * 64 + fq * 8), q1 = *(const bf16x8*)(Q + qtok * 512 + h * 64 + 32 + fq * 8);
        f32x4 o[4];
#pragma unroll
        for (int mt = 0; mt < 4; ++mt) o[mt] = (f32x4){0.f, 0.f, 0.f, 0.f};
        float mx = -1e30f, l = 0.f;
#pragma unroll 1
        for (int g = 0; g < 4; ++g) {
            const bool win = g < 2;
            f32x4 s[8];
#pragma unroll
            for (int tl = 0; tl < 8; ++tl) {
                const size_t kt = win ? (size_t)b * NS + (rs + g * 4 + (tl >> 1)) * 64 + kc0 + (tl & 1) * 16 + fr : (size_t)MT + b * NL + ((g - 2) * 8 + tl) * 16 + fr;
                const bf16x8 k0 = *(const bf16x8*)(Kk + kt * 512 + h * 64 + fq * 8), k1 = *(const bf16x8*)(Kk + kt * 512 + h * 64 + 32 + fq * 8);
                f32x4 acc = (f32x4){0.f, 0.f, 0.f, 0.f};
                acc = __builtin_amdgcn_mfma_f32_16x16x32_bf16(k0, q0, acc, 0, 0, 0);
                acc = __builtin_amdgcn_mfma_f32_16x16x32_bf16(k1, q1, acc, 0, 0, 0);
                s[tl] = acc;
            }
            if (win) {
#pragma unroll
                for (int tl = 0; tl < 8; ++tl) {
                    const int dr = rs + g * 4 + (tl >> 1) - r + 7;
#pragma unroll
                    for (int e = 0; e < 4; ++e) {
                        const int kcol = kc0 + (tl & 1) * 16 + fq * 4 + e;
                        const bool ok = (kcol >= cs) && (kcol < cs + 16);
                        const int dc = min(max(kcol - qc + 15, 0), 30);
                        s[tl][e] = ok ? s[tl][e] + rpbL[h * 465 + dr * 31 + dc] : -1e30f;
                    }
                }
            }
            float gm = -1e30f;
#pragma unroll
            for (int tl = 0; tl < 8; ++tl) gm = fmaxf(gm, fmaxf(fmaxf(s[tl][0], s[tl][1]), fmaxf(s[tl][2], s[tl][3])));
            gm = fmaxf(gm, __shfl_xor(gm, 16)); gm = fmaxf(gm, __shfl_xor(gm, 32));
            const float mn = fmaxf(mx, gm), sc = __expf(mx - mn);
            mx = mn;
            float ls = 0.f;
#pragma unroll
            for (int tl = 0; tl < 8; ++tl)
#pragma unroll
                for (int e = 0; e < 4; ++e) { const float pe = __expf(s[tl][e] - mn); s[tl][e] = pe; ls += pe; }
            l = l * sc + ls;
#pragma unroll
            for (int mt = 0; mt < 4; ++mt) o[mt] = o[mt] * sc;
#pragma unroll
            for (int pl = 0; pl < 4; ++pl) {
                u32x4 pw; pw[0] = pack2(s[2 * pl][0], s[2 * pl][1]); pw[1] = pack2(s[2 * pl][2], s[2 * pl][3]); pw[2] = pack2(s[2 * pl + 1][0], s[2 * pl + 1][1]); pw[3] = pack2(s[2 * pl + 1][2], s[2 * pl + 1][3]);
                const bf16x8 pf = __builtin_bit_cast(bf16x8, pw);
#pragma unroll
                for (int mt = 0; mt < 4; ++mt) {
                    const size_t drow = (size_t)((b * 8 + h) * 64 + mt * 16 + fr);
                    const bf16_t* vp = win ? VT + drow * 2048 + (rs + g * 4 + pl) * 64 + kc0 + fq * 4 : VT + (size_t)MT * 512 + drow * 256 + ((g - 2) * 4 + pl) * 32 + fq * 4;
                    const u32x2 va = *(const u32x2*)vp, vb = *(const u32x2*)(vp + 16);
                    u32x4 vw; vw[0] = va[0]; vw[1] = va[1]; vw[2] = vb[0]; vw[3] = vb[1];
                    o[mt] = __builtin_amdgcn_mfma_f32_16x16x32_bf16(__builtin_bit_cast(bf16x8, vw), pf, o[mt], 0, 0, 0);
                }
            }
        }
        l += __shfl_xor(l, 16); l += __shfl_xor(l, 32);
        const float inv = 1.f / l;
#pragma unroll
        for (int mt = 0; mt < 4; ++mt)
            *(u32x2*)(mix + qtok * ND + h * 64 + mt * 16 + fq * 4) = (u32x2){pack2(o[mt][0] * inv, o[mt][1] * inv), pack2(o[mt][2] * inv, o[mt][3] * inv)};
    }
}

constexpr int NA_KW = 0, NA_VW = 73728, NA_CK = 0, NA_CV = 32768, NA_RPB = 148480, NA_VWS = 1168, NA_CVS = 528;
template <bool WIN>
__device__ __forceinline__ void na3_group(const unsigned char* lds, const float* rpbL, int g, int lrow0, int kc0, int fr, int fq, int qc, int cs, int dr0,
                                          const bf16x8& q0, const bf16x8& q1, f32x4 (&o)[4], float& mx, float& l) {
    f32x4 s[8];
    const int sw = fr & 7;
#pragma unroll
    for (int tl = 0; tl < 8; ++tl) {
        const int key = WIN ? (lrow0 + g * 4 + (tl >> 1)) * 64 + kc0 + (tl & 1) * 16 + fr : (g * 8 + tl) * 16 + fr;
        const unsigned char* kb = lds + (WIN ? NA_KW : NA_CK) + key * 128;
        const bf16x8 k0 = *(const bf16x8*)(kb + ((fq ^ sw) << 4)), k1 = *(const bf16x8*)(kb + (((4 + fq) ^ sw) << 4));
        f32x4 acc = (f32x4){0.f, 0.f, 0.f, 0.f};
        acc = __builtin_amdgcn_mfma_f32_16x16x32_bf16(k0, q0, acc, 0, 0, 0);
        acc = __builtin_amdgcn_mfma_f32_16x16x32_bf16(k1, q1, acc, 0, 0, 0);
        s[tl] = acc;
    }
    if (WIN) {
#pragma unroll
        for (int tl = 0; tl < 8; ++tl) {
            const int dr = dr0 + g * 4 + (tl >> 1);
#pragma unroll
            for (int e = 0; e < 4; ++e) {
                const int kcol = kc0 + (tl & 1) * 16 + fq * 4 + e;
                const bool ok = (kcol >= cs) && (kcol < cs + 16);
                const int dc = min(max(kcol - qc + 15, 0), 30);
                s[tl][e] = ok ? s[tl][e] + rpbL[dr * 31 + dc] : -1e30f;
            }
        }
    }
    float gm = -1e30f;
#pragma unroll
    for (int tl = 0; tl < 8; ++tl) gm = fmaxf(gm, fmaxf(fmaxf(s[tl][0], s[tl][1]), fmaxf(s[tl][2], s[tl][3])));
    gm = fmaxf(gm, __shfl_xor(gm, 16)); gm = fmaxf(gm, __shfl_xor(gm, 32));
    const float mn = fmaxf(mx, gm), sc = __expf(mx - mn);
    mx = mn;
    float ls = 0.f;
#pragma unroll
    for (int tl = 0; tl < 8; ++tl)
#pragma unroll
        for (int e = 0; e < 4; ++e) { const float pe = __expf(s[tl][e] - mn); s[tl][e] = pe; ls += pe; }
    l = l * sc + ls;
#pragma unroll
    for (int mt = 0; mt < 4; ++mt) o[mt] = o[mt] * sc;
#pragma unroll
    for (int pl = 0; pl < 4; ++pl) {
        u32x4 pw; pw[0] = pack2(s[2 * pl][0], s[2 * pl][1]); pw[1] = pack2(s[2 * pl][2], s[2 * pl][3]); pw[2] = pack2(s[2 * pl + 1][0], s[2 * pl + 1][1]); pw[3] = pack2(s[2 * pl + 1][2], s[2 * pl + 1][3]);
        const bf16x8 pf = __builtin_bit_cast(bf16x8, pw);
#pragma unroll
        for (int mt = 0; mt < 4; ++mt) {
            const unsigned char* vp = WIN ? lds + NA_VW + (mt * 16 + fr) * NA_VWS + ((lrow0 + g * 4 + pl) * 64 + kc0 + fq * 4) * 2
                                          : lds + NA_CV + (mt * 16 + fr) * NA_CVS + ((g * 4 + pl) * 32 + fq * 4) * 2;
            const u32x2 va = *(const u32x2*)vp, vb = *(const u32x2*)(vp + 32);
            u32x4 vw; vw[0] = va[0]; vw[1] = va[1]; vw[2] = vb[0]; vw[3] = vb[1];
            o[mt] = __builtin_amdgcn_mfma_f32_16x16x32_bf16(__builtin_bit_cast(bf16x8, vw), pf, o[mt], 0, 0, 0);
        }
    }
}
__device__ __forceinline__ void na3_phase(const Params& p, unsigned char* lds, int blk, int nblk) {
    const bf16_t* Q = (const bf16_t*)(p.ws + WS_NAQ); const bf16_t* Kk = (const bf16_t*)(p.ws + WS_NAK); const bf16_t* VT = (const bf16_t*)(p.ws + WS_NAV);
    bf16_t* mix = (bf16_t*)(p.ws + WS_XN);
    float* rpbL = (float*)(lds + NA_RPB);
    const int tid = threadIdx.x, lane = tid & 63, wave = tid >> 6, fr = lane & 15, fq = lane >> 4;
    const int i0 = (int)(((long)blk * 1024) / nblk), i1 = (int)(((long)(blk + 1) * 1024) / nblk);
    if (i0 >= i1) return;
    const int lch = tid & 7, lrc = tid >> 3;
    u32x4 wk[9], wv[9], ck[4], cv[4];
    int cur_h = -1;
#define NA3_WLOAD(it_) do { const int it__ = (it_); const int bh_ = it__ >> 4, rp_ = it__ & 15, b_ = bh_ >> 3, h_ = bh_ & 7; \
        const int rsA_ = min(max(2 * rp_ - 4, 0), NROWS - 8), rsB_ = min(max(2 * rp_ - 3, 0), NROWS - 8), nr_ = rsB_ + 8 - rsA_; \
        _Pragma("unroll") for (int i = 0; i < 9; ++i) if (i < nr_) { \
            wk[i] = *(const u32x4*)(Kk + ((size_t)b_ * NS + (rsA_ + i) * 64 + lrc) * 512 + h_ * 64 + lch * 8); \
            wv[i] = *(const u32x4*)(VT + ((size_t)((b_ * 8 + h_) * 64 + lrc)) * 2048 + (rsA_ + i) * 64 + lch * 8); } } while (0)
    NA3_WLOAD(i0);
    for (int it = i0; it < i1; ++it) {
        const int bh = it >> 4, rp = it & 15, b = bh >> 3, h = bh & 7;
        const int rsA = min(max(2 * rp - 4, 0), NROWS - 8), rsB = min(max(2 * rp - 3, 0), NROWS - 8), nr = rsB + 8 - rsA;
        const int r = 2 * rp + (wave >> 2), cb = wave & 3;
        const int rs = (wave >> 2) ? rsB : rsA, kc0 = min(max(cb * 16 - 8, 0), GW - 32);
        const int qc = cb * 16 + fr, cs = min(max(qc - 8, 0), GW - 16);
        const size_t qtok = (size_t)b * NS + r * 64 + qc;
        __syncthreads();
        if (h != cur_h) { for (int i = tid; i < 465; i += NT) rpbL[i] = p.rpb[h * 465 + i]; cur_h = h; }
#pragma unroll
        for (int i = 0; i < 9; ++i) if (i < nr) {
            const int key = i * 64 + lrc;
            *(u32x4*)(lds + NA_KW + key * 128 + ((lch ^ (key & 7)) << 4)) = wk[i];
            *(u32x4*)(lds + NA_VW + lrc * NA_VWS + i * 128 + lch * 16) = wv[i];
        }
#pragma unroll
        for (int i = 0; i < 4; ++i) {
            const int c = tid + i * NT;
            ck[i] = *(const u32x4*)(Kk + ((size_t)MT + b * NL + (c >> 3)) * 512 + h * 64 + (c & 7) * 8);
            cv[i] = *(const u32x4*)(VT + (size_t)MT * 512 + ((size_t)((b * 8 + h) * 64 + (c >> 5))) * 256 + (c & 31) * 8);
        }
        const bf16x8 q0 = *(const bf16x8*)(Q + qtok * 512 + h * 64 + fq * 8), q1 = *(const bf16x8*)(Q + qtok * 512 + h * 64 + 32 + fq * 8);
        __syncthreads();
        f32x4 o[4];
#pragma unroll
        for (int mt = 0; mt < 4; ++mt) o[mt] = (f32x4){0.f, 0.f, 0.f, 0.f};
        float mx = -1e30f, l = 0.f;
#pragma unroll 1
        for (int g = 0; g < 2; ++g) na3_group<true>(lds, rpbL, g, rs - rsA, kc0, fr, fq, qc, cs, rs - r + 7, q0, q1, o, mx, l);
        __syncthreads();
#pragma unroll
        for (int i = 0; i < 4; ++i) {
            const int c = tid + i * NT;
            const int key = c >> 3;
            *(u32x4*)(lds + NA_CK + key * 128 + (((c & 7) ^ (key & 7)) << 4)) = ck[i];
            *(u32x4*)(lds + NA_CV + (c >> 5) * NA_CVS + (c & 31) * 16) = cv[i];
        }
        if (it + 1 < i1) NA3_WLOAD(it + 1);
        __syncthreads();
#pragma unroll 1
        for (int g = 0; g < 2; ++g) na3_group<false>(lds, rpbL, g, 0, 0, fr, fq, qc, cs, 0, q0, q1, o, mx, l);
        l += __shfl_xor(l, 16); l += __shfl_xor(l, 32);
        const float inv = 1.f / l;
#pragma unroll
        for (int mt = 0; mt < 4; ++mt)
            *(u32x2*)(mix + qtok * ND + h * 64 + mt * 16 + fq * 4) = (u32x2){pack2(o[mt][0] * inv, o[mt][1] * inv), pack2(o[mt][2] * inv, o[mt][3] * inv)};
    }
#undef NA3_WLOAD
}

__device__ __forceinline__ void hg_naive_phase(const Params& p) {
    const bf16_t* HQ = (const bf16_t*)(p.ws + WS_HQ); const bf16_t* HI = (const bf16_t*)(p.ws + WS_HI);
    const float* lbp = (const float*)(p.ws + WS_LB);
    const int tid = threadIdx.x, vl = tid >> 4, dsl = tid & 15;
    for (int unit = blockIdx.x; unit < NB * 4 * 2 * 4; unit += gridDim.x) {
        const int vs = unit & 3, dir = (unit >> 2) & 1, h = (unit >> 3) & 3, b = unit >> 5;
        const bf16_t* Z = (const bf16_t*)(p.ws + (dir ? WS_ZB : WS_ZF));
        float* O = p.out + (size_t)dir * MT * 512;
        const int v = vs * 32 + vl, d0 = dsl * 8;
        float lb[8], S[8];
#pragma unroll
        for (int e = 0; e < 8; ++e) { lb[e] = lbp[dir * 512 + h * 128 + d0 + e]; S[e] = 0.f; }
        for (int step = 0; step < NL + NS; ++step) {
            const bool isctx = step < NL;
            int t = isctx ? step : step - NL;
            if (dir) t = (isctx ? NL : NS) - 1 - t;
            const size_t row = isctx ? (size_t)MT + b * NL + t : (size_t)b * NS + t;
            const u32x4 zw = *(const u32x4*)(Z + row * 512 + h * 128 + d0);
            const float vv = bf2f(HI[row * 512 + h * 128 + v]);
            float z[8];
#pragma unroll
            for (int e = 0; e < 4; ++e) { z[e * 2] = bflo(zw[e]); z[e * 2 + 1] = bfhi(zw[e]); }
#pragma unroll
            for (int e = 0; e < 8; ++e) { const float f = lb[e] + (1.f - lb[e]) * sigmoid_f(z[e]); S[e] = f * S[e] + (1.f - f) * vv; }
            if (!isctx) {
                const u32x4 qw = *(const u32x4*)(HQ + row * 512 + h * 128 + d0);
                float acc = 0.f;
#pragma unroll
                for (int e = 0; e < 4; ++e) { acc += bflo(qw[e]) * S[e * 2]; acc += bfhi(qw[e]) * S[e * 2 + 1]; }
                acc += __shfl_xor(acc, 1); acc += __shfl_xor(acc, 2); acc += __shfl_xor(acc, 4); acc += __shfl_xor(acc, 8);
                if (dsl == 0) O[row * 512 + h * 128 + v] = acc;
            }
        }
    }
}

__device__ __forceinline__ int swz8(int row) { return (((row >> 3) & 1) ^ row) & 7; }
__device__ __forceinline__ bf16x8 ld256(const unsigned char* base, int row, int ch) { return *(const bf16x8*)(base + row * 256 + (((ch ^ row) & 15) << 4)); }
__device__ __forceinline__ bf16x8 ld128(const unsigned char* base, int row, int ch) { return *(const bf16x8*)(base + row * 128 + ((ch ^ swz8(row)) << 4)); }
constexpr int HG_LDS = 157696;
__device__ __forceinline__ size_t hg_row(int ci, int t, int b, int dir) {
    const bool isctx = ci < 4; const int lc = isctx ? ci : ci - 4, T = isctx ? NL : NS; const size_t base = isctx ? (size_t)MT + b * NL : (size_t)b * NS;
    const int pos = lc * 64 + t; return dir ? base + T - 1 - pos : base + pos;
}
__device__ __forceinline__ void hg_chain(const Params& p, unsigned char* lds, int unit, int seg) {
    const int tid = threadIdx.x, lane = tid & 63, wave = tid >> 6, fr = lane & 15, fq = lane >> 4;
    const int dir = unit & 1, h = (unit >> 1) & 3, b = unit >> 3;
    float* BF = (float*)lds;
    unsigned char* QT = lds + 32768;
    unsigned char* QH = lds + 49152;
    unsigned char* KT = lds + 65536;
    unsigned char* KBT = lds + 81920;
    unsigned char* VT = lds + 98304;
    unsigned char* PP = lds + 114688;
    unsigned char* SB = lds + 122880;
    float* TOT = (float*)(lds + 155648);
    const bf16_t* HQ = (const bf16_t*)(p.ws + WS_HQ); const bf16_t* HIT = (const bf16_t*)(p.ws + WS_HI);
    const bf16_t* Z = (const bf16_t*)(p.ws + (dir ? WS_ZB : WS_ZF));
    float* O = p.out + (size_t)dir * MT * 512;
    const int bt = tid >> 3, bg = tid & 7;
    const int vdv = tid >> 2, vpart = tid & 3;
    int o256[4], o128[2];
#pragma unroll
    for (int kd = 0; kd < 4; ++kd) o256[kd] = fr * 256 + ((((kd * 4 + fq) ^ fr) & 15) << 4);
#pragma unroll
    for (int ks = 0; ks < 2; ++ks) o128[ks] = fr * 128 + ((((ks * 4 + fq) ^ swz8(fr)) & 7) << 4);
    for (int i = tid; i < (8192 + 32768) / 16; i += NT) *(u32x4*)(PP + i * 16) = (u32x4){0u, 0u, 0u, 0u};
    f32x4 accS[8];
#pragma unroll
    for (int i = 0; i < 8; ++i) accS[i] = (f32x4){0.f, 0.f, 0.f, 0.f};
    u32x4 zr[2], qr[2], vr[2];
#define HG_LOAD(ci_) do { const int ci__ = (ci_); const bool cx = ci__ < 4; const size_t r = hg_row(ci__, bt, b, dir); \
        _Pragma("unroll") for (int g = 0; g < 2; ++g) { const size_t o = r * 512 + h * 128 + g * 64 + bg * 8; zr[g] = *(const u32x4*)(Z + o); qr[g] = cx ? (u32x4){0u, 0u, 0u, 0u} : *(const u32x4*)(HQ + o); } \
        const int lc = cx ? ci__ : ci__ - 4, T = cx ? NL : NS; const int tok0 = dir ? T - 64 * (lc + 1) : lc * 64; \
        const bf16_t* vp = cx ? HIT + (size_t)MT * 512 + ((size_t)((b * 4 + h) * 128 + vdv)) * 256 + tok0 + vpart * 16 : HIT + ((size_t)((b * 4 + h) * 128 + vdv)) * 2048 + tok0 + vpart * 16; \
        vr[0] = *(const u32x4*)vp; vr[1] = *(const u32x4*)(vp + 8); } while (0)
    const int cbeg = seg * 18, cend = cbeg + 18;
    bf16_t* QHC = (bf16_t*)(p.ws + WS_QHC) + (size_t)unit * 18 * 64 * 128;
    float* CUM = (float*)(lds + 157696);
    if (tid < 128) CUM[tid] = 0.f;
    HG_LOAD(cbeg);
    __syncthreads();
#pragma unroll 1
    for (int ci = cbeg; ci < cend; ++ci) {
        const bool isctx = ci < 4;
#pragma unroll
        for (int g = 0; g < 2; ++g) {
            *(f32x4*)(BF + bt * 128 + g * 64 + bg * 8) = (f32x4){bflo(zr[g][0]), bfhi(zr[g][0]), bflo(zr[g][1]), bfhi(zr[g][1])};
            *(f32x4*)(BF + bt * 128 + g * 64 + bg * 8 + 4) = (f32x4){bflo(zr[g][2]), bfhi(zr[g][2]), bflo(zr[g][3]), bfhi(zr[g][3])};
            const int pc = vpart * 2 + g;
            u32x4 w = vr[g];
            if (dir) { w = (u32x4){__builtin_amdgcn_alignbit(vr[g][3], vr[g][3], 16), __builtin_amdgcn_alignbit(vr[g][2], vr[g][2], 16), __builtin_amdgcn_alignbit(vr[g][1], vr[g][1], 16), __builtin_amdgcn_alignbit(vr[g][0], vr[g][0], 16)}; }
            *(u32x4*)(VT + vdv * 128 + ((((dir ? 7 - pc : pc) ^ swz8(vdv)) & 7) << 4)) = w;
        }
        __syncthreads();
        {
            const int d = tid & 127, I = tid >> 7;
            float v[16];
#pragma unroll
            for (int j = 0; j < 16; ++j) v[j] = BF[(I * 16 + j) * 128 + d];
#pragma unroll
            for (int j = 1; j < 16; ++j) v[j] += v[j - 1];
#pragma unroll
            for (int j = 0; j < 16; ++j) BF[(I * 16 + j) * 128 + d] = v[j];
            TOT[I * 128 + d] = v[15];
        }
        __syncthreads();
#pragma unroll
        for (int g = 0; g < 2; ++g) {
            const int d0 = g * 64 + bg * 8;
            float bl[8], t0[8], t1[8], t2[8], b31[8], cm[8];
#pragma unroll
            for (int q4 = 0; q4 < 2; ++q4) {
                const f32x4 a = *(const f32x4*)(BF + bt * 128 + d0 + q4 * 4), x0 = *(const f32x4*)(TOT + d0 + q4 * 4), x1 = *(const f32x4*)(TOT + 128 + d0 + q4 * 4),
                            x2 = *(const f32x4*)(TOT + 256 + d0 + q4 * 4), m = *(const f32x4*)(BF + 31 * 128 + d0 + q4 * 4), m63 = *(const f32x4*)(CUM + d0 + q4 * 4);
#pragma unroll
                for (int e = 0; e < 4; ++e) { bl[q4 * 4 + e] = a[e]; t0[q4 * 4 + e] = x0[e]; t1[q4 * 4 + e] = x1[e]; t2[q4 * 4 + e] = x2[e]; b31[q4 * 4 + e] = m[e]; cm[q4 * 4 + e] = m63[e]; }
            }
            const int I = bt >> 4;
            float vq[8], vh[8], vk[8], vc[8];
#pragma unroll
            for (int e = 0; e < 8; ++e) {
                const float off = (I > 0 ? t0[e] : 0.f) + (I > 1 ? t1[e] : 0.f) + (I > 2 ? t2[e] : 0.f);
                const float bte = bl[e] + off, bmid = b31[e] + t0[e];
                const float x = fminf(fmaxf(bte - bmid, -115.f), 115.f);
                const unsigned zw = zr[g][e >> 1], qw = qr[g][e >> 1];
                const float qv = (e & 1) ? bfhi(qw) : bflo(qw), kf = 1.f - __builtin_amdgcn_exp2f((e & 1) ? bfhi(zw) : bflo(zw));
                vq[e] = qv * __builtin_amdgcn_exp2f(x); vh[e] = qv * __builtin_amdgcn_exp2f(bte); vk[e] = kf * __builtin_amdgcn_exp2f(-x);
                vc[e] = qv * __builtin_amdgcn_exp2f(bte + cm[e]);
            }
            if (seg) *(u32x4*)(QHC + ((size_t)(ci - 18) * 64 + bt) * 128 + d0) = (u32x4){pack2(vc[0], vc[1]), pack2(vc[2], vc[3]), pack2(vc[4], vc[5]), pack2(vc[6], vc[7])};
            const int so = bt * 256 + ((((d0 >> 3) ^ bt) & 15) << 4);
            *(u32x4*)(QT + so) = (u32x4){pack2(vq[0], vq[1]), pack2(vq[2], vq[3]), pack2(vq[4], vq[5]), pack2(vq[6], vq[7])};
            *(u32x4*)(QH + so) = (u32x4){pack2(vh[0], vh[1]), pack2(vh[2], vh[3]), pack2(vh[4], vh[5]), pack2(vh[6], vh[7])};
            *(u32x4*)(KT + so) = (u32x4){pack2(vk[0], vk[1]), pack2(vk[2], vk[3]), pack2(vk[4], vk[5]), pack2(vk[6], vk[7])};
        }
        if (ci + 1 < cend) HG_LOAD(ci + 1);
        __syncthreads();
        if (!isctx) {
            for (int n = wave; n < 10; n += 8) {
                const int I = n >= 6 ? 3 : n >= 3 ? 2 : n >= 1 ? 1 : 0, J = n - (I * (I + 1)) / 2;
                f32x4 acc = (f32x4){0.f, 0.f, 0.f, 0.f};
#pragma unroll
                for (int kd = 0; kd < 4; ++kd) acc = __builtin_amdgcn_mfma_f32_16x16x32_bf16(*(const bf16x8*)(KT + J * 4096 + o256[kd]), *(const bf16x8*)(QT + I * 4096 + o256[kd]), acc, 0, 0, 0);
                if (I == J) {
#pragma unroll
                    for (int e = 0; e < 4; ++e) if (fq * 4 + e > fr) acc[e] = 0.f;
                }
                const int t = I * 16 + fr;
                *(u32x2*)(PP + t * 128 + ((((J * 2 + (fq >> 1)) ^ swz8(t)) & 7) << 4) + (fq & 1) * 8) = (u32x2){pack2(acc[0], acc[1]), pack2(acc[2], acc[3])};
            }
        }
        {
            const int d = tid & 127, sg = tid >> 7;
            const float c2 = __builtin_amdgcn_exp2f(BF[63 * 128 + d] + TOT[128 + d] + TOT[256 + d] - BF[31 * 128 + d]);
            if (sg == 0) CUM[d] += BF[63 * 128 + d] + TOT[d] + TOT[128 + d] + TOT[256 + d];
            const unsigned char* kp = KT + sg * 4096 + (d & 7) * 2; const int dh = d >> 3;
            float kv[16];
#pragma unroll
            for (int j = 0; j < 16; ++j) kv[j] = bf2f(*(const bf16_t*)(kp + j * 256 + (((dh ^ j) & 15) << 4))) * c2;
            const int sw = swz8(d);
            *(u32x4*)(KBT + d * 128 + ((((sg * 2) ^ sw) & 7) << 4)) = (u32x4){pack2(kv[0], kv[1]), pack2(kv[2], kv[3]), pack2(kv[4], kv[5]), pack2(kv[6], kv[7])};
            *(u32x4*)(KBT + d * 128 + ((((sg * 2 + 1) ^ sw) & 7) << 4)) = (u32x4){pack2(kv[8], kv[9]), pack2(kv[10], kv[11]), pack2(kv[12], kv[13]), pack2(kv[14], kv[15])};
        }
        __syncthreads();
        if (!isctx) {
            f32x4 acc[4];
#pragma unroll
            for (int tt = 0; tt < 4; ++tt) acc[tt] = (f32x4){0.f, 0.f, 0.f, 0.f};
#pragma unroll
            for (int kd = 0; kd < 4; ++kd) {
                const bf16x8 a = *(const bf16x8*)(SB + wave * 4096 + o256[kd]);
#pragma unroll
                for (int tt = 0; tt < 4; ++tt) acc[tt] = __builtin_amdgcn_mfma_f32_16x16x32_bf16(a, *(const bf16x8*)(QH + tt * 4096 + o256[kd]), acc[tt], 0, 0, 0);
            }
#pragma unroll
            for (int ks = 0; ks < 2; ++ks) {
                const bf16x8 a = *(const bf16x8*)(VT + wave * 2048 + o128[ks]);
#pragma unroll
                for (int tt = 0; tt < 4; ++tt) acc[tt] = __builtin_amdgcn_mfma_f32_16x16x32_bf16(a, *(const bf16x8*)(PP + tt * 2048 + o128[ks]), acc[tt], 0, 0, 0);
            }
#pragma unroll
            for (int tt = 0; tt < 4; ++tt) *(f32x4*)(O + hg_row(ci, tt * 16 + fr, b, dir) * 512 + h * 128 + wave * 16 + fq * 4) = acc[tt];
        }
        {
            const int d4 = wave * 16 + fq * 4;
            const f32x4 l63 = *(const f32x4*)(BF + 63 * 128 + d4), x0 = *(const f32x4*)(TOT + d4), x1 = *(const f32x4*)(TOT + 128 + d4), x2 = *(const f32x4*)(TOT + 256 + d4);
            f32x4 c3;
#pragma unroll
            for (int e = 0; e < 4; ++e) c3[e] = __builtin_amdgcn_exp2f(l63[e] + x0[e] + x1[e] + x2[e]);
            const bf16x8 a0 = *(const bf16x8*)(KBT + wave * 2048 + o128[0]), a1 = *(const bf16x8*)(KBT + wave * 2048 + o128[1]);
#pragma unroll
            for (int vt = 0; vt < 8; ++vt) {
                accS[vt] = accS[vt] * c3;
                accS[vt] = __builtin_amdgcn_mfma_f32_16x16x32_bf16(a0, *(const bf16x8*)(VT + vt * 2048 + o128[0]), accS[vt], 0, 0, 0);
                accS[vt] = __builtin_amdgcn_mfma_f32_16x16x32_bf16(a1, *(const bf16x8*)(VT + vt * 2048 + o128[1]), accS[vt], 0, 0, 0);
            }
        }
        __syncthreads();
#pragma unroll
        for (int vt = 0; vt < 8; ++vt)
            *(u32x2*)(SB + vt * 4096 + fr * 256 + ((((wave * 2 + (fq >> 1)) ^ fr) & 15) << 4) + (fq & 1) * 8) = (u32x2){pack2(accS[vt][0], accS[vt][1]), pack2(accS[vt][2], accS[vt][3])};
    }
#undef HG_LOAD
    if (!seg) {
        bf16_t* S0 = (bf16_t*)(p.ws + WS_S0T) + (size_t)unit * 128 * 128;
#pragma unroll
        for (int vt = 0; vt < 8; ++vt) *(u32x2*)(S0 + (size_t)(vt * 16 + fr) * 128 + wave * 16 + fq * 4) = (u32x2){pack2(accS[vt][0], accS[vt][1]), pack2(accS[vt][2], accS[vt][3])};
    }
    __syncthreads();
}
__device__ __forceinline__ void hg_corr_phase(const Params& p) {
    const int tid = threadIdx.x, lane = tid & 63, wave = tid >> 6, fr = lane & 15, fq = lane >> 4;
    for (int u = blockIdx.x; u < 64 * 18; u += gridDim.x) {
        const int chain = u / 18, cc = u % 18, dir = chain & 1, h = (chain >> 1) & 3, b = chain >> 3;
        const bf16_t* S0 = (const bf16_t*)(p.ws + WS_S0T) + (size_t)chain * 128 * 128;
        const bf16_t* QH = (const bf16_t*)(p.ws + WS_QHC) + ((size_t)chain * 18 + cc) * 64 * 128;
        float* O = p.out + (size_t)dir * MT * 512;
        f32x4 acc[4];
#pragma unroll
        for (int tt = 0; tt < 4; ++tt) acc[tt] = (f32x4){0.f, 0.f, 0.f, 0.f};
#pragma unroll
        for (int kd = 0; kd < 4; ++kd) {
            const bf16x8 a = *(const bf16x8*)(S0 + (size_t)(wave * 16 + fr) * 128 + kd * 32 + fq * 8);
#pragma unroll
            for (int tt = 0; tt < 4; ++tt) acc[tt] = __builtin_amdgcn_mfma_f32_16x16x32_bf16(a, *(const bf16x8*)(QH + (size_t)(tt * 16 + fr) * 128 + kd * 32 + fq * 8), acc[tt], 0, 0, 0);
        }
#pragma unroll
        for (int tt = 0; tt < 4; ++tt) { float* op = O + hg_row(18 + cc, tt * 16 + fr, b, dir) * 512 + h * 128 + wave * 16 + fq * 4; *(f32x4*)op = *(const f32x4*)op + acc[tt]; }
    }
}
__device__ __forceinline__ void hg_chunk_phase(const Params& p, unsigned char* lds) {
    for (int unit = blockIdx.x; unit < 128; unit += gridDim.x) hg_chain(p, lds, unit >> 1, unit & 1);
}

__device__ __forceinline__ void hgmix_phase(const Params& p) {
    const float* OF = p.out; const float* OB = p.out + (size_t)MT * 512;
    const bf16_t* HG = (const bf16_t*)(p.ws + WS_HG);
    bf16_t* mix = (bf16_t*)(p.ws + WS_XN);
    const int tid = threadIdx.x, lane = tid & 63, wave = tid >> 6;
    for (int row = blockIdx.x * 8 + wave; row < MT; row += gridDim.x * 8) {
        const int c0 = lane * 8;
        float o[8]; float ss = 0.f;
        const f32x4 a0 = *(const f32x4*)(OF + (size_t)row * 512 + c0), a1 = *(const f32x4*)(OF + (size_t)row * 512 + c0 + 4);
        const f32x4 b0 = *(const f32x4*)(OB + (size_t)row * 512 + c0), b1 = *(const f32x4*)(OB + (size_t)row * 512 + c0 + 4);
#pragma unroll
        for (int e = 0; e < 4; ++e) { o[e] = a0[e] + b0[e]; o[4 + e] = a1[e] + b1[e]; }
#pragma unroll
        for (int e = 0; e < 8; ++e) ss += o[e] * o[e];
        ss += __shfl_xor(ss, 1); ss += __shfl_xor(ss, 2); ss += __shfl_xor(ss, 4); ss += __shfl_xor(ss, 8);
        const float rstd = rsqrtf(ss * (1.f / 128.f) + EPS);
        const u32x4 gw = *(const u32x4*)(HG + (size_t)row * 512 + c0);
        float r[8];
#pragma unroll
        for (int e = 0; e < 4; ++e) { r[e * 2] = o[e * 2] * rstd * p.hg_norm[c0 + e * 2] * bflo(gw[e]); r[e * 2 + 1] = o[e * 2 + 1] * rstd * p.hg_norm[c0 + e * 2 + 1] * bfhi(gw[e]); }
        u32x4 w; w[0] = pack2(r[0], r[1]); w[1] = pack2(r[2], r[3]); w[2] = pack2(r[4], r[5]); w[3] = pack2(r[6], r[7]);
        *(u32x4*)(mix + (size_t)row * ND + 512 + c0) = w;
    }
}

__device__ __forceinline__ void wave_argmax(float& v, int& i) {
#pragma unroll
    for (int o = 32; o >= 1; o >>= 1) { const float ov = __shfl_xor(v, o); const int oi = __shfl_xor(i, o); if (ov > v || (ov == v && oi < i)) { v = ov; i = oi; } }
}
__device__ __forceinline__ unsigned ukey(float f) { const unsigned u = __float_as_uint(f); return (u & 0x80000000u) ? ~u : (u | 0x80000000u); }
__device__ __forceinline__ float ukey_inv(unsigned u) { return __uint_as_float((u & 0x80000000u) ? (u & 0x7fffffffu) : ~u); }
__device__ __forceinline__ int mbcnt64(unsigned long long m) { return (int)__builtin_amdgcn_mbcnt_hi((unsigned)(m >> 32), __builtin_amdgcn_mbcnt_lo((unsigned)m, 0u)); }
__device__ __forceinline__ void topk_phase(const Params& p, float* lds) {
    constexpr int LDW = 260;
    float* wsv = lds + 64 * LDW + (threadIdx.x >> 6) * 64;
    int* wsi = (int*)(wsv + 32);
    const bf16_t* PQ = (const bf16_t*)(p.ws + WS_PQ); const bf16_t* KEYS = (const bf16_t*)(p.ws + WS_KEYS);
    int* PIDX = (int*)(p.ws + WS_PIDX); float* PG = (float*)(p.ws + WS_PG);
    const int tid = threadIdx.x, lane = tid & 63, wave = tid >> 6, fr = lane & 15, fq = lane >> 4;
    for (int unit = blockIdx.x; unit < (MT / 64) * 8; unit += gridDim.x) {
        const int hp = unit & 7, t0 = (unit >> 3) * 64;
        {
            const int c = wave >> 2, kb = (wave & 3) * 32;
            f32x4 acc[4][2];
#pragma unroll
            for (int i = 0; i < 4; ++i) { acc[i][0] = (f32x4){0.f, 0.f, 0.f, 0.f}; acc[i][1] = (f32x4){0.f, 0.f, 0.f, 0.f}; }
#pragma unroll
            for (int ks = 0; ks < 4; ++ks) {
                bf16x8 fa[4], fb[2];
#pragma unroll
                for (int i = 0; i < 4; ++i) fa[i] = *(const bf16x8*)(PQ + (size_t)(t0 + i * 16 + fr) * 2048 + hp * 256 + c * 128 + ks * 32 + fq * 8);
#pragma unroll
                for (int j = 0; j < 2; ++j) fb[j] = *(const bf16x8*)(KEYS + (size_t)((hp * 2 + c) * 128 + kb + j * 16 + fr) * 128 + ks * 32 + fq * 8);
#pragma unroll
                for (int i = 0; i < 4; ++i)
#pragma unroll
                    for (int j = 0; j < 2; ++j) acc[i][j] = __builtin_amdgcn_mfma_f32_16x16x32_bf16(fa[i], fb[j], acc[i][j], 0, 0, 0);
            }
#pragma unroll
            for (int i = 0; i < 4; ++i)
#pragma unroll
                for (int j = 0; j < 2; ++j)
#pragma unroll
                    for (int e = 0; e < 4; ++e) lds[(i * 16 + fq * 4 + e) * LDW + c * 128 + kb + j * 16 + fr] = acc[i][j][e];
        }
        __syncthreads();
        for (int tt = 0; tt < 8; ++tt) {
            const int tl = wave * 8 + tt;
            const float* row = lds + tl * LDW;
            float a[2][2]; unsigned k[2][2];
#pragma unroll
            for (int c = 0; c < 2; ++c) {
                a[c][0] = row[c * 128 + lane]; a[c][1] = row[c * 128 + 64 + lane];
                k[c][0] = (ukey(a[c][0]) & ~127u) | (unsigned)(127 - lane);
                k[c][1] = (ukey(a[c][1]) & ~127u) | (unsigned)(63 - lane);
            }
            unsigned lo0 = 0u, hi0 = 0xffffffffu, lo1 = 0u, hi1 = 0xffffffffu, T0 = 0u, T1 = 0u; bool d0 = false, d1 = false;
            for (int it = 0; it < 40; ++it) {
                const unsigned m0 = lo0 + ((hi0 - lo0) >> 1), m1 = lo1 + ((hi1 - lo1) >> 1);
                const int c0 = __popcll(__ballot(k[0][0] >= m0)) + __popcll(__ballot(k[0][1] >= m0));
                const int c1 = __popcll(__ballot(k[1][0] >= m1)) + __popcll(__ballot(k[1][1] >= m1));
                if (!d0) { if (c0 == 16) { d0 = true; T0 = m0; } else if (c0 > 16) lo0 = m0; else hi0 = m0; }
                if (!d1) { if (c1 == 16) { d1 = true; T1 = m1; } else if (c1 > 16) lo1 = m1; else hi1 = m1; }
                if (d0 && d1) break;
            }
            if (!d0) T0 = hi0;
            if (!d1) T1 = hi1;
#pragma unroll
            for (int c = 0; c < 2; ++c) {
                const unsigned T = c ? T1 : T0;
                const bool f0 = k[c][0] >= T, f1 = k[c][1] >= T;
                const unsigned long long b0 = __ballot(f0), b1 = __ballot(f1);
                const int s0 = mbcnt64(b0), s1 = __popcll(b0) + mbcnt64(b1);
                if (f0 && s0 < 16) { wsv[c * 16 + s0] = a[c][0]; wsi[c * 16 + s0] = lane; }
                if (f1 && s1 < 16) { wsv[c * 16 + s1] = a[c][1]; wsi[c * 16 + s1] = lane + 64; }
            }
            const float s1v = wsv[lane >> 2]; const int i1 = wsi[lane >> 2];
            const f32x4 s2v = *(const f32x4*)(wsv + 16 + (lane & 3) * 4);
            float cv[4]; unsigned ck[4];
#pragma unroll
            for (int e = 0; e < 4; ++e) { cv[e] = s1v + s2v[e]; ck[e] = (ukey(cv[e]) & ~255u) | (unsigned)(255 - (lane * 4 + e)); }
            unsigned lo = 0u, hi = 0xffffffffu, T = 0u; bool dn = false;
            for (int it = 0; it < 40; ++it) {
                const unsigned m = lo + ((hi - lo) >> 1);
                int c = 0;
#pragma unroll
                for (int e = 0; e < 4; ++e) c += __popcll(__ballot(ck[e] >= m));
                if (c == 16) { dn = true; T = m; break; } else if (c > 16) lo = m; else hi = m;
            }
            if (!dn) T = hi;
            const float Tf = ukey_inv(T & ~255u);
            float ex[4]; float es = 0.f;
#pragma unroll
            for (int e = 0; e < 4; ++e) { ex[e] = (ck[e] >= T) ? __expf(cv[e] - Tf) : 0.f; es += ex[e]; }
            const float inv = 1.f / wave_sum(es);
            const size_t o = ((size_t)(t0 + tl) * 8 + hp) * 16;
            int base = 0;
#pragma unroll
            for (int e = 0; e < 4; ++e) {
                const bool f = ck[e] >= T;
                const unsigned long long bm = __ballot(f);
                const int slot = base + mbcnt64(bm);
                if (f && slot < 16) { PIDX[o + slot] = i1 * 128 + wsi[16 + (lane & 3) * 4 + e]; PG[o + slot] = ex[e] * inv; }
                base += __popcll(bm);
            }
        }
        __syncthreads();
    }
}

__device__ __forceinline__ void ins16(unsigned (&t)[16], unsigned x) {
#pragma unroll
    for (int k = 0; k < 16; ++k) { const unsigned hi = max(t[k], x); x = min(t[k], x); t[k] = hi; }
}
__device__ __forceinline__ void bsort16(unsigned (&a)[16]) {
#pragma unroll
    for (int k = 2; k <= 16; k <<= 1)
#pragma unroll
        for (int j = k >> 1; j > 0; j >>= 1)
#pragma unroll
            for (int i = 0; i < 16; ++i) {
                const int l = i ^ j;
                if (l > i) { const unsigned hi = max(a[i], a[l]), lo = min(a[i], a[l]); if ((i & k) == 0) { a[i] = hi; a[l] = lo; } else { a[i] = lo; a[l] = hi; } }
            }
}
__device__ __forceinline__ void bmerge16(unsigned (&a)[16], const unsigned (&b)[16]) {
#pragma unroll
    for (int i = 0; i < 16; ++i) a[i] = max(a[i], b[15 - i]);
#pragma unroll
    for (int j = 8; j > 0; j >>= 1)
#pragma unroll
        for (int i = 0; i < 16; ++i) { const int l = i ^ j; if (l > i) { const unsigned hi = max(a[i], a[l]), lo = min(a[i], a[l]); a[i] = hi; a[l] = lo; } }
}
__device__ __forceinline__ void topk3_phase(const Params& p, float* lds) {
    constexpr int LDW = 260;
    const bf16_t* PQ = (const bf16_t*)(p.ws + WS_PQ); const bf16_t* KEYS = (const bf16_t*)(p.ws + WS_KEYS);
    int* PIDX = (int*)(p.ws + WS_PIDX); float* PG = (float*)(p.ws + WS_PG);
    int* tab = (int*)(lds + 128 * LDW);
    const int tid = threadIdx.x, lane = tid & 63, wave = tid >> 6, fr = lane & 15, fq = lane >> 4;
    for (int unit = blockIdx.x; unit < (MT / 64) * 4; unit += gridDim.x) {
        const int hp2 = unit & 3, t0 = (unit >> 2) * 64;
        {
            const int hs = wave >> 2, c = (wave >> 1) & 1, kb = (wave & 1) * 64, hp = hp2 * 2 + hs;
            f32x4 acc[4][4];
#pragma unroll
            for (int i = 0; i < 4; ++i)
#pragma unroll
                for (int j = 0; j < 4; ++j) acc[i][j] = (f32x4){0.f, 0.f, 0.f, 0.f};
#pragma unroll
            for (int ks = 0; ks < 4; ++ks) {
                bf16x8 fa[4], fb[4];
#pragma unroll
                for (int i = 0; i < 4; ++i) fa[i] = *(const bf16x8*)(PQ + (size_t)(t0 + i * 16 + fr) * 2048 + hp * 256 + c * 128 + ks * 32 + fq * 8);
#pragma unroll
                for (int j = 0; j < 4; ++j) fb[j] = *(const bf16x8*)(KEYS + (size_t)((hp * 2 + c) * 128 + kb + j * 16 + fr) * 128 + ks * 32 + fq * 8);
#pragma unroll
                for (int i = 0; i < 4; ++i)
#pragma unroll
                    for (int j = 0; j < 4; ++j) acc[i][j] = __builtin_amdgcn_mfma_f32_16x16x32_bf16(fa[i], fb[j], acc[i][j], 0, 0, 0);
            }
#pragma unroll
            for (int i = 0; i < 4; ++i)
#pragma unroll
                for (int j = 0; j < 4; ++j)
#pragma unroll
                    for (int e = 0; e < 4; ++e) lds[(hs * 64 + i * 16 + fq * 4 + e) * LDW + (c * 2 + (wave & 1)) * 65 + j * 16 + fr] = acc[i][j][e];
        }
        __syncthreads();
        {
            const int task = tid >> 2, q = tid & 3;
            const float* row = lds + task * LDW + q * 65;
            unsigned t[16], o[16];
            {
                unsigned t1[16], t2[16], t3[16];
#pragma unroll
                for (int i = 0; i < 16; ++i) {
                    t[i] = (ukey(row[i]) & ~127u) | (unsigned)(127 - ((q & 1) * 64 + i));
                    t1[i] = (ukey(row[16 + i]) & ~127u) | (unsigned)(127 - ((q & 1) * 64 + 16 + i));
                    t2[i] = (ukey(row[32 + i]) & ~127u) | (unsigned)(127 - ((q & 1) * 64 + 32 + i));
                    t3[i] = (ukey(row[48 + i]) & ~127u) | (unsigned)(127 - ((q & 1) * 64 + 48 + i));
                }
                bsort16(t); bsort16(t1); bsort16(t2); bsort16(t3);
                bmerge16(t, t1); bmerge16(t2, t3); bmerge16(t, t2);
            }
#pragma unroll
            for (int k = 0; k < 16; ++k) o[k] = (unsigned)__shfl_xor((int)t[k], 1);
            bmerge16(t, o);
#pragma unroll
            for (int k = 0; k < 16; ++k) o[k] = (unsigned)__shfl_xor((int)t[k], 2);
            float v1[16], v2[16];
#pragma unroll
            for (int k = 0; k < 16; ++k) {
                const unsigned s1 = (q & 2) ? o[k] : t[k], s2 = (q & 2) ? t[k] : o[k];
                v1[k] = ukey_inv(s1 & ~127u); v2[k] = ukey_inv(s2 & ~127u);
                if ((k & 3) == q) { tab[task * 32 + k] = 127 - (int)(s1 & 127u); tab[task * 32 + 16 + k] = 127 - (int)(s2 & 127u); }
            }
#define CKEY(i, j) ((ukey(v1[i] + v2[j]) & ~255u) | (unsigned)(255 - ((i) * 16 + (j))))
            unsigned cd[16], cb[16], cc[16], ce[16];
#pragma unroll
            for (int j = 0; j < 16; ++j) cd[j] = CKEY(0, j);
#pragma unroll
            for (int j = 0; j < 8; ++j) cb[j] = CKEY(1, j);
#pragma unroll
            for (int j = 0; j < 5; ++j) cb[8 + j] = CKEY(2, j);
#pragma unroll
            for (int j = 0; j < 3; ++j) cb[13 + j] = CKEY(4, j);
#pragma unroll
            for (int j = 0; j < 4; ++j) cc[j] = CKEY(3, j);
#pragma unroll
            for (int i = 5; i < 8; ++i) { cc[4 + (i - 5) * 2] = CKEY(i, 0); cc[5 + (i - 5) * 2] = CKEY(i, 1); }
#pragma unroll
            for (int i = 8; i < 14; ++i) cc[10 + (i - 8)] = CKEY(i, 0);
            ce[0] = CKEY(14, 0); ce[1] = CKEY(15, 0);
#pragma unroll
            for (int j = 2; j < 16; ++j) ce[j] = 0u;
#undef CKEY
            bsort16(cb); bsort16(cc);
            { const unsigned hi = max(ce[0], ce[1]), lo = min(ce[0], ce[1]); ce[0] = hi; ce[1] = lo; }
            bmerge16(cd, cb); bmerge16(cc, ce); bmerge16(cd, cc);
            const float vmax = ukey_inv(cd[0] & ~255u);
            float es = 0.f;
#pragma unroll
            for (int k = 0; k < 16; ++k) es += __expf(ukey_inv(cd[k] & ~255u) - vmax);
            const float inv = 1.f / es;
            const size_t ob = ((size_t)(t0 + (task & 63)) * 8 + hp2 * 2 + (task >> 6)) * 16 + q * 4;
#pragma unroll
            for (int e = 0; e < 4; ++e) {
                const unsigned key = q == 0 ? cd[e] : q == 1 ? cd[4 + e] : q == 2 ? cd[8 + e] : cd[12 + e];
                const int pos = 255 - (int)(key & 255u);
                PIDX[ob + e] = tab[task * 32 + (pos >> 4)] * 128 + tab[task * 32 + 16 + (pos & 15)];
                PG[ob + e] = __expf(ukey_inv(key & ~255u) - vmax) * inv;
            }
        }
        __syncthreads();
    }
}

__device__ __forceinline__ void gather_phase(const Params& p, float* lds) {
    const bf16_t* H2 = (const bf16_t*)(p.ws + WS_XN); const bf16_t* U = (const bf16_t*)(p.ws + WS_U); const bf16_t* V = (const bf16_t*)(p.ws + WS_V);
    const int* PIDX = (const int*)(p.ws + WS_PIDX); const float* PG = (const float*)(p.ws + WS_PG);
    const float* mod = (const float*)(p.ws + WS_MOD);
    const int tid = threadIdx.x, lane = tid & 63, wave = tid >> 6;
    float* part = lds;
    float* red = lds + 8 * 1024;
    for (int tok = blockIdx.x; tok < MT; tok += gridDim.x) {
        const int b = tok / NS;
        float hv[16];
        {
            const u32x4 w0 = *(const u32x4*)(H2 + (size_t)tok * ND + lane * 8), w1 = *(const u32x4*)(H2 + (size_t)tok * ND + 512 + lane * 8);
#pragma unroll
            for (int e = 0; e < 4; ++e) { hv[e * 2] = bflo(w0[e]); hv[e * 2 + 1] = bfhi(w0[e]); hv[8 + e * 2] = bflo(w1[e]); hv[8 + e * 2 + 1] = bfhi(w1[e]); }
        }
        float acc[16];
#pragma unroll
        for (int e = 0; e < 16; ++e) acc[e] = 0.f;
        for (int k = 0; k < 16; ++k) {
            const size_t o = ((size_t)tok * 8 + wave) * 16 + k;
            const int idx = PIDX[o]; const float g = PG[o];
            const u32x4 u0 = *(const u32x4*)(U + (size_t)idx * ND + lane * 8), u1 = *(const u32x4*)(U + (size_t)idx * ND + 512 + lane * 8);
            float d = 0.f;
#pragma unroll
            for (int e = 0; e < 4; ++e) { d += hv[e * 2] * bflo(u0[e]) + hv[e * 2 + 1] * bfhi(u0[e]); d += hv[8 + e * 2] * bflo(u1[e]) + hv[8 + e * 2 + 1] * bfhi(u1[e]); }
            d = wave_sum(d);
            const float a = 0.5f * d * (1.f + erff(d * 0.70710678118654752f));
            const float w = g * a;
            const u32x4 v0 = *(const u32x4*)(V + (size_t)idx * ND + lane * 8), v1 = *(const u32x4*)(V + (size_t)idx * ND + 512 + lane * 8);
#pragma unroll
            for (int e = 0; e < 4; ++e) { acc[e * 2] += w * bflo(v0[e]); acc[e * 2 + 1] += w * bfhi(v0[e]); acc[8 + e * 2] += w * bflo(v1[e]); acc[8 + e * 2 + 1] += w * bfhi(v1[e]); }
        }
#pragma unroll
        for (int e = 0; e < 8; ++e) { part[wave * 1024 + lane * 8 + e] = acc[e]; part[wave * 1024 + 512 + lane * 8 + e] = acc[8 + e]; }
        __syncthreads();
        float y[2]; float ss = 0.f;
#pragma unroll
        for (int q = 0; q < 2; ++q) {
            const int d = tid + q * NT;
            float s = 0.f;
#pragma unroll
            for (int w = 0; w < 8; ++w) s += part[w * 1024 + d];
            y[q] = p.out[(size_t)tok * ND + d] + mod[b * 6144 + 5120 + d] * s;
            ss += y[q] * y[q];
        }
        ss = wave_sum(ss);
        if (lane == 0) red[wave] = ss;
        __syncthreads();
        float tot = 0.f;
#pragma unroll
        for (int w = 0; w < 8; ++w) tot += red[w];
        const float rstd = rsqrtf(tot * (1.f / ND) + EPS);
#pragma unroll
        for (int q = 0; q < 2; ++q) { const int d = tid + q * NT; p.out[(size_t)tok * ND + d] = y[q] * rstd * p.norm_f[d]; }
        __syncthreads();
    }
}

typedef float f32x2 __attribute__((ext_vector_type(2)));
__device__ __forceinline__ int rfl(int v) { return __builtin_amdgcn_readfirstlane(v); }
__device__ __forceinline__ void gather2_phase(const Params& p, unsigned char* lds) {
    const unsigned char* UV = p.ws + WS_U; const bf16_t* H2 = (const bf16_t*)(p.ws + WS_XN);
    const int* PIDX = (const int*)(p.ws + WS_PIDX); const float* PG = (const float*)(p.ws + WS_PG);
    const float* mod = (const float*)(p.ws + WS_MOD);
    const int tid = threadIdx.x, lane = tid & 63, wave = tid >> 6;
    unsigned char* wl = lds + wave * 4608;
    int* Lidx = (int*)wl; float* Lw = (float*)(wl + 2048); int* Loff = (int*)(wl + 4096);
    for (int pass = blockIdx.x; pass < MT / 32; pass += gridDim.x) {
        const int tokbase = pass * 32 + wave * 4;
#pragma unroll
        for (int tk = 0; tk < 4; ++tk) {
            const size_t o = (size_t)(tokbase + tk) * 128;
            const int i0 = PIDX[o + lane], i1 = PIDX[o + 64 + lane]; const float w0 = PG[o + lane], w1 = PG[o + 64 + lane];
            const int r0 = i0 >> 10, r1 = i1 >> 10;
            int pos0 = 0, pos1 = 0, myoff = 0, base = 0;
#pragma unroll
            for (int q = 0; q < 16; ++q) {
                const unsigned long long m0 = __ballot(r0 == q), m1 = __ballot(r1 == q); const int c0 = __popcll(m0);
                if (r0 == q) pos0 = base + mbcnt64(m0);
                if (r1 == q) pos1 = base + c0 + mbcnt64(m1);
                if (lane == q) myoff = base;
                base += c0 + __popcll(m1);
            }
            if (lane == 16) myoff = base;
            Lidx[tk * 128 + pos0] = i0; Lw[tk * 128 + pos0] = w0; Lidx[tk * 128 + pos1] = i1; Lw[tk * 128 + pos1] = w1;
            if (lane < 17) Loff[tk * 32 + lane] = myoff;
        }
        f32x2 h[4][8], acc[4][8];
#pragma unroll
        for (int tk = 0; tk < 4; ++tk) {
            const u32x4 a = *(const u32x4*)(H2 + (size_t)(tokbase + tk) * ND + lane * 16), c = *(const u32x4*)(H2 + (size_t)(tokbase + tk) * ND + lane * 16 + 8);
#pragma unroll
            for (int e = 0; e < 4; ++e) { h[tk][e] = (f32x2){bflo(a[e]), bfhi(a[e])}; h[tk][4 + e] = (f32x2){bflo(c[e]), bfhi(c[e])}; acc[tk][e] = (f32x2){0.f, 0.f}; acc[tk][4 + e] = (f32x2){0.f, 0.f}; }
        }
#pragma unroll 1
        for (int r = 0; r < 16; ++r) {
#pragma unroll
            for (int tk = 0; tk < 4; ++tk) {
                const int beg = rfl(Loff[tk * 32 + r]), end = rfl(Loff[tk * 32 + r + 1]);
                for (int j0 = beg; j0 < end; j0 += 8) {
                    const int n = min(8, end - j0);
                    u32x4 rr[8]; const unsigned char* rowp[8];
#pragma unroll
                    for (int j = 0; j < 8; ++j) if (j < n) { rowp[j] = UV + (size_t)rfl(Lidx[tk * 128 + j0 + j]) * 2048 + lane * 16; rr[j] = *(const u32x4*)rowp[j]; }
                    float d[8];
#pragma unroll
                    for (int j = 0; j < 8; ++j) {
                        d[j] = 0.f;
                        if (j < n) {
                            f32x2 s = (f32x2){0.f, 0.f};
#pragma unroll
                            for (int k = 0; k < 4; ++k) {
                                s = __builtin_elementwise_fma(__builtin_amdgcn_cvt_pk_f32_fp8(rr[j][k], false), h[tk][2 * k], s);
                                s = __builtin_elementwise_fma(__builtin_amdgcn_cvt_pk_f32_fp8(rr[j][k], true), h[tk][2 * k + 1], s);
                            }
                            d[j] = s.x + s.y;
                            rr[j] = *(const u32x4*)(rowp[j] + 1024);
                        }
                    }
                    float r4[4], r2[2], r1;
#pragma unroll
                    for (int j = 0; j < 4; ++j) { const float keep = (lane & 32) ? d[j + 4] : d[j], send = (lane & 32) ? d[j] : d[j + 4]; r4[j] = keep + __shfl_xor(send, 32); }
#pragma unroll
                    for (int j = 0; j < 2; ++j) { const float keep = (lane & 16) ? r4[j + 2] : r4[j], send = (lane & 16) ? r4[j] : r4[j + 2]; r2[j] = keep + __shfl_xor(send, 16); }
                    { const float keep = (lane & 8) ? r2[1] : r2[0], send = (lane & 8) ? r2[0] : r2[1]; r1 = keep + __shfl_xor(send, 8); }
                    r1 += __shfl_xor(r1, 4); r1 += __shfl_xor(r1, 2); r1 += __shfl_xor(r1, 1);
                    float wq = 0.f;
                    if ((lane >> 3) < n) { const float x = r1 * (1.f / 64.f); wq = Lw[tk * 128 + j0 + (lane >> 3)] * (0.5f * x * (1.f + erff(x * 0.70710678118654752f))) * 0.125f; }
#pragma unroll
                    for (int j = 0; j < 8; ++j) if (j < n) {
                        const float wj = __int_as_float(__builtin_amdgcn_readlane(__float_as_int(wq), j * 8));
                        const f32x2 w2 = (f32x2){wj, wj};
#pragma unroll
                        for (int k = 0; k < 4; ++k) {
                            acc[tk][2 * k] = __builtin_elementwise_fma(__builtin_amdgcn_cvt_pk_f32_fp8(rr[j][k], false), w2, acc[tk][2 * k]);
                            acc[tk][2 * k + 1] = __builtin_elementwise_fma(__builtin_amdgcn_cvt_pk_f32_fp8(rr[j][k], true), w2, acc[tk][2 * k + 1]);
                        }
                    }
                }
            }
        }
#pragma unroll
        for (int tk = 0; tk < 4; ++tk) {
            const int tok = tokbase + tk, b = tok / NS;
            float* xo = p.out + (size_t)tok * ND + lane * 16; const float* g2 = mod + b * 6144 + 5120 + lane * 16; const float* nf = p.norm_f + lane * 16;
            f32x4 y[4]; float ss = 0.f;
#pragma unroll
            for (int q = 0; q < 4; ++q) {
                const f32x4 xv = *(const f32x4*)(xo + q * 4), gv = *(const f32x4*)(g2 + q * 4);
                y[q] = xv + gv * (f32x4){acc[tk][2 * q].x, acc[tk][2 * q].y, acc[tk][2 * q + 1].x, acc[tk][2 * q + 1].y};
                ss += y[q][0] * y[q][0] + y[q][1] * y[q][1] + y[q][2] * y[q][2] + y[q][3] * y[q][3];
            }
            ss = wave_sum(ss);
            const float rstd = rsqrtf(ss * (1.f / ND) + EPS);
#pragma unroll
            for (int q = 0; q < 4; ++q) *(f32x4*)(xo + q * 4) = y[q] * rstd * *(const f32x4*)(nf + q * 4);
        }
    }
}

__device__ __forceinline__ void gather3_phase(const Params& p, unsigned char* lds) {
    const unsigned char* UV = p.ws + WS_U; const bf16_t* H2 = (const bf16_t*)(p.ws + WS_XN);
    const int* PIDX = (const int*)(p.ws + WS_PIDX); const float* PG = (const float*)(p.ws + WS_PG);
    const float* mod = (const float*)(p.ws + WS_MOD);
    const int tid = threadIdx.x, lane = tid & 63, wave = tid >> 6;
    unsigned char* wl = lds + wave * 12800;
    int* Lidx = (int*)wl; float* Lw = (float*)(wl + 2048); int* cnt = (int*)(wl + 4096); int* bs = (int*)(wl + 4352); unsigned char* hl = wl + 4608;
    for (int pass = blockIdx.x; pass < MT / 32; pass += gridDim.x) {
        const int tokbase = pass * 32 + wave * 4;
        cnt[lane] = 0;
        int ei[8]; float ew[8]; int pib[8];
#pragma unroll
        for (int tk = 0; tk < 4; ++tk) {
            const size_t o = (size_t)(tokbase + tk) * 128;
            ei[tk * 2] = PIDX[o + lane]; ei[tk * 2 + 1] = PIDX[o + 64 + lane]; ew[tk * 2] = PG[o + lane]; ew[tk * 2 + 1] = PG[o + 64 + lane];
        }
#pragma unroll
        for (int s = 0; s < 8; ++s) pib[s] = atomicAdd(&cnt[ei[s] >> 8], 1);
        {
            const int c = cnt[lane]; int x = c;
#pragma unroll
            for (int off = 1; off < 64; off <<= 1) { const int y = __shfl_up(x, off); if (lane >= off) x += y; }
            bs[lane] = x - c;
        }
#pragma unroll
        for (int s = 0; s < 8; ++s) { const int pos = bs[ei[s] >> 8] + pib[s]; Lidx[pos] = ei[s] | ((s >> 1) << 16); Lw[pos] = ew[s]; }
        f32x2 acc[4][8];
#pragma unroll
        for (int tk = 0; tk < 4; ++tk) {
            *(u32x4*)(hl + tk * 2048 + lane * 32) = *(const u32x4*)(H2 + (size_t)(tokbase + tk) * ND + lane * 16);
            *(u32x4*)(hl + tk * 2048 + lane * 32 + 16) = *(const u32x4*)(H2 + (size_t)(tokbase + tk) * ND + lane * 16 + 8);
#pragma unroll
            for (int e = 0; e < 8; ++e) acc[tk][e] = (f32x2){0.f, 0.f};
        }
#define G3_ACC(T) { asm volatile("; acc slot"); _Pragma("unroll") for (int k = 0; k < 4; ++k) { \
            acc[T][2 * k] = __builtin_elementwise_fma(__builtin_amdgcn_cvt_pk_f32_fp8(rv[j][k], false), w2, acc[T][2 * k]); \
            acc[T][2 * k + 1] = __builtin_elementwise_fma(__builtin_amdgcn_cvt_pk_f32_fp8(rv[j][k], true), w2, acc[T][2 * k + 1]); } }
#pragma unroll 1
        for (int j0 = 0; j0 < 512; j0 += 8) {
            u32x4 rr[8], rv[8]; int tkj[8];
#pragma unroll
            for (int j = 0; j < 8; ++j) { const int e = rfl(Lidx[j0 + j]); tkj[j] = e >> 16; const unsigned char* rowp = UV + (size_t)(e & 0xffff) * 2048 + lane * 16; rr[j] = *(const u32x4*)rowp; rv[j] = *(const u32x4*)(rowp + 1024); }
            float d[8];
#pragma unroll
            for (int j = 0; j < 8; ++j) {
                f32x2 s = (f32x2){0.f, 0.f};
                {
                    const unsigned char* hp = hl + tkj[j] * 2048 + lane * 32;
                    const u32x4 ha = *(const u32x4*)hp, hb = *(const u32x4*)(hp + 16);
#pragma unroll
                    for (int k = 0; k < 4; ++k) {
                        const unsigned h0 = k < 2 ? ha[2 * k] : hb[2 * k - 4], h1 = k < 2 ? ha[2 * k + 1] : hb[2 * k - 3];
                        s = __builtin_elementwise_fma(__builtin_amdgcn_cvt_pk_f32_fp8(rr[j][k], false), (f32x2){bflo(h0), bfhi(h0)}, s);
                        s = __builtin_elementwise_fma(__builtin_amdgcn_cvt_pk_f32_fp8(rr[j][k], true), (f32x2){bflo(h1), bfhi(h1)}, s);
                    }
                }
                d[j] = s.x + s.y;
            }
            float r4[4], r2[2], r1;
#pragma unroll
            for (int j = 0; j < 4; ++j) { const float keep = (lane & 32) ? d[j + 4] : d[j], send = (lane & 32) ? d[j] : d[j + 4]; r4[j] = keep + __shfl_xor(send, 32); }
#pragma unroll
            for (int j = 0; j < 2; ++j) { const float keep = (lane & 16) ? r4[j + 2] : r4[j], send = (lane & 16) ? r4[j] : r4[j + 2]; r2[j] = keep + __shfl_xor(send, 16); }
            { const float keep = (lane & 8) ? r2[1] : r2[0], send = (lane & 8) ? r2[0] : r2[1]; r1 = keep + __shfl_xor(send, 8); }
            r1 += __shfl_xor(r1, 4); r1 += __shfl_xor(r1, 2); r1 += __shfl_xor(r1, 1);
            const float x = r1 * (1.f / 64.f);
            const float wq = Lw[j0 + (lane >> 3)] * (0.5f * x * (1.f + erff(x * 0.70710678118654752f))) * 0.125f;
#pragma unroll
            for (int j = 0; j < 8; ++j) {
                const float wj = __int_as_float(__builtin_amdgcn_readlane(__float_as_int(wq), j * 8));
                const f32x2 w2 = (f32x2){wj, wj};
                if (tkj[j] == 0) G3_ACC(0) else if (tkj[j] == 1) G3_ACC(1) else if (tkj[j] == 2) G3_ACC(2) else G3_ACC(3)
            }
        }
#undef G3_ACC
#pragma unroll
        for (int tk = 0; tk < 4; ++tk) {
            const int tok = tokbase + tk, b = tok / NS;
            float* xo = p.out + (size_t)tok * ND + lane * 16; const float* g2 = mod + b * 6144 + 5120 + lane * 16; const float* nf = p.norm_f + lane * 16;
            f32x4 y[4]; float ss = 0.f;
#pragma unroll
            for (int q = 0; q < 4; ++q) {
                const f32x4 xv = *(const f32x4*)(xo + q * 4), gv = *(const f32x4*)(g2 + q * 4);
                y[q] = xv + gv * (f32x4){acc[tk][2 * q].x, acc[tk][2 * q].y, acc[tk][2 * q + 1].x, acc[tk][2 * q + 1].y};
                ss += y[q][0] * y[q][0] + y[q][1] * y[q][1] + y[q][2] * y[q][2] + y[q][3] * y[q][3];
            }
            ss = wave_sum(ss);
            const float rstd = rsqrtf(ss * (1.f / ND) + EPS);
#pragma unroll
            for (int q = 0; q < 4; ++q) *(f32x4*)(xo + q * 4) = y[q] * rstd * *(const f32x4*)(nf + q * 4);
        }
    }
}

#define G4_LOAD(RU, RV, J0) { _Pragma("unroll") for (int j = 0; j < 4; ++j) { const int e = rfl(Lidx[(J0) + j]); \
        const unsigned char* rowp = UV + (size_t)(e & 0xffff) * 2048 + lane * 16; RU[j] = *(const u32x4*)rowp; RV[j] = *(const u32x4*)(rowp + 1024); } }
#define G4_DOT(T) { asm volatile("; dot slot %0" :: "i"(T)); _Pragma("unroll") for (int k = 0; k < 4; ++k) { \
        s = __builtin_elementwise_fma(__builtin_amdgcn_cvt_pk_f32_fp8(RU_[j][k], false), h[T][2 * k], s); \
        s = __builtin_elementwise_fma(__builtin_amdgcn_cvt_pk_f32_fp8(RU_[j][k], true), h[T][2 * k + 1], s); } }
#define G4_ACC(T) { asm volatile("; acc slot %0" :: "i"(T)); _Pragma("unroll") for (int k = 0; k < 4; ++k) { \
        acc[T][2 * k] = __builtin_elementwise_fma(__builtin_amdgcn_cvt_pk_f32_fp8(RV_[j][k], false), w2, acc[T][2 * k]); \
        acc[T][2 * k + 1] = __builtin_elementwise_fma(__builtin_amdgcn_cvt_pk_f32_fp8(RV_[j][k], true), w2, acc[T][2 * k + 1]); } }
__device__ __forceinline__ void gather4_batch(const u32x4 (&RU_)[4], const u32x4 (&RV_)[4], const int* Lidx, const float* Lw, int j0, int lane, const f32x2 (&h)[2][8], f32x2 (&acc)[2][8]) {
    int tkj[4];
#pragma unroll
    for (int j = 0; j < 4; ++j) tkj[j] = rfl(Lidx[j0 + j]) >> 16;
    float d[4];
#pragma unroll
    for (int j = 0; j < 4; ++j) {
        f32x2 s = (f32x2){0.f, 0.f};
        if (tkj[j] == 0) G4_DOT(0) else G4_DOT(1)
        d[j] = s.x + s.y;
    }
    float r2[2], r1;
#pragma unroll
    for (int j = 0; j < 2; ++j) { const float keep = (lane & 32) ? d[j + 2] : d[j], send = (lane & 32) ? d[j] : d[j + 2]; r2[j] = keep + __shfl_xor(send, 32); }
    { const float keep = (lane & 16) ? r2[1] : r2[0], send = (lane & 16) ? r2[0] : r2[1]; r1 = keep + __shfl_xor(send, 16); }
    r1 += __shfl_xor(r1, 8); r1 += __shfl_xor(r1, 4); r1 += __shfl_xor(r1, 2); r1 += __shfl_xor(r1, 1);
    const float x = r1 * (1.f / 64.f);
    const float wq = Lw[j0 + (lane >> 4)] * (0.5f * x * (1.f + erff(x * 0.70710678118654752f))) * 0.125f;
#pragma unroll
    for (int j = 0; j < 4; ++j) {
        const float wj = __int_as_float(__builtin_amdgcn_readlane(__float_as_int(wq), j * 16));
        const f32x2 w2 = (f32x2){wj, wj};
        if (tkj[j] == 0) G4_ACC(0) else G4_ACC(1)
    }
}
__device__ __forceinline__ void gather4_phase(const Params& p, unsigned char* lds) {
    const unsigned char* UV = p.ws + WS_U; const bf16_t* H2 = (const bf16_t*)(p.ws + WS_XN);
    const int* PIDX = (const int*)(p.ws + WS_PIDX); const float* PG = (const float*)(p.ws + WS_PG);
    const float* mod = (const float*)(p.ws + WS_MOD);
    const int tid = threadIdx.x, lane = tid & 63, wave = tid >> 6;
    unsigned char* wl = lds + wave * 2560;
    int* Lidx = (int*)wl; float* Lw = (float*)(wl + 1024); int* cnt = (int*)(wl + 2048); int* bs = (int*)(wl + 2304);
    for (int pass = blockIdx.x; pass < MT / 16; pass += gridDim.x) {
        const int tokbase = pass * 16 + wave * 2;
        cnt[lane] = 0;
        int ei[4]; float ew[4]; int pib[4];
#pragma unroll
        for (int tk = 0; tk < 2; ++tk) {
            const size_t o = (size_t)(tokbase + tk) * 128;
            ei[tk * 2] = PIDX[o + lane]; ei[tk * 2 + 1] = PIDX[o + 64 + lane]; ew[tk * 2] = PG[o + lane]; ew[tk * 2 + 1] = PG[o + 64 + lane];
        }
#pragma unroll
        for (int s = 0; s < 4; ++s) pib[s] = atomicAdd(&cnt[ei[s] >> 8], 1);
        {
            const int c = cnt[lane]; int x = c;
#pragma unroll
            for (int off = 1; off < 64; off <<= 1) { const int y = __shfl_up(x, off); if (lane >= off) x += y; }
            bs[lane] = x - c;
        }
#pragma unroll
        for (int s = 0; s < 4; ++s) { const int pos = bs[ei[s] >> 8] + pib[s]; Lidx[pos] = ei[s] | ((s >> 1) << 16); Lw[pos] = ew[s]; }
        f32x2 h[2][8], acc[2][8];
#pragma unroll
        for (int tk = 0; tk < 2; ++tk) {
            const u32x4 a = *(const u32x4*)(H2 + (size_t)(tokbase + tk) * ND + lane * 16), c = *(const u32x4*)(H2 + (size_t)(tokbase + tk) * ND + lane * 16 + 8);
#pragma unroll
            for (int e = 0; e < 4; ++e) { h[tk][e] = (f32x2){bflo(a[e]), bfhi(a[e])}; h[tk][4 + e] = (f32x2){bflo(c[e]), bfhi(c[e])}; acc[tk][e] = (f32x2){0.f, 0.f}; acc[tk][4 + e] = (f32x2){0.f, 0.f}; }
        }
        u32x4 ua[4], va[4], ub[4], vb[4];
        G4_LOAD(ua, va, 0)
#pragma unroll 1
        for (int j0 = 0; j0 < 256; j0 += 8) {
            G4_LOAD(ub, vb, j0 + 4)
            gather4_batch(ua, va, Lidx, Lw, j0, lane, h, acc);
            if (j0 + 8 < 256) G4_LOAD(ua, va, j0 + 8)
            gather4_batch(ub, vb, Lidx, Lw, j0 + 4, lane, h, acc);
        }
#pragma unroll
        for (int tk = 0; tk < 2; ++tk) {
            const int tok = tokbase + tk, b = tok / NS;
            float* xo = p.out + (size_t)tok * ND + lane * 16; const float* g2 = mod + b * 6144 + 5120 + lane * 16; const float* nf = p.norm_f + lane * 16;
            f32x4 y[4]; float ss = 0.f;
#pragma unroll
            for (int q = 0; q < 4; ++q) {
                const f32x4 xv = *(const f32x4*)(xo + q * 4), gv = *(const f32x4*)(g2 + q * 4);
                y[q] = xv + gv * (f32x4){acc[tk][2 * q].x, acc[tk][2 * q].y, acc[tk][2 * q + 1].x, acc[tk][2 * q + 1].y};
                ss += y[q][0] * y[q][0] + y[q][1] * y[q][1] + y[q][2] * y[q][2] + y[q][3] * y[q][3];
            }
            ss = wave_sum(ss);
            const float rstd = rsqrtf(ss * (1.f / ND) + EPS);
#pragma unroll
            for (int q = 0; q < 4; ++q) *(f32x4*)(xo + q * 4) = y[q] * rstd * *(const f32x4*)(nf + q * 4);
        }
    }
}
#undef G4_LOAD
#undef G4_DOT
#undef G4_ACC

__device__ __forceinline__ void gather5_phase(const Params& p, unsigned char* lds, float* outp) {
    const unsigned char* UV = p.ws + WS_U; const bf16_t* H2 = (const bf16_t*)(p.ws + WS_XN);
    const int* PIDX = (const int*)(p.ws + WS_PIDX); const float* PG = (const float*)(p.ws + WS_PG);
    const float* mod = (const float*)(p.ws + WS_MOD);
    const int tid = threadIdx.x, lane = tid & 63, wave = tid >> 6, half = lane >> 5, hl = lane & 31;
    unsigned char* wl = lds + wave * 2560 + half * 1280;
    int* Lidx = (int*)wl; float* Lw = (float*)(wl + 512); int* cnt = (int*)(wl + 1024);
    for (int pass = blockIdx.x; pass < MT / 16; pass += gridDim.x) {
        const int tok = pass * 16 + wave * 2 + half;
        cnt[hl] = 0; cnt[32 + hl] = 0;
        int ei[4]; float ew[4]; int pib[4];
#pragma unroll
        for (int s = 0; s < 4; ++s) { ei[s] = PIDX[(size_t)tok * 128 + s * 32 + hl]; ew[s] = PG[(size_t)tok * 128 + s * 32 + hl]; }
#pragma unroll
        for (int s = 0; s < 4; ++s) pib[s] = atomicAdd(&cnt[ei[s] >> 8], 1);
        {
            const int c0 = cnt[2 * hl], c1 = cnt[2 * hl + 1]; int x = c0 + c1;
#pragma unroll
            for (int off = 1; off < 32; off <<= 1) { const int y = __shfl_up(x, off, 32); if (hl >= off) x += y; }
            const int ex = x - c0 - c1;
            cnt[2 * hl] = ex; cnt[2 * hl + 1] = ex + c0;
        }
#pragma unroll
        for (int s = 0; s < 4; ++s) { const int pos = cnt[ei[s] >> 8] + pib[s]; Lidx[pos] = ei[s]; Lw[pos] = ew[s]; }
        f32x2 h[16], acc[16];
        {
            const bf16_t* hp = H2 + (size_t)tok * ND + hl * 32;
#pragma unroll
            for (int q = 0; q < 4; ++q) { const u32x4 a = *(const u32x4*)(hp + q * 8);
#pragma unroll
                for (int e = 0; e < 4; ++e) { h[q * 4 + e] = (f32x2){bflo(a[e]), bfhi(a[e])}; acc[q * 4 + e] = (f32x2){0.f, 0.f}; } }
        }
        u32x4 ru[4][2], rv[4][2];
#define G5_ROW(j0_, j_) (UV + (size_t)Lidx[(j0_) + (j_)] * 2048 + hl * 32)
#pragma unroll
        for (int j = 0; j < 4; ++j) { const unsigned char* rp = G5_ROW(0, j); ru[j][0] = *(const u32x4*)rp; ru[j][1] = *(const u32x4*)(rp + 16); rv[j][0] = *(const u32x4*)(rp + 1024); rv[j][1] = *(const u32x4*)(rp + 1040); }
#pragma unroll 1
        for (int j0 = 0; j0 < 128; j0 += 4) {
            const int jn = (j0 + 4 < 128) ? j0 + 4 : j0;
            float d[4];
#pragma unroll
            for (int j = 0; j < 4; ++j) {
                f32x2 s = (f32x2){0.f, 0.f};
#pragma unroll
                for (int w = 0; w < 2; ++w)
#pragma unroll
                    for (int k = 0; k < 4; ++k) {
                        s = __builtin_elementwise_fma(__builtin_amdgcn_cvt_pk_f32_fp8(ru[j][w][k], false), h[w * 8 + 2 * k], s);
                        s = __builtin_elementwise_fma(__builtin_amdgcn_cvt_pk_f32_fp8(ru[j][w][k], true), h[w * 8 + 2 * k + 1], s);
                    }
                d[j] = s.x + s.y;
                const unsigned char* rp = G5_ROW(jn, j); ru[j][0] = *(const u32x4*)rp; ru[j][1] = *(const u32x4*)(rp + 16);
            }
            float r2[2], r1;
#pragma unroll
            for (int j = 0; j < 2; ++j) { const float keep = (hl & 16) ? d[j + 2] : d[j], send = (hl & 16) ? d[j] : d[j + 2]; r2[j] = keep + __shfl_xor(send, 16); }
            { const float keep = (hl & 8) ? r2[1] : r2[0], send = (hl & 8) ? r2[0] : r2[1]; r1 = keep + __shfl_xor(send, 8); }
            r1 += __shfl_xor(r1, 4); r1 += __shfl_xor(r1, 2); r1 += __shfl_xor(r1, 1);
            const float x = r1 * (1.f / 64.f);
            const float wq = Lw[j0 + (hl >> 3)] * (0.5f * x * (1.f + erff(x * 0.70710678118654752f))) * 0.125f;
#pragma unroll
            for (int j = 0; j < 4; ++j) {
                const float wj = __shfl(wq, (lane & 32) | (j * 8));
                const f32x2 w2 = (f32x2){wj, wj};
#pragma unroll
                for (int w = 0; w < 2; ++w)
#pragma unroll
                    for (int k = 0; k < 4; ++k) {
                        acc[w * 8 + 2 * k] = __builtin_elementwise_fma(__builtin_amdgcn_cvt_pk_f32_fp8(rv[j][w][k], false), w2, acc[w * 8 + 2 * k]);
                        acc[w * 8 + 2 * k + 1] = __builtin_elementwise_fma(__builtin_amdgcn_cvt_pk_f32_fp8(rv[j][w][k], true), w2, acc[w * 8 + 2 * k + 1]);
                    }
                const unsigned char* rp = G5_ROW(jn, j); rv[j][0] = *(const u32x4*)(rp + 1024); rv[j][1] = *(const u32x4*)(rp + 1040);
            }
        }
#undef G5_ROW
        {
            const int b = tok / NS;
            const float* xo = p.out + (size_t)tok * ND + hl * 32; float* yo = outp + (size_t)tok * ND + hl * 32; const float* g2 = mod + b * 6144 + 5120 + hl * 32; const float* nf = p.norm_f + hl * 32;
            f32x4 y[8]; float ss = 0.f;
#pragma unroll
            for (int q = 0; q < 8; ++q) {
                const f32x4 xv = *(const f32x4*)(xo + q * 4), gv = *(const f32x4*)(g2 + q * 4);
                y[q] = xv + gv * (f32x4){acc[2 * q].x, acc[2 * q].y, acc[2 * q + 1].x, acc[2 * q + 1].y};
                ss += y[q][0] * y[q][0] + y[q][1] * y[q][1] + y[q][2] * y[q][2] + y[q][3] * y[q][3];
            }
            ss += __shfl_xor(ss, 16); ss += __shfl_xor(ss, 8); ss += __shfl_xor(ss, 4); ss += __shfl_xor(ss, 2); ss += __shfl_xor(ss, 1);
            const float rstd = rsqrtf(ss * (1.f / ND) + EPS);
#pragma unroll
            for (int q = 0; q < 8; ++q) *(f32x4*)(yo + q * 4) = y[q] * rstd * *(const f32x4*)(nf + q * 4);
        }
    }
}

typedef float f32x32 __attribute__((ext_vector_type(32)));
typedef unsigned u32x6 __attribute__((ext_vector_type(6)));
typedef unsigned u32x3 __attribute__((ext_vector_type(3)));
__device__ __forceinline__ u32x6 ld24(const unsigned char* p) { const u32x3 a = *(const u32x3*)p, b = *(const u32x3*)(p + 12); return (u32x6){a[0], a[1], a[2], b[0], b[1], b[2]}; }
__device__ __forceinline__ void gather6_phase(const Params& p, unsigned char* lds, float* outp) {
    const unsigned char* UV = p.ws + WS_U; const bf16_t* H2 = (const bf16_t*)(p.ws + WS_XN);
    const int* PIDX = (const int*)(p.ws + WS_PIDX); const float* PG = (const float*)(p.ws + WS_PG);
    const float* mod = (const float*)(p.ws + WS_MOD);
    const int tid = threadIdx.x, lane = tid & 63, wave = tid >> 6, half = lane >> 5, hl = lane & 31;
    unsigned char* wl = lds + wave * 2560 + half * 1280;
    int* Lidx = (int*)wl; float* Lw = (float*)(wl + 512); int* cnt = (int*)(wl + 1024);
    for (int pass = blockIdx.x; pass < MT / 16; pass += gridDim.x) {
        const int tok = pass * 16 + wave * 2 + half;
        cnt[hl] = 0; cnt[32 + hl] = 0;
        int ei[4]; float ew[4]; int pib[4];
#pragma unroll
        for (int s = 0; s < 4; ++s) { ei[s] = PIDX[(size_t)tok * 128 + s * 32 + hl]; ew[s] = PG[(size_t)tok * 128 + s * 32 + hl]; }
#pragma unroll
        for (int s = 0; s < 4; ++s) pib[s] = atomicAdd(&cnt[ei[s] >> 8], 1);
        {
            const int c0 = cnt[2 * hl], c1 = cnt[2 * hl + 1]; int x = c0 + c1;
#pragma unroll
            for (int off = 1; off < 32; off <<= 1) { const int y = __shfl_up(x, off, 32); if (hl >= off) x += y; }
            const int ex = x - c0 - c1;
            cnt[2 * hl] = ex; cnt[2 * hl + 1] = ex + c0;
        }
#pragma unroll
        for (int s = 0; s < 4; ++s) { const int pos = cnt[ei[s] >> 8] + pib[s]; Lidx[pos] = ei[s]; Lw[pos] = ew[s]; }
        f32x2 h[16], acc[16];
        {
            const bf16_t* hp = H2 + (size_t)tok * ND + hl * 32;
#pragma unroll
            for (int q = 0; q < 4; ++q) { const u32x4 a = *(const u32x4*)(hp + q * 8);
#pragma unroll
                for (int e = 0; e < 4; ++e) { h[q * 4 + e] = (f32x2){bflo(a[e]), bfhi(a[e])}; acc[q * 4 + e] = (f32x2){0.f, 0.f}; } }
        }
        u32x6 ru[4], rv[4];
#define G6_ROW(j0_, j_) (UV + (size_t)Lidx[(j0_) + (j_)] * 1536 + hl * 24)
#pragma unroll
        for (int j = 0; j < 4; ++j) { const unsigned char* rp = G6_ROW(0, j); ru[j] = ld24(rp); rv[j] = ld24(rp + 768); }
#pragma unroll 1
        for (int j0 = 0; j0 < 128; j0 += 4) {
            const int jn = (j0 + 4 < 128) ? j0 + 4 : j0;
            float d[4];
#pragma unroll
            for (int j = 0; j < 4; ++j) {
                const f32x32 x = __builtin_amdgcn_cvt_scalef32_pk32_f32_fp6(ru[j], 1.0f);
                f32x2 s = (f32x2){0.f, 0.f};
#pragma unroll
                for (int k = 0; k < 16; ++k) s = __builtin_elementwise_fma((f32x2){x[2 * k], x[2 * k + 1]}, h[k], s);
                d[j] = s.x + s.y;
                ru[j] = ld24(G6_ROW(jn, j));
                __builtin_amdgcn_sched_barrier(0);
            }
            float r2[2], r1;
#pragma unroll
            for (int j = 0; j < 2; ++j) { const float keep = (hl & 16) ? d[j + 2] : d[j], send = (hl & 16) ? d[j] : d[j + 2]; r2[j] = keep + __shfl_xor(send, 16); }
            { const float keep = (hl & 8) ? r2[1] : r2[0], send = (hl & 8) ? r2[0] : r2[1]; r1 = keep + __shfl_xor(send, 8); }
            r1 += __shfl_xor(r1, 4); r1 += __shfl_xor(r1, 2); r1 += __shfl_xor(r1, 1);
            const float xg = r1 * (1.f / 64.f);
            const float wq = Lw[j0 + (hl >> 3)] * (0.5f * xg * (1.f + erff(xg * 0.70710678118654752f))) * (1.f / 5.5f);
#pragma unroll
            for (int j = 0; j < 4; ++j) {
                const float wj = __shfl(wq, (lane & 32) | (j * 8));
                const f32x2 w2 = (f32x2){wj, wj};
                const f32x32 x = __builtin_amdgcn_cvt_scalef32_pk32_f32_fp6(rv[j], 1.0f);
#pragma unroll
                for (int k = 0; k < 16; ++k) acc[k] = __builtin_elementwise_fma((f32x2){x[2 * k], x[2 * k + 1]}, w2, acc[k]);
                rv[j] = ld24(G6_ROW(jn, j) + 768);
                __builtin_amdgcn_sched_barrier(0);
            }
        }
#undef G6_ROW
        {
            const int b = tok / NS;
            const float* xo = p.out + (size_t)tok * ND + hl * 32; float* yo = outp + (size_t)tok * ND + hl * 32; const float* g2 = mod + b * 6144 + 5120 + hl * 32; const float* nf = p.norm_f + hl * 32;
            f32x4 y[8]; float ss = 0.f;
#pragma unroll
            for (int q = 0; q < 8; ++q) {
                const f32x4 xv = *(const f32x4*)(xo + q * 4), gv = *(const f32x4*)(g2 + q * 4);
                y[q] = xv + gv * (f32x4){acc[2 * q].x, acc[2 * q].y, acc[2 * q + 1].x, acc[2 * q + 1].y};
                ss += y[q][0] * y[q][0] + y[q][1] * y[q][1] + y[q][2] * y[q][2] + y[q][3] * y[q][3];
            }
            ss += __shfl_xor(ss, 16); ss += __shfl_xor(ss, 8); ss += __shfl_xor(ss, 4); ss += __shfl_xor(ss, 2); ss += __shfl_xor(ss, 1);
            const float rstd = rsqrtf(ss * (1.f / ND) + EPS);
#pragma unroll
            for (int q = 0; q < 8; ++q) *(f32x4*)(yo + q * 4) = y[q] * rstd * *(const f32x4*)(nf + q * 4);
        }
    }
}

#define XB_TMO      128
#define XB_XCNT(j)  (256  + 64 * (j))
#define XB_XSUB(j)  (1280 + 64 * (j))
#define XB_XGEN(j)  (2304 + 64 * (j))
#define XB_TOP      3328
#define XB_TOPGEN   3392
#define XCD_BAR_WORDS 3456
#define XB_SPIN_CAP (1u << 18)
#define LAS __attribute__((address_space(3)))
__device__ __forceinline__ unsigned xb_ld(unsigned* p)              { return __hip_atomic_load(p, __ATOMIC_RELAXED, __HIP_MEMORY_SCOPE_AGENT); }
__device__ __forceinline__ unsigned xb_add(unsigned* p, unsigned v) { return __hip_atomic_fetch_add(p, v, __ATOMIC_RELAXED, __HIP_MEMORY_SCOPE_AGENT); }
__device__ __forceinline__ unsigned xb_xcc_id() { return (unsigned)__builtin_amdgcn_s_getreg((3 << 11) | 20) & 0xFu; }
#define XB_SPIN(cond, bar) do { unsigned _sp = 0; while (cond) { __builtin_amdgcn_s_sleep(1); \
    if ((++_sp & 255u) == 0u) { if (xb_ld(&(bar)[XB_TMO])) break; if (_sp > XB_SPIN_CAP) { atomicAdd(&(bar)[XB_TMO], 1u); break; } } } } while (0)
struct XcdBarrier { unsigned* bar; unsigned x; volatile LAS unsigned* st; };
__device__ __forceinline__ XcdBarrier xcd_barrier_post(unsigned* bar, volatile LAS unsigned* st) {
    XcdBarrier b; b.bar = bar; b.x = xb_xcc_id(); b.st = st;
    if (threadIdx.x == 0) (void)xb_add(&bar[XB_XCNT(b.x)], 1u);
    return b;
}
__device__ __forceinline__ void xcd_barrier_complete(unsigned* bar, unsigned x, unsigned& nloc, unsigned& nx) {
    const unsigned G = gridDim.x * gridDim.y * gridDim.z;
    unsigned sum, cnt, mine, sp = 0u;
    for (;;) {
        sum = 0u; cnt = 0u; mine = 0u;
#pragma unroll
        for (unsigned j = 0; j < 16; ++j) { const unsigned c = xb_ld(&bar[XB_XCNT(j)]); sum += c; cnt += (c > 0u) ? 1u : 0u; mine = (j == x) ? c : mine; }
        if (sum == G) break;
        __builtin_amdgcn_s_sleep(1);
        if ((++sp & 255u) == 0u) { if (xb_ld(&bar[XB_TMO])) break; if (sp > XB_SPIN_CAP) { atomicAdd(&bar[XB_TMO], 1u); break; } }
    }
    nloc = mine > 0u ? mine : 1u; nx = cnt > 0u ? cnt : 1u;
}
__device__ __forceinline__ void xcd_barrier(const XcdBarrier& b) {
    asm volatile("s_waitcnt vmcnt(0)" ::: "memory");
    __syncthreads();
    if (threadIdx.x == 0) {
        unsigned* bar = b.bar;
        __builtin_amdgcn_s_waitcnt(0);
        unsigned nloc = b.st[0], nx = b.st[1];
        if (nloc == 0u) { xcd_barrier_complete(bar, b.x, nloc, nx); b.st[0] = nloc; b.st[1] = nx; }
        const unsigned old = xb_add(&bar[XB_XSUB(b.x)], 1u);
        const unsigned gen = old / nloc;
        if (old + 1u == (gen + 1u) * nloc) {
            __builtin_amdgcn_fence(__ATOMIC_RELEASE, "agent");
            asm volatile("s_waitcnt vmcnt(0)" ::: "memory");
            const unsigned og = xb_add(&bar[XB_TOP], 1u);
            const unsigned tg = og / nx;
            if (og + 1u == (tg + 1u) * nx) xb_add(&bar[XB_TOPGEN], 1u);
            else XB_SPIN(xb_ld(&bar[XB_TOPGEN]) == tg, bar);
            __builtin_amdgcn_fence(__ATOMIC_ACQUIRE, "agent");
            xb_add(&bar[XB_XGEN(b.x)], 1u);
            asm volatile("s_waitcnt vmcnt(0)" ::: "memory");
        } else {
            XB_SPIN(xb_ld(&bar[XB_XGEN(b.x)]) == gen, bar);
            __builtin_amdgcn_fence(__ATOMIC_ACQUIRE, "agent");
            asm volatile("s_waitcnt vmcnt(0)" ::: "memory");
        }
    }
    __syncthreads();
}

constexpr int LDS_BYTES = 157696 + 512 + 16;
__global__ void __launch_bounds__(NT, 2) k_mega(Params p) {
    __shared__ __attribute__((aligned(16))) unsigned char lds[LDS_BYTES];
    volatile LAS unsigned* xst = (volatile LAS unsigned*)(lds + 157696 + 512);
    if (threadIdx.x == 0) { xst[0] = 0u; xst[1] = 0u; }
    __syncthreads();
    (void)xcd_barrier_post((unsigned*)(p.ws + WS_CTL), xst);
#define GRID_BARRIER() do { XcdBarrier xb_; xb_.bar = (unsigned*)(p.ws + WS_CTL); xb_.x = xb_xcc_id(); xb_.st = (volatile LAS unsigned*)(lds + 157696 + 512); xcd_barrier(xb_); } while (0)
#define REPS(k) for (int rep_ = 0; rep_ < ((DUP == (k)) ? 2 : 1); ++rep_)
    _Pragma("unroll 1") REPS(1) {
    mod_phase(p, (float*)lds);
    transpose_convert(p.w_in, (bf16_t*)(p.ws + WS_WIN), ND, NIN, (float*)lds);
    transpose_convert(p.w_out, (bf16_t*)(p.ws + WS_WOUT), ND, ND, (float*)lds);
    transpose_convert(p.wq, (bf16_t*)(p.ws + WS_WQ), ND, 2048, (float*)lds);
    convert_flat(p.keys, (bf16_t*)(p.ws + WS_KEYS), (size_t)8 * 2 * 128 * 128);
    }
    GRID_BARRIER();
    _Pragma("unroll 1") REPS(2) prep_phase(p, 0);
    GRID_BARRIER();
    _Pragma("unroll 1") REPS(3) inproj8_phase(p, lds);
    GRID_BARRIER();
    _Pragma("unroll 1") REPS(4) {
        const bool split = gridDim.x >= 256;
        if (!split || blockIdx.x < 128) { _Pragma("unroll 1") REPS(10) hg_chunk_phase(p, lds); }
        if (!split || blockIdx.x >= 128) { _Pragma("unroll 1") REPS(11) na3_phase(p, lds, split ? blockIdx.x - 128 : blockIdx.x, split ? gridDim.x - 128 : gridDim.x); }
    }
    GRID_BARRIER();
    hg_corr_phase(p);
    GRID_BARRIER();
    _Pragma("unroll 1") REPS(5) hgmix_phase(p);
    GRID_BARRIER();
    _Pragma("unroll 1") REPS(6) outproj8_phase(p, lds);
    GRID_BARRIER();
    _Pragma("unroll 1") REPS(7) prep_phase(p, 1);
    GRID_BARRIER();
    _Pragma("unroll 1") REPS(8) pq8_phase(p, lds);
    GRID_BARRIER();
    _Pragma("unroll 1") REPS(9) topk3_phase(p, (float*)lds);
    GRID_BARRIER();
    _Pragma("unroll 1") for (int rep_ = ((DUP == 12) ? 0 : 1); rep_ < 2; ++rep_) gather6_phase(p, lds, rep_ ? p.out : (float*)(p.ws + WS_PQ));
}
}

extern "C" void kernel_launch(void* const* d_in, const int* in_sizes, int n_in, void* d_out, int out_size, void* d_ws, size_t ws_size, hipStream_t stream) {
    if (n_in != 18 || ws_size < WS_END) { fprintf(stderr, "kernel_launch: unexpected n_in %d / ws_size %zu\n", n_in, ws_size); return; }
    Params p{};
    p.x = (const float*)d_in[0]; p.c = (const float*)d_in[1]; p.ctx = (const float*)d_in[2]; p.c_ctx = (const float*)d_in[3];
    p.w_mod = (const float*)d_in[4]; p.b_mod = (const float*)d_in[5]; p.norm1 = (const float*)d_in[6]; p.norm2 = (const float*)d_in[7];
    p.w_in = (const float*)d_in[8]; p.w_out = (const float*)d_in[9]; p.rpb = (const float*)d_in[10]; p.hg_lb = (const float*)d_in[11];
    p.hg_norm = (const float*)d_in[12]; p.wq = (const float*)d_in[13]; p.keys = (const float*)d_in[14]; p.pu = (const float*)d_in[15];
    p.pv = (const float*)d_in[16]; p.norm_f = (const float*)d_in[17];
    p.out = (float*)d_out; p.ws = (unsigned char*)d_ws;
    static int grid_blocks = 0;
    if (!grid_blocks) {
        int dev = 0, cus = 0, per_cu = 0;
        hipGetDevice(&dev);
        hipDeviceGetAttribute(&cus, hipDeviceAttributeMultiprocessorCount, dev);
        hipOccupancyMaxActiveBlocksPerMultiprocessor(&per_cu, k_mega, NT, 0);
        if (per_cu < 1) { fprintf(stderr, "kernel_launch: occupancy query says %d blocks per CU\n", per_cu); per_cu = 1; }
        if (per_cu > 1) per_cu = 1;
        grid_blocks = cus * per_cu;
    }
    if (hipMemsetAsync((char*)d_ws + WS_CTL, 0, XCD_BAR_WORDS * 4, stream) != hipSuccess) { fprintf(stderr, "kernel_launch: memset of the barrier words failed\n"); return; }
    hipLaunchKernelGGL(k_mega, dim3(grid_blocks), dim3(NT), 0, stream, p);
}
```

```cpp
#include <hip/hip_runtime.h>
#include <hip/hip_cooperative_groups.h>
#include <cstdint>
#include <cstdio>

typedef unsigned short bf16_t;
typedef short bf16x8 __attribute__((ext_vector_type(8)));
typedef float f32x4 __attribute__((ext_vector_type(4)));
typedef unsigned u32x4 __attribute__((ext_vector_type(4)));
typedef unsigned u32x2 __attribute__((ext_vector_type(2)));

namespace pg8 {
#define PG8_LAS __attribute__((address_space(3)))
typedef unsigned short bf16_t;
typedef short bf16x8 __attribute__((ext_vector_type(8)));
typedef float f32x4 __attribute__((ext_vector_type(4)));
typedef unsigned u32x4 __attribute__((ext_vector_type(4)));
constexpr int BM = 256, BK = 64, HALF = 128, HTB = HALF * BK * 2  , STAGE_BYTES = 8 * HTB, NXCD = 8, WGM = 8;

__host__ __device__ __forceinline__ int lds_byte(int r, int c) { const int st = (r >> 4) * 2 + (c >> 5), rr = r & 15, cc = c & 31, ob = rr * 64 + cc * 2; return st * 1024 + (ob ^ (((ob >> 9) & 1) << 5)); }
__host__ __device__ __forceinline__ void stage_rc(int b, int& R, int& C) { const int st = b / 1024, sb = b % 1024, swz = sb ^ (((sb >> 9) & 1) << 5); R = (st >> 1) * 16 + swz / 64; C = (st & 1) * 32 + (swz % 64) / 2; }
__host__ __device__ __forceinline__ int perm32(int rho) { const int n = rho >> 4, i = rho & 15; return 8 * (i >> 2) + 4 * n + (i & 3); }

struct Unit { int pm, pn; };
struct Gemm { const bf16_t* A; const bf16_t* Bt; int M, N, K; };

struct StaticOrder {
    int nM, nN, nwg, G, c;
    __host__ __device__ void init(int M, int N, int G_, int c_) { nM = M / BM; nN = N / BM; nwg = nM * nN; G = G_; c = c_; }
    __host__ __device__ bool next(int i, Unit& u) const {
        const long L = (long)i * G + c; if (L >= nwg) return false;
        int wgid = (int)L; { const int q = nwg / NXCD, r = nwg % NXCD, xcd = wgid % NXCD, off = wgid / NXCD; wgid = (xcd < r ? xcd * (q + 1) : r * (q + 1) + (xcd - r) * q) + off; }
        const int nig = WGM * nN, gid = wgid / nig, fm = gid * WGM, gsz = (nM - fm) < WGM ? (nM - fm) : WGM;
        u.pm = fm + ((wgid % nig) % gsz); u.pn = (wgid % nig) / gsz; return true;
    }
    __device__ __forceinline__ void a_ready(const Unit&) const {}
    __device__ __forceinline__ void done(const Unit&) const {}
};
__device__ __forceinline__ unsigned cvt_pk_bf16(float lo, float hi) { unsigned r; asm volatile("v_cvt_pk_bf16_f32 %0, %1, %2" : "=v"(r) : "v"(lo), "v"(hi)); return r; }
template <class Epi, class Sched, bool STAMP = false>
__device__ __forceinline__ void gemm_phase(PG8_LAS unsigned char* lds, const Gemm g, const Sched& S, const Epi& E, unsigned long long* stamps) {
    int tid_ = threadIdx.x; asm volatile("" : "+v"(tid_));
    const int tid = tid_, wid = __builtin_amdgcn_readfirstlane(tid >> 6), lane = tid & 63, wr = wid >> 2, wc = wid & 3, fr = lane & 15, fq = lane >> 4;
    const int K = g.K, nt = K / BK;
    int ts_lo = 0, ts_hi = 0, nts = 0; const unsigned long long rt_entry = STAMP ? (unsigned long long)wall_clock64() : 0ull;
#define PG8_STAMP() do { if (STAMP && wid == 0 && nts < 64) { const unsigned long long _c = (unsigned long long)clock64(); \
        ts_lo = (lane == nts) ? (int)(unsigned)_c : ts_lo; ts_hi = (lane == nts) ? (int)(unsigned)(_c >> 32) : ts_hi; ++nts; } } while (0)
    PG8_STAMP();
    unsigned voffA[2], voffB[2];
#pragma unroll
    for (int i = 0; i < 2; ++i) { int R, C; stage_rc(tid * 16 + i * 8192, R, C); const int Rb = Epi::PERM ? ((R & ~31) + perm32(R & 31)) : R;
        voffA[i] = (unsigned)(R * K + C) * 2u; voffB[i] = (unsigned)(Rb * K + C) * 2u; }
    const size_t kstep = (size_t)(BK * 2);
    const size_t hstep = (size_t)HALF * K * 2;
    const size_t tstep = 2 * hstep;
    const unsigned ldsw = (unsigned)wid * 1024u;
    const int aoff = lds_byte(wr * 64 + fr, fq * 8), boff = lds_byte(wc * 32 + fr, fq * 8);
#define PG8_SA(b, h) (((b) * 2 + (h)) * HTB)
#define PG8_SB(b, h) ((4 + (b) * 2 + (h)) * HTB)
#define PG8_STAGE(bufoff, gbase, voff) do { _Pragma("unroll") for (int _i = 0; _i < 2; ++_i) \
        __builtin_amdgcn_global_load_lds((const unsigned*)((const char*)(gbase) + (voff)[_i]), (PG8_LAS unsigned*)(lds + (bufoff) + ldsw + _i * 8192), 16, 0, 0); } while (0)
#define PG8_LDA(dst, b, h) do { _Pragma("unroll") for (int m = 0; m < 4; ++m) _Pragma("unroll") for (int k = 0; k < 2; ++k) dst[m][k] = *(const PG8_LAS bf16x8*)(lds + PG8_SA(b, h) + aoff + m * 2048 + k * 1024); } while (0)
#define PG8_LDB(dst, b, h) do { _Pragma("unroll") for (int n = 0; n < 2; ++n) _Pragma("unroll") for (int k = 0; k < 2; ++k) dst[n][k] = *(const PG8_LAS bf16x8*)(lds + PG8_SB(b, h) + boff + n * 2048 + k * 1024); } while (0)
#define PG8_MMA(ai, bj, At, Bt) do { __builtin_amdgcn_s_setprio(1); _Pragma("unroll") for (int m = 0; m < 4; ++m) _Pragma("unroll") for (int n = 0; n < 2; ++n) _Pragma("unroll") for (int k = 0; k < 2; ++k) \
        acc[ai][bj][m][n] = __builtin_amdgcn_mfma_f32_16x16x32_bf16(Bt[n][k], At[m][k], acc[ai][bj][m][n], 0, 0, 0); __builtin_amdgcn_s_setprio(0); } while (0)
#define PG8_WAIT_V(n) asm volatile("s_waitcnt vmcnt(" #n ")" ::: "memory")
#define PG8_WAIT_L(n) asm volatile("s_waitcnt lgkmcnt(" #n ")" ::: "memory")
#define PG8_BAR __builtin_amdgcn_s_barrier()
#define PG8_SCHED __builtin_amdgcn_sched_barrier(0)
    Unit cur, nxt; int ui = 0;
    if (!S.next(0, cur)) return;
    f32x4 acc[2][2][4][2];
#pragma unroll
    for (int a = 0; a < 2; ++a)
#pragma unroll
        for (int b = 0; b < 2; ++b)
#pragma unroll
            for (int m = 0; m < 4; ++m)
#pragma unroll
                for (int n = 0; n < 2; ++n) acc[a][b][m][n] = (f32x4){0.f, 0.f, 0.f, 0.f};
    bf16x8 At[4][2], B0[2][2], B1[2][2];
    const char* cA = (const char*)g.A + (size_t)cur.pm * tstep; const char* cB = (const char*)g.Bt + (size_t)cur.pn * tstep;
    S.a_ready(cur);
    PG8_STAGE(PG8_SB(0, 0), cB, voffB); PG8_STAGE(PG8_SA(0, 0), cA, voffA); PG8_STAGE(PG8_SB(0, 1), cB + hstep, voffB); PG8_STAGE(PG8_SA(0, 1), cA + hstep, voffA);
    if (wr == 1) PG8_BAR;
    PG8_WAIT_V(4); PG8_BAR;
    PG8_STAGE(PG8_SB(1, 0), cB + kstep, voffB); PG8_STAGE(PG8_SA(1, 0), cA + kstep, voffA); PG8_STAGE(PG8_SB(1, 1), cB + hstep + kstep, voffB);
    PG8_WAIT_V(6); PG8_BAR;
    PG8_STAMP();
    for (;;) {
        const bool has_next = S.next(ui + 1, nxt);
        const char* nA = has_next ? (const char*)g.A + (size_t)nxt.pm * tstep : cA; const char* nB = has_next ? (const char*)g.Bt + (size_t)nxt.pn * tstep : cB;
        for (int t = 0; t < nt; t += 2) {
            const bool last = (t == nt - 2);
            const char* a1 = cA + (size_t)(t + 1) * kstep;
            const char* a2 = last ? nA : cA + (size_t)(t + 2) * kstep; const char* b2 = last ? nB : cB + (size_t)(t + 2) * kstep;
            const char* a3 = a2 + kstep; const char* b3 = b2 + kstep;
            if (last && has_next) S.a_ready(nxt);
            PG8_LDB(B0, 0, 0); PG8_SCHED; PG8_LDA(At, 0, 0); PG8_STAGE(PG8_SA(1, 1), a1 + hstep, voffA);
            PG8_WAIT_L(8); PG8_BAR; PG8_WAIT_L(0); PG8_MMA(0, 0, At, B0); PG8_BAR; PG8_SCHED;
            PG8_LDB(B1, 0, 1); PG8_STAGE(PG8_SB(0, 0), b2, voffB);
            PG8_BAR; PG8_WAIT_L(0); PG8_MMA(0, 1, At, B1); PG8_BAR;
            PG8_LDA(At, 0, 1); PG8_STAGE(PG8_SA(0, 0), a2, voffA);
            PG8_BAR; PG8_WAIT_L(0); PG8_MMA(1, 0, At, B0); PG8_BAR; PG8_SCHED;
            PG8_STAGE(PG8_SB(0, 1), b2 + hstep, voffB);
            PG8_WAIT_V(6); PG8_BAR; PG8_MMA(1, 1, At, B1); PG8_BAR;
            PG8_LDB(B0, 1, 0); PG8_SCHED; PG8_LDA(At, 1, 0); PG8_STAGE(PG8_SA(0, 1), a2 + hstep, voffA);
            PG8_WAIT_L(8); PG8_BAR; PG8_WAIT_L(0); PG8_MMA(0, 0, At, B0); PG8_BAR; PG8_SCHED;
            PG8_LDB(B1, 1, 1); PG8_STAGE(PG8_SB(1, 0), b3, voffB);
            PG8_BAR; PG8_WAIT_L(0); PG8_MMA(0, 1, At, B1); PG8_BAR;
            PG8_LDA(At, 1, 1); PG8_STAGE(PG8_SA(1, 0), a3, voffA);
            PG8_BAR; PG8_WAIT_L(0); PG8_MMA(1, 0, At, B0); PG8_BAR; PG8_SCHED;
            PG8_STAGE(PG8_SB(1, 1), b3 + hstep, voffB);
            PG8_WAIT_V(6); PG8_BAR; PG8_MMA(1, 1, At, B1); PG8_BAR;
        }
        PG8_STAMP();
        if constexpr (!Epi::AFTER_DRAIN) { E(acc, cur, wr, wc, fr, fq); S.done(cur); }
        PG8_STAMP();
        if (!has_next) break;
#pragma unroll
        for (int a = 0; a < 2; ++a)
#pragma unroll
            for (int b = 0; b < 2; ++b)
#pragma unroll
                for (int m = 0; m < 4; ++m)
#pragma unroll
                    for (int n = 0; n < 2; ++n) acc[a][b][m][n] = (f32x4){0.f, 0.f, 0.f, 0.f};
        cur = nxt; cA = nA; cB = nB; ++ui;
    }
    PG8_WAIT_V(0);
    if (wr == 0) PG8_BAR;
    PG8_BAR;
    if constexpr (Epi::AFTER_DRAIN) { E.fused(acc, cur, wr, wc, fr, fq, lds, wid, lane); S.done(cur); }
    PG8_STAMP();
    if (STAMP && wid == 0) { stamps[lane] = lane < nts ? (((unsigned long long)(unsigned)ts_hi << 32) | (unsigned)ts_lo) : 0ull;
        if (lane == 62) stamps[62] = rt_entry; if (lane == 63) stamps[63] = (unsigned long long)wall_clock64(); }
#undef PG8_STAMP
#undef PG8_SA
#undef PG8_SB
#undef PG8_STAGE
#undef PG8_LDA
#undef PG8_LDB
#undef PG8_MMA
#undef PG8_WAIT_V
#undef PG8_WAIT_L
#undef PG8_BAR
#undef PG8_SCHED
}
}

#ifndef DUP
#define DUP 0
#endif
namespace cg = cooperative_groups;
namespace {
constexpr int NB = 8, NS = 2048, ND = 1024, NL = 256, GW = 64, NROWS = 32;
constexpr int MT = NB * NS;
constexpr int MC = NB * NL;
constexpr int MA = MT + MC;
constexpr int NIN = 4096;
constexpr int NT = 512;
constexpr float EPS = 1e-6f;

constexpr size_t MiB = 1ull << 20;
constexpr size_t WS_CTL = 0;
constexpr size_t WS_MOD = 64 * 1024;
constexpr size_t WS_LB = 320 * 1024;
constexpr size_t WS_KEYS = 512 * 1024;
constexpr size_t WS_WIN = 1 * MiB;
constexpr size_t WS_WOUT = 9 * MiB;
constexpr size_t WS_WQ = 11 * MiB;
constexpr size_t WS_U = 15 * MiB;
constexpr size_t WS_V = 47 * MiB;
constexpr size_t WS_QHC = 47 * MiB;
constexpr size_t WS_S0T = 66 * MiB;
constexpr size_t WS_XN = 79 * MiB;
constexpr size_t WS_NAQ = 115 * MiB;
constexpr size_t WS_NAK = 131 * MiB;
constexpr size_t WS_NAV = 149 * MiB;
constexpr size_t WS_HQ = 167 * MiB;
constexpr size_t WS_ZF = 183 * MiB;
constexpr size_t WS_ZB = 201 * MiB;
constexpr size_t WS_HI = 219 * MiB;
constexpr size_t WS_HG = 237 * MiB;
constexpr size_t WS_END = 253 * MiB;
constexpr size_t WS_PQ = 115 * MiB;
constexpr size_t WS_PIDX = 179 * MiB;
constexpr size_t WS_PG = 187 * MiB;

struct Params {
    const float* x; const float* c; const float* ctx; const float* c_ctx; const float* w_mod; const float* b_mod;
    const float* norm1; const float* norm2; const float* w_in; const float* w_out; const float* rpb; const float* hg_lb;
    const float* hg_norm; const float* wq; const float* keys; const float* pu; const float* pv; const float* norm_f;
    float* out; unsigned char* ws;
};

__device__ __forceinline__ bf16_t f2bf(float f) { unsigned u = __float_as_uint(f); u += 0x7fffu + ((u >> 16) & 1u); return (bf16_t)(u >> 16); }
__device__ __forceinline__ float bf2f(bf16_t h) { return __uint_as_float(((unsigned)h) << 16); }
__device__ __forceinline__ unsigned pack2(float lo, float hi) { return (unsigned)f2bf(lo) | ((unsigned)f2bf(hi) << 16); }
__device__ __forceinline__ float bflo(unsigned w) { return __uint_as_float(w << 16); }
__device__ __forceinline__ float bfhi(unsigned w) { return __uint_as_float(w & 0xffff0000u); }
__device__ __forceinline__ float silu_f(float v) { return v / (1.f + __expf(-v)); }
__device__ __forceinline__ float sigmoid_f(float v) { return 1.f / (1.f + __expf(-v)); }
__device__ __forceinline__ float wave_sum(float v) {
#pragma unroll
    for (int o = 32; o >= 1; o >>= 1) v += __shfl_xor(v, o);
    return v;
}

__device__ __forceinline__ void mod_phase(const Params& p, float* lds) {
    float* sc = lds;
    float* red = lds + 9 * 1024;
    const int tid = threadIdx.x;
    float* mod = (float*)(p.ws + WS_MOD);
    for (int i = tid; i < 9 * 1024; i += NT) {
        const int r = i >> 10, k = i & 1023;
        const float v = (r < 8) ? p.c[r * 1024 + k] : p.c_ctx[k];
        sc[i] = silu_f(v);
    }
    __syncthreads();
    const int c4 = tid & 15, ks = tid >> 4, lane = tid & 63, wave = tid >> 6;
    for (int unit = blockIdx.x; unit < 6144 / 64; unit += gridDim.x) {
        const int j0 = unit * 64 + c4 * 4;
        f32x4 acc[9];
#pragma unroll
        for (int r = 0; r < 9; ++r) acc[r] = (f32x4){0.f, 0.f, 0.f, 0.f};
#pragma unroll 1
        for (int kb = ks * 32; kb < ks * 32 + 32; kb += 8) {
            f32x4 w[8];
#pragma unroll
            for (int i = 0; i < 8; ++i) w[i] = *(const f32x4*)(p.w_mod + (size_t)(kb + i) * 6144 + j0);
#pragma unroll
            for (int i = 0; i < 8; ++i)
#pragma unroll
                for (int r = 0; r < 9; ++r) acc[r] += w[i] * sc[r * 1024 + kb + i];
        }
#pragma unroll
        for (int r = 0; r < 9; ++r)
#pragma unroll
            for (int e = 0; e < 4; ++e) { float v = acc[r][e]; v += __shfl_xor(v, 16); v += __shfl_xor(v, 32); acc[r][e] = v; }
        if (lane < 16) {
#pragma unroll
            for (int r = 0; r < 9; ++r) *(f32x4*)(red + (wave * 9 + r) * 64 + c4 * 4) = acc[r];
        }
        __syncthreads();
        for (int i = tid; i < 9 * 64; i += NT) {
            const int r = i >> 6, cc = i & 63;
            float s = 0.f;
#pragma unroll
            for (int q = 0; q < 8; ++q) s += red[(q * 9 + r) * 64 + cc];
            mod[r * 6144 + unit * 64 + cc] = s + p.b_mod[unit * 64 + cc];
        }
        __syncthreads();
    }
    float* lb = (float*)(p.ws + WS_LB);
    for (int i = blockIdx.x * NT + tid; i < 1024; i += gridDim.x * NT) {
        const float a0 = p.hg_lb[i], a1 = p.hg_lb[1024 + i];
        lb[i] = 1.f / (1.f + __expf(a1 - a0));
    }
}

__device__ __forceinline__ void transpose_convert(const float* W, bf16_t* Wt, int K, int N, float* lds) {
    const int tid = threadIdx.x;
    const int tk = K / 64, tn = N / 64;
    for (int unit = blockIdx.x; unit < tk * tn; unit += gridDim.x) {
        const int k0 = (unit / tn) * 64, n0 = (unit % tn) * 64;
        for (int i = tid; i < 64 * 64; i += NT) { const int r = i >> 6, cc = i & 63; lds[r * 65 + cc] = W[(size_t)(k0 + r) * N + n0 + cc]; }
        __syncthreads();
        for (int i = tid; i < 64 * 64; i += NT) { const int n = i >> 6, k = i & 63; Wt[(size_t)(n0 + n) * K + k0 + k] = f2bf(lds[k * 65 + n]); }
        __syncthreads();
    }
}
__device__ __forceinline__ void convert_flat(const float* src, bf16_t* dst, size_t n) {
    const size_t stride = (size_t)gridDim.x * NT * 4;
    for (size_t i = ((size_t)blockIdx.x * NT + threadIdx.x) * 4; i < n; i += stride) {
        const f32x4 v = *(const f32x4*)(src + i);
        u32x2 o; o.x = pack2(v[0], v[1]); o.y = pack2(v[2], v[3]);
        *(u32x2*)(dst + i) = o;
    }
}

__device__ __forceinline__ void convert_uv_fp8(const float* u, const float* v, unsigned char* uv, int blk, int nblk) {
    const size_t nq = (size_t)16384 * 256;
    const size_t stride = (size_t)nblk * NT;
    for (size_t i = (size_t)blk * NT + threadIdx.x; i < 2 * nq; i += stride) {
        const bool isv = i >= nq; const size_t q = isv ? i - nq : i;
        const size_t e = q >> 8, c = q & 255;
        const f32x4 x = *(const f32x4*)((isv ? v : u) + q * 4) * (isv ? 8.f : 64.f);
        int w = 0;
        w = __builtin_amdgcn_cvt_pk_fp8_f32(x[0], x[1], w, false);
        w = __builtin_amdgcn_cvt_pk_fp8_f32(x[2], x[3], w, true);
        *(int*)(uv + e * 2048 + (isv ? 1024 : 0) + c * 4) = w;
    }
}

__device__ __forceinline__ unsigned fp6_code(float x) {
    const float a = fminf(fabsf(x), 7.5f);
    float c = a < 2.f ? __builtin_rintf(a * 8.f) : (a < 4.f ? 16.f + __builtin_rintf((a - 2.f) * 4.f) : 24.f + __builtin_rintf((a - 4.f) * 2.f));
    return (unsigned)c | (x < 0.f ? 32u : 0u);
}
__device__ __forceinline__ void convert_uv_fp6(const float* u, const float* v, unsigned char* uv, int blk, int nblk) {
    const size_t ng = (size_t)16384 * 32;
    const size_t stride = (size_t)nblk * NT;
    for (size_t i = (size_t)blk * NT + threadIdx.x; i < 2 * ng; i += stride) {
        const bool isv = i >= ng; const size_t q = isv ? i - ng : i;
        const size_t e = q >> 5, grp = q & 31;
        const float* src = (isv ? v : u) + q * 32; const float sc = isv ? 5.5f : 64.f;
        unsigned w[6] = {0u, 0u, 0u, 0u, 0u, 0u};
#pragma unroll
        for (int j = 0; j < 8; ++j) {
            const f32x4 x = *(const f32x4*)(src + j * 4) * sc;
#pragma unroll
            for (int k = 0; k < 4; ++k) {
                const int idx = j * 4 + k, bit = idx * 6, dw = bit >> 5, off = bit & 31;
                const unsigned code = fp6_code(x[k]);
                w[dw] |= code << off;
                if (off > 26) w[dw + 1] |= code >> (32 - off);
            }
        }
        unsigned* dst = (unsigned*)(uv + e * 1536 + (isv ? 768 : 0) + grp * 24);
        *(u32x2*)dst = (u32x2){w[0], w[1]}; *(u32x2*)(dst + 2) = (u32x2){w[2], w[3]}; *(u32x2*)(dst + 4) = (u32x2){w[4], w[5]};
    }
}

__device__ __forceinline__ void prep_phase(const Params& p, int which) {
    const int tid = threadIdx.x, lane = tid & 63, wave = tid >> 6;
    const float* mod = (const float*)(p.ws + WS_MOD);
    bf16_t* dst = (bf16_t*)(p.ws + WS_XN);
    const int nrows = which == 0 ? MA : MT;
    const float* g = which == 0 ? p.norm1 : p.norm2;
    for (int row = blockIdx.x * 8 + wave; row < nrows; row += gridDim.x * 8) {
        const float* src; int mr;
        if (which == 0) { if (row < MT) { src = p.x + (size_t)row * ND; mr = row / NS; } else { src = p.ctx + (size_t)(row - MT) * ND; mr = 8; } }
        else { src = p.out + (size_t)row * ND; mr = row / NS; }
        const float* sh = mod + mr * 6144 + (which == 0 ? 0 : 3072);
        const float* scl = mod + mr * 6144 + (which == 0 ? 1024 : 4096);
        f32x4 v[4]; float ss = 0.f;
#pragma unroll
        for (int i = 0; i < 4; ++i) { v[i] = *(const f32x4*)(src + i * 256 + lane * 4); ss += v[i][0] * v[i][0] + v[i][1] * v[i][1] + v[i][2] * v[i][2] + v[i][3] * v[i][3]; }
        ss = wave_sum(ss);
        const float rstd = rsqrtf(ss * (1.f / ND) + EPS);
#pragma unroll
        for (int i = 0; i < 4; ++i) {
            const int d = i * 256 + lane * 4;
            const f32x4 gg = *(const f32x4*)(g + d), s1 = *(const f32x4*)(sh + d), s2 = *(const f32x4*)(scl + d);
            float h[4];
#pragma unroll
            for (int e = 0; e < 4; ++e) h[e] = (v[i][e] * rstd * gg[e]) * (1.f + s2[e]) + s1[e];
            u32x2 o; o.x = pack2(h[0], h[1]); o.y = pack2(h[2], h[3]);
            *(u32x2*)(dst + (size_t)row * ND + d) = o;
        }
    }
}


struct InProjOrder {
    pg8::StaticOrder so; int G, c;
    __device__ void init(int G_, int c_) { so.init(MT, NIN, G_, c_); G = G_; c = c_; }
    __device__ bool next(int i, pg8::Unit& u) const {
        const long L = (long)i * G + c;
        if (L < 1024) return so.next(i, u);
        const int j = (int)(L - 1024); if (j >= 80) return false;
        const int q = j % 10; u.pm = 64 + j / 10; u.pn = q < 4 ? 2 + q : 4 + q;
        return true;
    }
    __device__ __forceinline__ void a_ready(const pg8::Unit&) const {}
    __device__ __forceinline__ void done(const pg8::Unit&) const {}
};
struct EpiInProj8 {
    static constexpr bool PERM = true, AFTER_DRAIN = false;
    unsigned char* ws;
    __device__ __forceinline__ void operator()(const f32x4 (&acc)[2][2][4][2], const pg8::Unit& u, int wr, int wc, int fr, int fq) const {
#pragma unroll
        for (int bj = 0; bj < 2; ++bj) {
            const int c0 = u.pn * 256 + bj * 128 + wc * 32 + 8 * fq, seg = c0 >> 9, c = c0 & 511;
#pragma unroll
            for (int ai = 0; ai < 2; ++ai)
#pragma unroll
                for (int m = 0; m < 4; ++m) {
                    const int row = u.pm * 256 + ai * 128 + wr * 64 + m * 16 + fr;
                    f32x4 v0 = acc[ai][bj][m][0], v1 = acc[ai][bj][m][1];
                    if (seg == 2 || seg == 6) {
                        bf16_t* vt = (bf16_t*)(ws + (seg == 2 ? WS_NAV : WS_HI));
                        const int hd = seg == 2 ? 64 : 128, nh = 512 / hd, hh = c / hd, dim = c % hd;
                        bf16_t* q; size_t st;
                        if (row < MT) { const int b = row >> 11, s = row & 2047; q = vt + ((size_t)((b * nh + hh) * hd + dim)) * 2048 + s; st = 2048; }
                        else { const int mm = row - MT, b = mm >> 8, j = mm & 255; q = vt + (size_t)MT * 512 + ((size_t)((b * nh + hh) * hd + dim)) * 256 + j; st = 256; }
#pragma unroll
                        for (int e = 0; e < 4; ++e) { q[e * st] = f2bf(v0[e]); q[(4 + e) * st] = f2bf(v1[e]); }
                    } else {
                        if (seg == 0) { v0 = v0 * 0.18033688011f; v1 = v1 * 0.18033688011f; }
                        if (seg == 4 || seg == 5) {
                            const float* lbp = (const float*)(ws + WS_LB) + (seg - 4) * 512 + c;
                            const f32x4 l0 = *(const f32x4*)lbp, l1 = *(const f32x4*)(lbp + 4);
#pragma unroll
                            for (int e = 0; e < 4; ++e) {
                                v0[e] = __builtin_amdgcn_logf(l0[e] + (1.f - l0[e]) * __builtin_amdgcn_rcpf(1.f + __builtin_amdgcn_exp2f(-1.44269504f * v0[e])));
                                v1[e] = __builtin_amdgcn_logf(l1[e] + (1.f - l1[e]) * __builtin_amdgcn_rcpf(1.f + __builtin_amdgcn_exp2f(-1.44269504f * v1[e])));
                            }
                        }
                        if (seg == 3 || seg == 7) {
#pragma unroll
                            for (int e = 0; e < 4; ++e) { v0[e] = silu_f(v0[e]); v1[e] = silu_f(v1[e]); }
                        }
                        const size_t wsoff = seg == 0 ? WS_NAQ : seg == 1 ? WS_NAK : seg == 3 ? WS_HQ : seg == 4 ? WS_ZF : seg == 5 ? WS_ZB : seg == 6 ? WS_HI : WS_HG;
                        u32x4 w; w[0] = pack2(v0[0], v0[1]); w[1] = pack2(v0[2], v0[3]); w[2] = pack2(v1[0], v1[1]); w[3] = pack2(v1[2], v1[3]);
                        *(u32x4*)((bf16_t*)(ws + wsoff) + (size_t)row * 512 + c) = w;
                    }
                }
        }
    }
};
struct EpiOutProj8 {
    static constexpr bool PERM = false, AFTER_DRAIN = false;
    const float* x; const float* mod; float* out;
    __device__ __forceinline__ void operator()(const f32x4 (&acc)[2][2][4][2], const pg8::Unit& u, int wr, int wc, int fr, int fq) const {
        const int row0 = u.pm * 256 + wr * 64 + fr, col0 = u.pn * 256 + wc * 32 + 4 * fq;
        const int b = (u.pm * 256) / NS;
        f32x4 gv[2][2];
#pragma unroll
        for (int bj = 0; bj < 2; ++bj)
#pragma unroll
            for (int n = 0; n < 2; ++n) gv[bj][n] = *(const f32x4*)(mod + b * 6144 + 2048 + col0 + bj * 128 + n * 16);
#pragma unroll
        for (int ai = 0; ai < 2; ++ai)
#pragma unroll
            for (int m = 0; m < 4; ++m) {
                const size_t ro = (size_t)(row0 + ai * 128 + m * 16) * ND + col0;
#pragma unroll
                for (int bj = 0; bj < 2; ++bj)
#pragma unroll
                    for (int n = 0; n < 2; ++n) *(f32x4*)(out + ro + bj * 128 + n * 16) = *(const f32x4*)(x + ro + bj * 128 + n * 16) + gv[bj][n] * acc[ai][bj][m][n];
            }
    }
};
struct EpiPq8 {
    static constexpr bool PERM = true, AFTER_DRAIN = false;
    bf16_t* pq;
    __device__ __forceinline__ void operator()(const f32x4 (&acc)[2][2][4][2], const pg8::Unit& u, int wr, int wc, int fr, int fq) const {
#pragma unroll
        for (int ai = 0; ai < 2; ++ai)
#pragma unroll
            for (int m = 0; m < 4; ++m)
#pragma unroll
                for (int bj = 0; bj < 2; ++bj) {
                    const f32x4 v0 = acc[ai][bj][m][0], v1 = acc[ai][bj][m][1];
                    u32x4 w; w[0] = pack2(v0[0], v0[1]); w[1] = pack2(v0[2], v0[3]); w[2] = pack2(v1[0], v1[1]); w[3] = pack2(v1[2], v1[3]);
                    *(u32x4*)(pq + (size_t)(u.pm * 256 + ai * 128 + wr * 64 + m * 16 + fr) * 2048 + u.pn * 256 + bj * 128 + wc * 32 + 8 * fq) = w;
                }
    }
};
__device__ __forceinline__ void inproj8_phase(const Params& p, unsigned char* lds) {
    pg8::Gemm g{(const bf16_t*)(p.ws + WS_XN), (const bf16_t*)(p.ws + WS_WIN), MA, NIN, ND};
    InProjOrder S; S.init((int)gridDim.x, (int)blockIdx.x);
    EpiInProj8 E{p.ws};
    pg8::gemm_phase<EpiInProj8, InProjOrder>((PG8_LAS unsigned char*)lds, g, S, E, nullptr);
    const int G = (int)gridDim.x, nidle = G > 80 ? G - 80 : G;
    if (G <= 80 || (int)blockIdx.x >= 80) convert_uv_fp6(p.pu, p.pv, p.ws + WS_U, G > 80 ? (int)blockIdx.x - 80 : (int)blockIdx.x, nidle);
}
__device__ __forceinline__ void outproj8_phase(const Params& p, unsigned char* lds) {
    pg8::Gemm g{(const bf16_t*)(p.ws + WS_XN), (const bf16_t*)(p.ws + WS_WOUT), MT, ND, ND};
    pg8::StaticOrder S; S.init(MT, ND, (int)gridDim.x, (int)blockIdx.x);
    EpiOutProj8 E{p.x, (const float*)(p.ws + WS_MOD), p.out};
    pg8::gemm_phase<EpiOutProj8, pg8::StaticOrder>((PG8_LAS unsigned char*)lds, g, S, E, nullptr);
}
__device__ __forceinline__ void pq8_phase(const Params& p, unsigned char* lds) {
    pg8::Gemm g{(const bf16_t*)(p.ws + WS_XN), (const bf16_t*)(p.ws + WS_WQ), MT, 2048, ND};
    pg8::StaticOrder S; S.init(MT, 2048, (int)gridDim.x, (int)blockIdx.x);
    EpiPq8 E{(bf16_t*)(p.ws + WS_PQ)};
    pg8::gemm_phase<EpiPq8, pg8::StaticOrder>((PG8_LAS unsigned char*)lds, g, S, E, nullptr);
}

template <class Epi>
__device__ __forceinline__ void gemm_tile(const bf16_t* __restrict__ A, int lda, const bf16_t* __restrict__ Bt, int ldb, int K, int m0, int n0, unsigned char* lds, const Epi& epi) {
    unsigned char* As = lds; unsigned char* Bs = lds + 32768;
    const int tid = threadIdx.x, lane = tid & 63, wave = tid >> 6;
    const int wm = wave >> 1, wn = wave & 1;
    const int lr = tid >> 3, lc = tid & 7;
    const int fr = lane & 15, fq = lane >> 4;
    f32x4 acc[4][4];
#pragma unroll
    for (int i = 0; i < 4; ++i)
#pragma unroll
        for (int j = 0; j < 4; ++j) acc[i][j] = (f32x4){0.f, 0.f, 0.f, 0.f};
    u32x4 ra[4], rb[2];
    const bf16_t* Ap = A + (size_t)(m0 + lr) * lda + lc * 8;
    const bf16_t* Bp = Bt + (size_t)(n0 + lr) * ldb + lc * 8;
#pragma unroll
    for (int i = 0; i < 4; ++i) ra[i] = *(const u32x4*)(Ap + (size_t)(i * 64) * lda);
#pragma unroll
    for (int i = 0; i < 2; ++i) rb[i] = *(const u32x4*)(Bp + (size_t)(i * 64) * ldb);
    const int nkt = K / 64;
    for (int kt = 0; kt < nkt; ++kt) {
#pragma unroll
        for (int i = 0; i < 4; ++i) { const int r = lr + i * 64; *(u32x4*)(As + r * 128 + ((lc ^ (r & 7)) << 4)) = ra[i]; }
#pragma unroll
        for (int i = 0; i < 2; ++i) { const int r = lr + i * 64; *(u32x4*)(Bs + r * 128 + ((lc ^ (r & 7)) << 4)) = rb[i]; }
        __syncthreads();
        if (kt + 1 < nkt) {
            const int k0 = (kt + 1) * 64;
#pragma unroll
            for (int i = 0; i < 4; ++i) ra[i] = *(const u32x4*)(Ap + (size_t)(i * 64) * lda + k0);
#pragma unroll
            for (int i = 0; i < 2; ++i) rb[i] = *(const u32x4*)(Bp + (size_t)(i * 64) * ldb + k0);
        }
#pragma unroll
        for (int kk = 0; kk < 2; ++kk) {
            const int ch = kk * 4 + fq;
            bf16x8 fa[4], fb[4];
#pragma unroll
            for (int i = 0; i < 4; ++i) { const int r = wm * 64 + i * 16 + fr; fa[i] = *(const bf16x8*)(As + r * 128 + ((ch ^ (r & 7)) << 4)); }
#pragma unroll
            for (int j = 0; j < 4; ++j) { const int r = wn * 64 + j * 16 + fr; fb[j] = *(const bf16x8*)(Bs + r * 128 + ((ch ^ (r & 7)) << 4)); }
#pragma unroll
            for (int i = 0; i < 4; ++i)
#pragma unroll
                for (int j = 0; j < 4; ++j) acc[i][j] = __builtin_amdgcn_mfma_f32_16x16x32_bf16(fb[j], fa[i], acc[i][j], 0, 0, 0);
        }
        __syncthreads();
    }
#pragma unroll
    for (int i = 0; i < 4; ++i)
#pragma unroll
        for (int j = 0; j < 4; ++j) epi(m0 + wm * 64 + i * 16 + fr, n0 + wn * 64 + j * 16 + fq * 4, acc[i][j]);
}

__device__ __forceinline__ void store_bf16x4(bf16_t* dst, const f32x4& v) { u32x2 o; o.x = pack2(v[0], v[1]); o.y = pack2(v[2], v[3]); *(u32x2*)dst = o; }

struct EpiInProj {
    unsigned char* ws;
    __device__ __forceinline__ void operator()(int m, int n, const f32x4& v) const {
        const int seg = n >> 9, c = n & 511;
        const size_t o = (size_t)m * 512 + c;
        switch (seg) {
            case 0: { f32x4 s = v * 0.125f; store_bf16x4((bf16_t*)(ws + WS_NAQ) + o, s); break; }
            case 1: store_bf16x4((bf16_t*)(ws + WS_NAK) + o, v); break;
            case 2: {
                bf16_t* vt = (bf16_t*)(ws + WS_NAV); const int hh = c >> 6, dim = c & 63;
                if (m < MT) { const int b = m >> 11, s = m & 2047; bf16_t* q = vt + ((size_t)((b * 8 + hh) * 64 + dim)) * 2048 + s;
                    q[0] = f2bf(v[0]); q[2048] = f2bf(v[1]); q[4096] = f2bf(v[2]); q[6144] = f2bf(v[3]); }
                else { const int mm = m - MT, b = mm >> 8, j = mm & 255; bf16_t* q = vt + (size_t)MT * 512 + ((size_t)((b * 8 + hh) * 64 + dim)) * 256 + j;
                    q[0] = f2bf(v[0]); q[256] = f2bf(v[1]); q[512] = f2bf(v[2]); q[768] = f2bf(v[3]); }
                break; }
            case 3: { f32x4 s; s[0] = silu_f(v[0]); s[1] = silu_f(v[1]); s[2] = silu_f(v[2]); s[3] = silu_f(v[3]); store_bf16x4((bf16_t*)(ws + WS_HQ) + o, s); break; }
            case 4: store_bf16x4((bf16_t*)(ws + WS_ZF) + o, v); break;
            case 5: store_bf16x4((bf16_t*)(ws + WS_ZB) + o, v); break;
            case 6: store_bf16x4((bf16_t*)(ws + WS_HI) + o, v); break;
            default: { f32x4 s; s[0] = silu_f(v[0]); s[1] = silu_f(v[1]); s[2] = silu_f(v[2]); s[3] = silu_f(v[3]); store_bf16x4((bf16_t*)(ws + WS_HG) + o, s); break; }
        }
    }
};
__device__ __forceinline__ void inproj_phase(const Params& p, unsigned char* lds) {
    const bf16_t* A = (const bf16_t*)(p.ws + WS_XN); const bf16_t* Bt = (const bf16_t*)(p.ws + WS_WIN);
    EpiInProj epi{p.ws};
    const int nlat = 64 * 32, nctx = 8 * 20;
    for (int unit = blockIdx.x; unit < nlat + nctx; unit += gridDim.x) {
        int mt, nt;
        if (unit < nlat) { mt = unit >> 5; nt = unit & 31; }
        else { const int u = unit - nlat; mt = 64 + u / 20; const int q = u % 20; nt = q < 8 ? 4 + q : 16 + (q - 8); }
        gemm_tile(A, ND, Bt, ND, ND, mt * 256, nt * 128, lds, epi);
    }
}

struct EpiOutProj {
    const float* x; const float* mod; float* out;
    __device__ __forceinline__ void operator()(int m, int n, const f32x4& v) const {
        const int b = m / NS;
        const f32x4 xv = *(const f32x4*)(x + (size_t)m * ND + n), g = *(const f32x4*)(mod + b * 6144 + 2048 + n);
        *(f32x4*)(out + (size_t)m * ND + n) = xv + g * v;
    }
};
__device__ __forceinline__ void outproj_phase(const Params& p, unsigned char* lds) {
    const bf16_t* A = (const bf16_t*)(p.ws + WS_XN); const bf16_t* Bt = (const bf16_t*)(p.ws + WS_WOUT);
    EpiOutProj epi{p.x, (const float*)(p.ws + WS_MOD), p.out};
    for (int unit = blockIdx.x; unit < 64 * 8; unit += gridDim.x) gemm_tile(A, ND, Bt, ND, ND, (unit >> 3) * 256, (unit & 7) * 128, lds, epi);
}
struct EpiPq { bf16_t* pq; __device__ __forceinline__ void operator()(int m, int n, const f32x4& v) const { store_bf16x4(pq + (size_t)m * 2048 + n, v); } };
__device__ __forceinline__ void pq_phase(const Params& p, unsigned char* lds) {
    const bf16_t* A = (const bf16_t*)(p.ws + WS_XN); const bf16_t* Bt = (const bf16_t*)(p.ws + WS_WQ);
    EpiPq epi{(bf16_t*)(p.ws + WS_PQ)};
    for (int unit = blockIdx.x; unit < 64 * 16; unit += gridDim.x) gemm_tile(A, ND, Bt, ND, ND, (unit >> 4) * 256, (unit & 15) * 128, lds, epi);
}

__device__ __forceinline__ void na_naive_phase(const Params& p) {
    const bf16_t* Q = (const bf16_t*)(p.ws + WS_NAQ); const bf16_t* Kk = (const bf16_t*)(p.ws + WS_NAK); const bf16_t* V = (const bf16_t*)(p.ws + WS_NAV);
    bf16_t* mix = (bf16_t*)(p.ws + WS_XN);
    const int tid = threadIdx.x;
    for (int unit = blockIdx.x; unit < MT / 64; unit += gridDim.x) {
        const int tok = unit * 64 + (tid >> 3), h = tid & 7;
        const int b = tok / NS, s = tok % NS, r = s >> 6, qc = s & 63;
        const int rs = min(max(r - 4, 0), NROWS - 8), cs = min(max(qc - 8, 0), GW - 16);
        float q[64], o[64];
        {
            const u32x4* qp = (const u32x4*)(Q + (size_t)tok * 512 + h * 64);
#pragma unroll
            for (int i = 0; i < 8; ++i) { const u32x4 w = qp[i];
#pragma unroll
                for (int e = 0; e < 4; ++e) { q[i * 8 + e * 2] = bflo(w[e]); q[i * 8 + e * 2 + 1] = bfhi(w[e]); } }
        }
#pragma unroll
        for (int i = 0; i < 64; ++i) o[i] = 0.f;
        float mx = -1e30f, l = 0.f;
        for (int it = 0; it < 128 + 256; ++it) {
            int kt; float bias = 0.f;
            if (it < 128) { const int kr = it >> 4, kc = it & 15; kt = b * NS + (rs + kr) * 64 + cs + kc; bias = p.rpb[h * 15 * 31 + (rs + kr - r + 7) * 31 + (cs + kc - qc + 15)]; }
            else kt = MT + b * NL + (it - 128);
            const u32x4* kp = (const u32x4*)(Kk + (size_t)kt * 512 + h * 64);
            float d = 0.f;
#pragma unroll
            for (int i = 0; i < 8; ++i) { const u32x4 w = kp[i];
#pragma unroll
                for (int e = 0; e < 4; ++e) { d += q[i * 8 + e * 2] * bflo(w[e]); d += q[i * 8 + e * 2 + 1] * bfhi(w[e]); } }
            d += bias;
            const float mn = fmaxf(mx, d), sc = __expf(mx - mn), pe = __expf(d - mn);
            l = l * sc + pe; mx = mn;
            const u32x4* vp = (const u32x4*)(V + (size_t)kt * 512 + h * 64);
#pragma unroll
            for (int i = 0; i < 8; ++i) { const u32x4 w = vp[i];
#pragma unroll
                for (int e = 0; e < 4; ++e) { o[i * 8 + e * 2] = o[i * 8 + e * 2] * sc + pe * bflo(w[e]); o[i * 8 + e * 2 + 1] = o[i * 8 + e * 2 + 1] * sc + pe * bfhi(w[e]); } }
        }
        const float inv = 1.f / l;
        u32x4* op = (u32x4*)(mix + (size_t)tok * ND + h * 64);
#pragma unroll
        for (int i = 0; i < 8; ++i) { u32x4 w;
#pragma unroll
            for (int e = 0; e < 4; ++e) w[e] = pack2(o[i * 8 + e * 2] * inv, o[i * 8 + e * 2 + 1] * inv);
            op[i] = w; }
    }
}

__device__ __forceinline__ void na_mfma_phase(const Params& p, float* rpbL, int blk, int nblk) {
    const bf16_t* Q = (const bf16_t*)(p.ws + WS_NAQ); const bf16_t* Kk = (const bf16_t*)(p.ws + WS_NAK); const bf16_t* VT = (const bf16_t*)(p.ws + WS_NAV);
    bf16_t* mix = (bf16_t*)(p.ws + WS_XN);
    const int tid = threadIdx.x, lane = tid & 63, wave = tid >> 6, fr = lane & 15, fq = lane >> 4;
    for (int i = tid; i < 8 * 15 * 31; i += NT) rpbL[i] = p.rpb[i];
    __syncthreads();
    for (int bu = blk; bu < 1024; bu += nblk) {
        const int u = bu * 8 + wave;
        const int cb = u & 3, r = (u >> 2) & 31, h = (u >> 7) & 7, b = u >> 10;
        const int rs = min(max(r - 4, 0), NROWS - 8), kc0 = min(max(cb * 16 - 8, 0), GW - 32);
        const int qc = cb * 16 + fr, cs = min(max(qc - 8, 0), GW - 16);
        const size_t qtok = (size_t)b * NS + r * 64 + qc;
        const bf16x8 q0 = *(const bf16x8*)(Q + qtok * 512 + h * 64 + fq * 8), q1 = *(const bf16x8*)(Q + qtok * 512 + h * 64 + 32 + fq * 8);
        f32x4 o[4];
#pragma unroll
        for (int mt = 0; mt < 4; ++mt) o[mt] = (f32x4){0.f, 0.f, 0.f, 0.f};
        float mx = -1e30f, l = 0.f;
#pragma unroll 1
        for (int g = 0; g < 4; ++g) {
            const bool win = g < 2;
            f32x4 s[8];
#pragma unroll
            for (int tl = 0; tl < 8; ++tl) {
                const size_t kt = win ? (size_t)b * NS + (rs + g * 4 + (tl >> 1)) * 64 + kc0 + (tl & 1) * 16 + fr : (size_t)MT + b * NL + ((g - 2) * 8 + tl) * 16 + fr;
                const bf16x8 k0 = *(const bf16x8*)(Kk + kt * 512 + h * 64 + fq * 8), k1 = *(const bf16x8*)(Kk + kt * 512 + h * 64 + 32 + fq * 8);
                f32x4 acc = (f32x4){0.f, 0.f, 0.f, 0.f};
                acc = __builtin_amdgcn_mfma_f32_16x16x32_bf16(k0, q0, acc, 0, 0, 0);
                acc = __builtin_amdgcn_mfma_f32_16x16x32_bf16(k1, q1, acc, 0, 0, 0);
                s[tl] = acc;
            }
            if (win) {
#pragma unroll
                for (int tl = 0; tl < 8; ++tl) {
                    const int dr = rs + g * 4 + (tl >> 1) - r + 7;
#pragma unroll
                    for (int e = 0; e < 4; ++e) {
                        const int kcol = kc0 + (tl & 1) * 16 + fq * 4 + e;
                        const bool ok = (kcol >= cs) && (kcol < cs + 16);
                        const int dc = min(max(kcol - qc + 15, 0), 30);
                        s[tl][e] = ok ? s[tl][e] + rpbL[h * 465 + dr * 31 + dc] : -1e30f;
                    }
                }
            }
            float gm = -1e30f;
#pragma unroll
            for (int tl = 0; tl < 8; ++tl) gm = fmaxf(gm, fmaxf(fmaxf(s[tl][0], s[tl][1]), fmaxf(s[tl][2], s[tl][3])));
            gm = fmaxf(gm, __shfl_xor(gm, 16)); gm = fmaxf(gm, __shfl_xor(gm, 32));
            const float mn = fmaxf(mx, gm), sc = __expf(mx - mn);
            mx = mn;
            float ls = 0.f;
#pragma unroll
            for (int tl = 0; tl < 8; ++tl)
#pragma unroll
                for (int e = 0; e < 4; ++e) { const float pe = __expf(s[tl][e] - mn); s[tl][e] = pe; ls += pe; }
            l = l * sc + ls;
#pragma unroll
            for (int mt = 0; mt < 4; ++mt) o[mt] = o[mt] * sc;
#pragma unroll
            for (int pl = 0; pl < 4; ++pl) {
                u32x4 pw; pw[0] = pack2(s[2 * pl][0], s[2 * pl][1]); pw[1] = pack2(s[2 * pl][2], s[2 * pl][3]); pw[2] = pack2(s[2 * pl + 1][0], s[2 * pl + 1][1]); pw[3] = pack2(s[2 * pl + 1][2], s[2 * pl + 1][3]);
                const bf16x8 pf = __builtin_bit_cast(bf16x8, pw);
#pragma unroll
                for (int mt = 0; mt < 4; ++mt) {
                    const size_t drow = (size_t)((b * 8 + h) * 64 + mt * 16 + fr);
                    const bf16_t* vp = win ? VT + drow * 2048 + (rs + g * 4 + pl) * 64 + kc0 + fq * 4 : VT + (size_t)MT * 512 + drow * 256 + ((g - 2) * 4 + pl) * 32 + fq * 4;
                    const u32x2 va = *(const u32x2*)vp, vb = *(const u32x2*)(vp + 16);
                    u32x4 vw; vw[0] = va[0]; vw[1] = va[1]; vw[2] = vb[0]; vw[3] = vb[1];
                    o[mt] = __builtin_amdgcn_mfma_f32_16x16x32_bf16(__builtin_bit_cast(bf16x8, vw), pf, o[mt], 0, 0, 0);
                }
            }
        }
        l += __shfl_xor(l, 16); l += __shfl_xor(l, 32);
        const float inv = 1.f / l;
#pragma unroll
        for (int mt = 0; mt < 4; ++mt)
            *(u32x2*)(mix + qtok * ND + h * 64 + mt * 16 + fq * 4) = (u32x2){pack2(o[mt][0] * inv, o[mt][1] * inv), pack2(o[mt][2] * inv, o[mt][3] * inv)};
    }
}

constexpr int NA_KW = 0, NA_VW = 73728, NA_CK = 0, NA_CV = 32768, NA_RPB = 148480, NA_VWS = 1168, NA_CVS = 528;
template <bool WIN>
__device__ __forceinline__ void na3_group(const unsigned char* lds, const float* rpbL, int g, int kbase, int kdelta, int vbase, int bbase, int mlo,
                                          const bf16x8& q0, const bf16x8& q1, f32x4 (&o)[4], float& mx, float& l) {
    f32x4 s[8];
    const unsigned char* kp = lds + kbase + g * (WIN ? 4 * 64 * 128 : 8 * 16 * 128);
#pragma unroll
    for (int tl = 0; tl < 8; ++tl) {
        const int koff = WIN ? (tl >> 1) * 64 * 128 + (tl & 1) * 16 * 128 : tl * 16 * 128;
        const bf16x8 k0 = *(const bf16x8*)(kp + koff), k1 = *(const bf16x8*)(kp + koff + kdelta);
        f32x4 acc = (f32x4){0.f, 0.f, 0.f, 0.f};
        acc = __builtin_amdgcn_mfma_f32_16x16x32_bf16(k0, q0, acc, 0, 0, 0);
        acc = __builtin_amdgcn_mfma_f32_16x16x32_bf16(k1, q1, acc, 0, 0, 0);
        s[tl] = acc;
    }
    if (WIN) {
        const float* bp = rpbL + bbase + g * 4 * 31;
#pragma unroll
        for (int tl = 0; tl < 8; ++tl)
#pragma unroll
            for (int e = 0; e < 4; ++e) {
                const int rel = (tl & 1) * 16 + e;
                const float bias = bp[(tl >> 1) * 31 + rel];
                s[tl][e] = ((unsigned)(rel - mlo) < 16u) ? s[tl][e] + bias : -1e30f;
            }
    }
    float gm = -1e30f;
#pragma unroll
    for (int tl = 0; tl < 8; ++tl) gm = fmaxf(gm, fmaxf(fmaxf(s[tl][0], s[tl][1]), fmaxf(s[tl][2], s[tl][3])));
    gm = fmaxf(gm, __shfl_xor(gm, 16)); gm = fmaxf(gm, __shfl_xor(gm, 32));
    const float mn = fmaxf(mx, gm), sc = __builtin_amdgcn_exp2f(mx - mn);
    mx = mn;
    float ls = 0.f;
#pragma unroll
    for (int tl = 0; tl < 8; ++tl)
#pragma unroll
        for (int e = 0; e < 4; ++e) { const float pe = __builtin_amdgcn_exp2f(s[tl][e] - mn); s[tl][e] = pe; ls += pe; }
    l = l * sc + ls;
#pragma unroll
    for (int mt = 0; mt < 4; ++mt) o[mt] = o[mt] * sc;
    const unsigned char* vp0 = lds + vbase + g * (WIN ? 4 * 128 : 4 * 64);
#pragma unroll
    for (int pl = 0; pl < 4; ++pl) {
        u32x4 pw; pw[0] = pack2(s[2 * pl][0], s[2 * pl][1]); pw[1] = pack2(s[2 * pl][2], s[2 * pl][3]); pw[2] = pack2(s[2 * pl + 1][0], s[2 * pl + 1][1]); pw[3] = pack2(s[2 * pl + 1][2], s[2 * pl + 1][3]);
        const bf16x8 pf = __builtin_bit_cast(bf16x8, pw);
#pragma unroll
        for (int mt = 0; mt < 4; ++mt) {
            const unsigned char* vp = vp0 + mt * 16 * (WIN ? NA_VWS : NA_CVS) + pl * (WIN ? 128 : 64);
            const u32x2 va = *(const u32x2*)vp, vb = *(const u32x2*)(vp + 32);
            u32x4 vw; vw[0] = va[0]; vw[1] = va[1]; vw[2] = vb[0]; vw[3] = vb[1];
            o[mt] = __builtin_amdgcn_mfma_f32_16x16x32_bf16(__builtin_bit_cast(bf16x8, vw), pf, o[mt], 0, 0, 0);
        }
    }
}
__device__ __forceinline__ void na3_phase(const Params& p, unsigned char* lds, int blk, int nblk) {
    const bf16_t* Q = (const bf16_t*)(p.ws + WS_NAQ); const bf16_t* Kk = (const bf16_t*)(p.ws + WS_NAK); const bf16_t* VT = (const bf16_t*)(p.ws + WS_NAV);
    bf16_t* mix = (bf16_t*)(p.ws + WS_XN);
    float* rpbL = (float*)(lds + NA_RPB);
    const int tid = threadIdx.x, lane = tid & 63, wave = tid >> 6, fr = lane & 15, fq = lane >> 4;
    const int i0 = (int)(((long)blk * 1024) / nblk), i1 = (int)(((long)(blk + 1) * 1024) / nblk);
    if (i0 >= i1) return;
    const int lch = tid & 7, lrc = tid >> 3;
    u32x4 wk[9], wv[9], ck[4], cv[4];
    int cur_h = -1;
#define NA3_WLOAD(it_) do { const int it__ = (it_); const int bh_ = it__ >> 4, rp_ = it__ & 15, b_ = bh_ >> 3, h_ = bh_ & 7; \
        const int rsA_ = min(max(2 * rp_ - 4, 0), NROWS - 8), rsB_ = min(max(2 * rp_ - 3, 0), NROWS - 8), nr_ = rsB_ + 8 - rsA_; \
        _Pragma("unroll") for (int i = 0; i < 9; ++i) if (i < nr_) { \
            wk[i] = *(const u32x4*)(Kk + ((size_t)b_ * NS + (rsA_ + i) * 64 + lrc) * 512 + h_ * 64 + lch * 8); \
            wv[i] = *(const u32x4*)(VT + ((size_t)((b_ * 8 + h_) * 64 + lrc)) * 2048 + (rsA_ + i) * 64 + lch * 8); } } while (0)
    NA3_WLOAD(i0);
    for (int it = i0; it < i1; ++it) {
        const int bh = it >> 4, rp = it & 15, b = bh >> 3, h = bh & 7;
        const int rsA = min(max(2 * rp - 4, 0), NROWS - 8), rsB = min(max(2 * rp - 3, 0), NROWS - 8), nr = rsB + 8 - rsA;
        const int r = 2 * rp + (wave >> 2), cb = wave & 3;
        const int rs = (wave >> 2) ? rsB : rsA, kc0 = min(max(cb * 16 - 8, 0), GW - 32);
        const int qc = cb * 16 + fr, cs = min(max(qc - 8, 0), GW - 16);
        const size_t qtok = (size_t)b * NS + r * 64 + qc;
        __syncthreads();
        if (h != cur_h) { for (int i = tid; i < 465; i += NT) rpbL[i] = p.rpb[h * 465 + i] * 1.44269504f; cur_h = h; }
#pragma unroll
        for (int i = 0; i < 9; ++i) if (i < nr) {
            const int key = i * 64 + lrc;
            *(u32x4*)(lds + NA_KW + key * 128 + ((lch ^ (key & 7)) << 4)) = wk[i];
            *(u32x4*)(lds + NA_VW + lrc * NA_VWS + i * 128 + lch * 16) = wv[i];
        }
#pragma unroll
        for (int i = 0; i < 4; ++i) {
            const int c = tid + i * NT;
            ck[i] = *(const u32x4*)(Kk + ((size_t)MT + b * NL + (c >> 3)) * 512 + h * 64 + (c & 7) * 8);
            cv[i] = *(const u32x4*)(VT + (size_t)MT * 512 + ((size_t)((b * 8 + h) * 64 + (c >> 5))) * 256 + (c & 31) * 8);
        }
        const bf16x8 q0 = *(const bf16x8*)(Q + qtok * 512 + h * 64 + fq * 8), q1 = *(const bf16x8*)(Q + qtok * 512 + h * 64 + 32 + fq * 8);
        __syncthreads();
        f32x4 o[4];
#pragma unroll
        for (int mt = 0; mt < 4; ++mt) o[mt] = (f32x4){0.f, 0.f, 0.f, 0.f};
        float mx = -1e30f, l = 0.f;
        const int sw = fr & 7, lrow0 = rs - rsA, kdl = ((fq ^ sw) & 4) ? -64 : 64;
        const int kbW = NA_KW + ((lrow0 * 64 + kc0 + fr) * 128) + ((fq ^ sw) << 4), vbW = NA_VW + fr * NA_VWS + (lrow0 * 64 + kc0 + fq * 4) * 2;
        const int bbW = (rs - r + 7) * 31 + (kc0 + fq * 4 - qc + 15), mlo = cs - kc0 - fq * 4;
#pragma unroll 1
        for (int g = 0; g < 2; ++g) na3_group<true>(lds, rpbL, g, kbW, kdl, vbW, bbW, mlo, q0, q1, o, mx, l);
        __syncthreads();
#pragma unroll
        for (int i = 0; i < 4; ++i) {
            const int c = tid + i * NT;
            const int key = c >> 3;
            *(u32x4*)(lds + NA_CK + key * 128 + (((c & 7) ^ (key & 7)) << 4)) = ck[i];
            *(u32x4*)(lds + NA_CV + (c >> 5) * NA_CVS + (c & 31) * 16) = cv[i];
        }
        if (it + 1 < i1) NA3_WLOAD(it + 1);
        __syncthreads();
        const int kbC = NA_CK + fr * 128 + ((fq ^ sw) << 4), vbC = NA_CV + fr * NA_CVS + fq * 8;
#pragma unroll 1
        for (int g = 0; g < 2; ++g) na3_group<false>(lds, rpbL, g, kbC, kdl, vbC, 0, 0, q0, q1, o, mx, l);
        l += __shfl_xor(l, 16); l += __shfl_xor(l, 32);
        const float inv = 1.f / l;
#pragma unroll
        for (int mt = 0; mt < 4; ++mt)
            *(u32x2*)(mix + qtok * ND + h * 64 + mt * 16 + fq * 4) = (u32x2){pack2(o[mt][0] * inv, o[mt][1] * inv), pack2(o[mt][2] * inv, o[mt][3] * inv)};
    }
#undef NA3_WLOAD
}

__device__ __forceinline__ void hg_naive_phase(const Params& p) {
    const bf16_t* HQ = (const bf16_t*)(p.ws + WS_HQ); const bf16_t* HI = (const bf16_t*)(p.ws + WS_HI);
    const float* lbp = (const float*)(p.ws + WS_LB);
    const int tid = threadIdx.x, vl = tid >> 4, dsl = tid & 15;
    for (int unit = blockIdx.x; unit < NB * 4 * 2 * 4; unit += gridDim.x) {
        const int vs = unit & 3, dir = (unit >> 2) & 1, h = (unit >> 3) & 3, b = unit >> 5;
        const bf16_t* Z = (const bf16_t*)(p.ws + (dir ? WS_ZB : WS_ZF));
        float* O = p.out + (size_t)dir * MT * 512;
        const int v = vs * 32 + vl, d0 = dsl * 8;
        float lb[8], S[8];
#pragma unroll
        for (int e = 0; e < 8; ++e) { lb[e] = lbp[dir * 512 + h * 128 + d0 + e]; S[e] = 0.f; }
        for (int step = 0; step < NL + NS; ++step) {
            const bool isctx = step < NL;
            int t = isctx ? step : step - NL;
            if (dir) t = (isctx ? NL : NS) - 1 - t;
            const size_t row = isctx ? (size_t)MT + b * NL + t : (size_t)b * NS + t;
            const u32x4 zw = *(const u32x4*)(Z + row * 512 + h * 128 + d0);
            const float vv = bf2f(HI[row * 512 + h * 128 + v]);
            float z[8];
#pragma unroll
            for (int e = 0; e < 4; ++e) { z[e * 2] = bflo(zw[e]); z[e * 2 + 1] = bfhi(zw[e]); }
#pragma unroll
            for (int e = 0; e < 8; ++e) { const float f = lb[e] + (1.f - lb[e]) * sigmoid_f(z[e]); S[e] = f * S[e] + (1.f - f) * vv; }
            if (!isctx) {
                const u32x4 qw = *(const u32x4*)(HQ + row * 512 + h * 128 + d0);
                float acc = 0.f;
#pragma unroll
                for (int e = 0; e < 4; ++e) { acc += bflo(qw[e]) * S[e * 2]; acc += bfhi(qw[e]) * S[e * 2 + 1]; }
                acc += __shfl_xor(acc, 1); acc += __shfl_xor(acc, 2); acc += __shfl_xor(acc, 4); acc += __shfl_xor(acc, 8);
                if (dsl == 0) O[row * 512 + h * 128 + v] = acc;
            }
        }
    }
}

__device__ __forceinline__ int swz8(int row) { return (((row >> 3) & 1) ^ row) & 7; }
__device__ __forceinline__ bf16x8 ld256(const unsigned char* base, int row, int ch) { return *(const bf16x8*)(base + row * 256 + (((ch ^ row) & 15) << 4)); }
__device__ __forceinline__ bf16x8 ld128(const unsigned char* base, int row, int ch) { return *(const bf16x8*)(base + row * 128 + ((ch ^ swz8(row)) << 4)); }
constexpr int HG_LDS = 157696;
__device__ __forceinline__ size_t hg_row(int ci, int t, int b, int dir) {
    const bool isctx = ci < 4; const int lc = isctx ? ci : ci - 4, T = isctx ? NL : NS; const size_t base = isctx ? (size_t)MT + b * NL : (size_t)b * NS;
    const int pos = lc * 64 + t; return dir ? base + T - 1 - pos : base + pos;
}
__device__ __forceinline__ void hg_chain(const Params& p, unsigned char* lds, int unit, int seg) {
    const int tid = threadIdx.x, lane = tid & 63, wave = tid >> 6, fr = lane & 15, fq = lane >> 4;
    const int dir = unit & 1, h = (unit >> 1) & 3, b = unit >> 3;
    float* BF = (float*)lds;
    unsigned char* QT = lds + 32768;
    unsigned char* QH = lds + 49152;
    unsigned char* KT = lds + 65536;
    unsigned char* KBT = lds + 81920;
    unsigned char* VT = lds + 98304;
    unsigned char* PP = lds + 114688;
    unsigned char* SB = lds + 122880;
    float* TOT = (float*)(lds + 155648);
    const bf16_t* HQ = (const bf16_t*)(p.ws + WS_HQ); const bf16_t* HIT = (const bf16_t*)(p.ws + WS_HI);
    const bf16_t* Z = (const bf16_t*)(p.ws + (dir ? WS_ZB : WS_ZF));
    float* O = p.out + (size_t)dir * MT * 512;
    const int bt = tid >> 3, bg = tid & 7;
    const int vdv = tid >> 2, vpart = tid & 3;
    int o256[4], o128[2];
#pragma unroll
    for (int kd = 0; kd < 4; ++kd) o256[kd] = fr * 256 + ((((kd * 4 + fq) ^ fr) & 15) << 4);
#pragma unroll
    for (int ks = 0; ks < 2; ++ks) o128[ks] = fr * 128 + ((((ks * 4 + fq) ^ swz8(fr)) & 7) << 4);
    for (int i = tid; i < (8192 + 32768) / 16; i += NT) *(u32x4*)(PP + i * 16) = (u32x4){0u, 0u, 0u, 0u};
    f32x4 accS[8];
#pragma unroll
    for (int i = 0; i < 8; ++i) accS[i] = (f32x4){0.f, 0.f, 0.f, 0.f};
    u32x4 zr[2], qr[2], vr[2];
#define HG_LOAD(ci_) do { const int ci__ = (ci_); const bool cx = ci__ < 4; const size_t r = hg_row(ci__, bt, b, dir); \
        _Pragma("unroll") for (int g = 0; g < 2; ++g) { const size_t o = r * 512 + h * 128 + g * 64 + bg * 8; zr[g] = *(const u32x4*)(Z + o); qr[g] = cx ? (u32x4){0u, 0u, 0u, 0u} : *(const u32x4*)(HQ + o); } \
        const int lc = cx ? ci__ : ci__ - 4, T = cx ? NL : NS; const int tok0 = dir ? T - 64 * (lc + 1) : lc * 64; \
        const bf16_t* vp = cx ? HIT + (size_t)MT * 512 + ((size_t)((b * 4 + h) * 128 + vdv)) * 256 + tok0 + vpart * 16 : HIT + ((size_t)((b * 4 + h) * 128 + vdv)) * 2048 + tok0 + vpart * 16; \
        vr[0] = *(const u32x4*)vp; vr[1] = *(const u32x4*)(vp + 8); } while (0)
    const int cbeg = seg * 18, cend = cbeg + 18;
    bf16_t* QHC = (bf16_t*)(p.ws + WS_QHC) + (size_t)unit * 18 * 64 * 128;
    float* CUM = (float*)(lds + 157696);
    if (tid < 128) CUM[tid] = 0.f;
    HG_LOAD(cbeg);
    __syncthreads();
#pragma unroll 1
    for (int ci = cbeg; ci < cend; ++ci) {
        const bool isctx = ci < 4;
#pragma unroll
        for (int g = 0; g < 2; ++g) {
            *(f32x4*)(BF + bt * 128 + g * 64 + bg * 8) = (f32x4){bflo(zr[g][0]), bfhi(zr[g][0]), bflo(zr[g][1]), bfhi(zr[g][1])};
            *(f32x4*)(BF + bt * 128 + g * 64 + bg * 8 + 4) = (f32x4){bflo(zr[g][2]), bfhi(zr[g][2]), bflo(zr[g][3]), bfhi(zr[g][3])};
            const int pc = vpart * 2 + g;
            u32x4 w = vr[g];
            if (dir) { w = (u32x4){__builtin_amdgcn_alignbit(vr[g][3], vr[g][3], 16), __builtin_amdgcn_alignbit(vr[g][2], vr[g][2], 16), __builtin_amdgcn_alignbit(vr[g][1], vr[g][1], 16), __builtin_amdgcn_alignbit(vr[g][0], vr[g][0], 16)}; }
            *(u32x4*)(VT + vdv * 128 + ((((dir ? 7 - pc : pc) ^ swz8(vdv)) & 7) << 4)) = w;
        }
        __syncthreads();
        {
            const int d = tid & 127, I = tid >> 7;
            float v[16];
#pragma unroll
            for (int j = 0; j < 16; ++j) v[j] = BF[(I * 16 + j) * 128 + d];
#pragma unroll
            for (int j = 1; j < 16; ++j) v[j] += v[j - 1];
#pragma unroll
            for (int j = 0; j < 16; ++j) BF[(I * 16 + j) * 128 + d] = v[j];
            TOT[I * 128 + d] = v[15];
        }
        __syncthreads();
#pragma unroll
        for (int g = 0; g < 2; ++g) {
            const int d0 = g * 64 + bg * 8;
            float bl[8], t0[8], t1[8], t2[8], b31[8], cm[8];
#pragma unroll
            for (int q4 = 0; q4 < 2; ++q4) {
                const f32x4 a = *(const f32x4*)(BF + bt * 128 + d0 + q4 * 4), x0 = *(const f32x4*)(TOT + d0 + q4 * 4), x1 = *(const f32x4*)(TOT + 128 + d0 + q4 * 4),
                            x2 = *(const f32x4*)(TOT + 256 + d0 + q4 * 4), m = *(const f32x4*)(BF + 31 * 128 + d0 + q4 * 4), m63 = *(const f32x4*)(CUM + d0 + q4 * 4);
#pragma unroll
                for (int e = 0; e < 4; ++e) { bl[q4 * 4 + e] = a[e]; t0[q4 * 4 + e] = x0[e]; t1[q4 * 4 + e] = x1[e]; t2[q4 * 4 + e] = x2[e]; b31[q4 * 4 + e] = m[e]; cm[q4 * 4 + e] = m63[e]; }
            }
            const int I = bt >> 4;
            float vq[8], vh[8], vk[8], vc[8];
#pragma unroll
            for (int e = 0; e < 8; ++e) {
                const float off = (I > 0 ? t0[e] : 0.f) + (I > 1 ? t1[e] : 0.f) + (I > 2 ? t2[e] : 0.f);
                const float bte = bl[e] + off, bmid = b31[e] + t0[e];
                const float x = fminf(fmaxf(bte - bmid, -115.f), 115.f);
                const unsigned zw = zr[g][e >> 1], qw = qr[g][e >> 1];
                const float qv = (e & 1) ? bfhi(qw) : bflo(qw), kf = 1.f - __builtin_amdgcn_exp2f((e & 1) ? bfhi(zw) : bflo(zw));
                vq[e] = qv * __builtin_amdgcn_exp2f(x); vh[e] = qv * __builtin_amdgcn_exp2f(bte); vk[e] = kf * __builtin_amdgcn_exp2f(-x);
                vc[e] = qv * __builtin_amdgcn_exp2f(bte + cm[e]);
            }
            if (seg) *(u32x4*)(QHC + ((size_t)(ci - 18) * 64 + bt) * 128 + d0) = (u32x4){pack2(vc[0], vc[1]), pack2(vc[2], vc[3]), pack2(vc[4], vc[5]), pack2(vc[6], vc[7])};
            const int so = bt * 256 + ((((d0 >> 3) ^ bt) & 15) << 4);
            *(u32x4*)(QT + so) = (u32x4){pack2(vq[0], vq[1]), pack2(vq[2], vq[3]), pack2(vq[4], vq[5]), pack2(vq[6], vq[7])};
            *(u32x4*)(QH + so) = (u32x4){pack2(vh[0], vh[1]), pack2(vh[2], vh[3]), pack2(vh[4], vh[5]), pack2(vh[6], vh[7])};
            *(u32x4*)(KT + so) = (u32x4){pack2(vk[0], vk[1]), pack2(vk[2], vk[3]), pack2(vk[4], vk[5]), pack2(vk[6], vk[7])};
        }
        if (ci + 1 < cend) HG_LOAD(ci + 1);
        __syncthreads();
        if (!isctx) {
            for (int n = wave; n < 10; n += 8) {
                const int I = n >= 6 ? 3 : n >= 3 ? 2 : n >= 1 ? 1 : 0, J = n - (I * (I + 1)) / 2;
                f32x4 acc = (f32x4){0.f, 0.f, 0.f, 0.f};
#pragma unroll
                for (int kd = 0; kd < 4; ++kd) acc = __builtin_amdgcn_mfma_f32_16x16x32_bf16(*(const bf16x8*)(KT + J * 4096 + o256[kd]), *(const bf16x8*)(QT + I * 4096 + o256[kd]), acc, 0, 0, 0);
                if (I == J) {
#pragma unroll
                    for (int e = 0; e < 4; ++e) if (fq * 4 + e > fr) acc[e] = 0.f;
                }
                const int t = I * 16 + fr;
                *(u32x2*)(PP + t * 128 + ((((J * 2 + (fq >> 1)) ^ swz8(t)) & 7) << 4) + (fq & 1) * 8) = (u32x2){pack2(acc[0], acc[1]), pack2(acc[2], acc[3])};
            }
        }
        {
            const int d = tid & 127, sg = tid >> 7;
            const float c2 = __builtin_amdgcn_exp2f(BF[63 * 128 + d] + TOT[128 + d] + TOT[256 + d] - BF[31 * 128 + d]);
            if (sg == 0) CUM[d] += BF[63 * 128 + d] + TOT[d] + TOT[128 + d] + TOT[256 + d];
            const unsigned char* kp = KT + sg * 4096 + (d & 7) * 2; const int dh = d >> 3;
            float kv[16];
#pragma unroll
            for (int j = 0; j < 16; ++j) kv[j] = bf2f(*(const bf16_t*)(kp + j * 256 + (((dh ^ j) & 15) << 4))) * c2;
            const int sw = swz8(d);
            *(u32x4*)(KBT + d * 128 + ((((sg * 2) ^ sw) & 7) << 4)) = (u32x4){pack2(kv[0], kv[1]), pack2(kv[2], kv[3]), pack2(kv[4], kv[5]), pack2(kv[6], kv[7])};
            *(u32x4*)(KBT + d * 128 + ((((sg * 2 + 1) ^ sw) & 7) << 4)) = (u32x4){pack2(kv[8], kv[9]), pack2(kv[10], kv[11]), pack2(kv[12], kv[13]), pack2(kv[14], kv[15])};
        }
        __syncthreads();
        if (!isctx) {
            f32x4 acc[4];
#pragma unroll
            for (int tt = 0; tt < 4; ++tt) acc[tt] = (f32x4){0.f, 0.f, 0.f, 0.f};
#pragma unroll
            for (int kd = 0; kd < 4; ++kd) {
                const bf16x8 a = *(const bf16x8*)(SB + wave * 4096 + o256[kd]);
#pragma unroll
                for (int tt = 0; tt < 4; ++tt) acc[tt] = __builtin_amdgcn_mfma_f32_16x16x32_bf16(a, *(const bf16x8*)(QH + tt * 4096 + o256[kd]), acc[tt], 0, 0, 0);
            }
#pragma unroll
            for (int ks = 0; ks < 2; ++ks) {
                const bf16x8 a = *(const bf16x8*)(VT + wave * 2048 + o128[ks]);
#pragma unroll
                for (int tt = 0; tt < 4; ++tt) acc[tt] = __builtin_amdgcn_mfma_f32_16x16x32_bf16(a, *(const bf16x8*)(PP + tt * 2048 + o128[ks]), acc[tt], 0, 0, 0);
            }
#pragma unroll
            for (int tt = 0; tt < 4; ++tt) *(f32x4*)(O + hg_row(ci, tt * 16 + fr, b, dir) * 512 + h * 128 + wave * 16 + fq * 4) = acc[tt];
        }
        {
            const int d4 = wave * 16 + fq * 4;
            const f32x4 l63 = *(const f32x4*)(BF + 63 * 128 + d4), x0 = *(const f32x4*)(TOT + d4), x1 = *(const f32x4*)(TOT + 128 + d4), x2 = *(const f32x4*)(TOT + 256 + d4);
            f32x4 c3;
#pragma unroll
            for (int e = 0; e < 4; ++e) c3[e] = __builtin_amdgcn_exp2f(l63[e] + x0[e] + x1[e] + x2[e]);
            const bf16x8 a0 = *(const bf16x8*)(KBT + wave * 2048 + o128[0]), a1 = *(const bf16x8*)(KBT + wave * 2048 + o128[1]);
#pragma unroll
            for (int vt = 0; vt < 8; ++vt) {
                accS[vt] = accS[vt] * c3;
                accS[vt] = __builtin_amdgcn_mfma_f32_16x16x32_bf16(a0, *(const bf16x8*)(VT + vt * 2048 + o128[0]), accS[vt], 0, 0, 0);
                accS[vt] = __builtin_amdgcn_mfma_f32_16x16x32_bf16(a1, *(const bf16x8*)(VT + vt * 2048 + o128[1]), accS[vt], 0, 0, 0);
            }
        }
        __syncthreads();
#pragma unroll
        for (int vt = 0; vt < 8; ++vt)
            *(u32x2*)(SB + vt * 4096 + fr * 256 + ((((wave * 2 + (fq >> 1)) ^ fr) & 15) << 4) + (fq & 1) * 8) = (u32x2){pack2(accS[vt][0], accS[vt][1]), pack2(accS[vt][2], accS[vt][3])};
    }
#undef HG_LOAD
    if (!seg) {
        bf16_t* S0 = (bf16_t*)(p.ws + WS_S0T) + (size_t)unit * 128 * 128;
#pragma unroll
        for (int vt = 0; vt < 8; ++vt) *(u32x2*)(S0 + (size_t)(vt * 16 + fr) * 128 + wave * 16 + fq * 4) = (u32x2){pack2(accS[vt][0], accS[vt][1]), pack2(accS[vt][2], accS[vt][3])};
    }
    __syncthreads();
}
__device__ __forceinline__ void hg_corr_phase(const Params& p) {
    const int tid = threadIdx.x, lane = tid & 63, wave = tid >> 6, fr = lane & 15, fq = lane >> 4;
    for (int u = blockIdx.x; u < 64 * 18; u += gridDim.x) {
        const int chain = u / 18, cc = u % 18, dir = chain & 1, h = (chain >> 1) & 3, b = chain >> 3;
        const bf16_t* S0 = (const bf16_t*)(p.ws + WS_S0T) + (size_t)chain * 128 * 128;
        const bf16_t* QH = (const bf16_t*)(p.ws + WS_QHC) + ((size_t)chain * 18 + cc) * 64 * 128;
        float* O = p.out + (size_t)dir * MT * 512;
        f32x4 acc[4];
#pragma unroll
        for (int tt = 0; tt < 4; ++tt) acc[tt] = (f32x4){0.f, 0.f, 0.f, 0.f};
#pragma unroll
        for (int kd = 0; kd < 4; ++kd) {
            const bf16x8 a = *(const bf16x8*)(S0 + (size_t)(wave * 16 + fr) * 128 + kd * 32 + fq * 8);
#pragma unroll
            for (int tt = 0; tt < 4; ++tt) acc[tt] = __builtin_amdgcn_mfma_f32_16x16x32_bf16(a, *(const bf16x8*)(QH + (size_t)(tt * 16 + fr) * 128 + kd * 32 + fq * 8), acc[tt], 0, 0, 0);
        }
#pragma unroll
        for (int tt = 0; tt < 4; ++tt) { float* op = O + hg_row(18 + cc, tt * 16 + fr, b, dir) * 512 + h * 128 + wave * 16 + fq * 4; *(f32x4*)op = *(const f32x4*)op + acc[tt]; }
    }
}
__device__ __forceinline__ void hg_chunk_phase(const Params& p, unsigned char* lds) {
    for (int unit = blockIdx.x; unit < 128; unit += gridDim.x) hg_chain(p, lds, unit >> 1, unit & 1);
}

__device__ __forceinline__ void hgmix_phase(const Params& p) {
    const float* OF = p.out; const float* OB = p.out + (size_t)MT * 512;
    const bf16_t* HG = (const bf16_t*)(p.ws + WS_HG);
    bf16_t* mix = (bf16_t*)(p.ws + WS_XN);
    const int tid = threadIdx.x, lane = tid & 63, wave = tid >> 6;
    for (int row = blockIdx.x * 8 + wave; row < MT; row += gridDim.x * 8) {
        const int c0 = lane * 8;
        float o[8]; float ss = 0.f;
        const f32x4 a0 = *(const f32x4*)(OF + (size_t)row * 512 + c0), a1 = *(const f32x4*)(OF + (size_t)row * 512 + c0 + 4);
        const f32x4 b0 = *(const f32x4*)(OB + (size_t)row * 512 + c0), b1 = *(const f32x4*)(OB + (size_t)row * 512 + c0 + 4);
#pragma unroll
        for (int e = 0; e < 4; ++e) { o[e] = a0[e] + b0[e]; o[4 + e] = a1[e] + b1[e]; }
#pragma unroll
        for (int e = 0; e < 8; ++e) ss += o[e] * o[e];
        ss += __shfl_xor(ss, 1); ss += __shfl_xor(ss, 2); ss += __shfl_xor(ss, 4); ss += __shfl_xor(ss, 8);
        const float rstd = rsqrtf(ss * (1.f / 128.f) + EPS);
        const u32x4 gw = *(const u32x4*)(HG + (size_t)row * 512 + c0);
        float r[8];
#pragma unroll
        for (int e = 0; e < 4; ++e) { r[e * 2] = o[e * 2] * rstd * p.hg_norm[c0 + e * 2] * bflo(gw[e]); r[e * 2 + 1] = o[e * 2 + 1] * rstd * p.hg_norm[c0 + e * 2 + 1] * bfhi(gw[e]); }
        u32x4 w; w[0] = pack2(r[0], r[1]); w[1] = pack2(r[2], r[3]); w[2] = pack2(r[4], r[5]); w[3] = pack2(r[6], r[7]);
        *(u32x4*)(mix + (size_t)row * ND + 512 + c0) = w;
    }
}

__device__ __forceinline__ void wave_argmax(float& v, int& i) {
#pragma unroll
    for (int o = 32; o >= 1; o >>= 1) { const float ov = __shfl_xor(v, o); const int oi = __shfl_xor(i, o); if (ov > v || (ov == v && oi < i)) { v = ov; i = oi; } }
}
__device__ __forceinline__ unsigned ukey(float f) { const unsigned u = __float_as_uint(f); return (u & 0x80000000u) ? ~u : (u | 0x80000000u); }
__device__ __forceinline__ float ukey_inv(unsigned u) { return __uint_as_float((u & 0x80000000u) ? (u & 0x7fffffffu) : ~u); }
__device__ __forceinline__ int mbcnt64(unsigned long long m) { return (int)__builtin_amdgcn_mbcnt_hi((unsigned)(m >> 32), __builtin_amdgcn_mbcnt_lo((unsigned)m, 0u)); }
__device__ __forceinline__ void topk_phase(const Params& p, float* lds) {
    constexpr int LDW = 260;
    float* wsv = lds + 64 * LDW + (threadIdx.x >> 6) * 64;
    int* wsi = (int*)(wsv + 32);
    const bf16_t* PQ = (const bf16_t*)(p.ws + WS_PQ); const bf16_t* KEYS = (const bf16_t*)(p.ws + WS_KEYS);
    int* PIDX = (int*)(p.ws + WS_PIDX); float* PG = (float*)(p.ws + WS_PG);
    const int tid = threadIdx.x, lane = tid & 63, wave = tid >> 6, fr = lane & 15, fq = lane >> 4;
    for (int unit = blockIdx.x; unit < (MT / 64) * 8; unit += gridDim.x) {
        const int hp = unit & 7, t0 = (unit >> 3) * 64;
        {
            const int c = wave >> 2, kb = (wave & 3) * 32;
            f32x4 acc[4][2];
#pragma unroll
            for (int i = 0; i < 4; ++i) { acc[i][0] = (f32x4){0.f, 0.f, 0.f, 0.f}; acc[i][1] = (f32x4){0.f, 0.f, 0.f, 0.f}; }
#pragma unroll
            for (int ks = 0; ks < 4; ++ks) {
                bf16x8 fa[4], fb[2];
#pragma unroll
                for (int i = 0; i < 4; ++i) fa[i] = *(const bf16x8*)(PQ + (size_t)(t0 + i * 16 + fr) * 2048 + hp * 256 + c * 128 + ks * 32 + fq * 8);
#pragma unroll
                for (int j = 0; j < 2; ++j) fb[j] = *(const bf16x8*)(KEYS + (size_t)((hp * 2 + c) * 128 + kb + j * 16 + fr) * 128 + ks * 32 + fq * 8);
#pragma unroll
                for (int i = 0; i < 4; ++i)
#pragma unroll
                    for (int j = 0; j < 2; ++j) acc[i][j] = __builtin_amdgcn_mfma_f32_16x16x32_bf16(fa[i], fb[j], acc[i][j], 0, 0, 0);
            }
#pragma unroll
            for (int i = 0; i < 4; ++i)
#pragma unroll
                for (int j = 0; j < 2; ++j)
#pragma unroll
                    for (int e = 0; e < 4; ++e) lds[(i * 16 + fq * 4 + e) * LDW + c * 128 + kb + j * 16 + fr] = acc[i][j][e];
        }
        __syncthreads();
        for (int tt = 0; tt < 8; ++tt) {
            const int tl = wave * 8 + tt;
            const float* row = lds + tl * LDW;
            float a[2][2]; unsigned k[2][2];
#pragma unroll
            for (int c = 0; c < 2; ++c) {
                a[c][0] = row[c * 128 + lane]; a[c][1] = row[c * 128 + 64 + lane];
                k[c][0] = (ukey(a[c][0]) & ~127u) | (unsigned)(127 - lane);
                k[c][1] = (ukey(a[c][1]) & ~127u) | (unsigned)(63 - lane);
            }
            unsigned lo0 = 0u, hi0 = 0xffffffffu, lo1 = 0u, hi1 = 0xffffffffu, T0 = 0u, T1 = 0u; bool d0 = false, d1 = false;
            for (int it = 0; it < 40; ++it) {
                const unsigned m0 = lo0 + ((hi0 - lo0) >> 1), m1 = lo1 + ((hi1 - lo1) >> 1);
                const int c0 = __popcll(__ballot(k[0][0] >= m0)) + __popcll(__ballot(k[0][1] >= m0));
                const int c1 = __popcll(__ballot(k[1][0] >= m1)) + __popcll(__ballot(k[1][1] >= m1));
                if (!d0) { if (c0 == 16) { d0 = true; T0 = m0; } else if (c0 > 16) lo0 = m0; else hi0 = m0; }
                if (!d1) { if (c1 == 16) { d1 = true; T1 = m1; } else if (c1 > 16) lo1 = m1; else hi1 = m1; }
                if (d0 && d1) break;
            }
            if (!d0) T0 = hi0;
            if (!d1) T1 = hi1;
#pragma unroll
            for (int c = 0; c < 2; ++c) {
                const unsigned T = c ? T1 : T0;
                const bool f0 = k[c][0] >= T, f1 = k[c][1] >= T;
                const unsigned long long b0 = __ballot(f0), b1 = __ballot(f1);
                const int s0 = mbcnt64(b0), s1 = __popcll(b0) + mbcnt64(b1);
                if (f0 && s0 < 16) { wsv[c * 16 + s0] = a[c][0]; wsi[c * 16 + s0] = lane; }
                if (f1 && s1 < 16) { wsv[c * 16 + s1] = a[c][1]; wsi[c * 16 + s1] = lane + 64; }
            }
            const float s1v = wsv[lane >> 2]; const int i1 = wsi[lane >> 2];
            const f32x4 s2v = *(const f32x4*)(wsv + 16 + (lane & 3) * 4);
            float cv[4]; unsigned ck[4];
#pragma unroll
            for (int e = 0; e < 4; ++e) { cv[e] = s1v + s2v[e]; ck[e] = (ukey(cv[e]) & ~255u) | (unsigned)(255 - (lane * 4 + e)); }
            unsigned lo = 0u, hi = 0xffffffffu, T = 0u; bool dn = false;
            for (int it = 0; it < 40; ++it) {
                const unsigned m = lo + ((hi - lo) >> 1);
                int c = 0;
#pragma unroll
                for (int e = 0; e < 4; ++e) c += __popcll(__ballot(ck[e] >= m));
                if (c == 16) { dn = true; T = m; break; } else if (c > 16) lo = m; else hi = m;
            }
            if (!dn) T = hi;
            const float Tf = ukey_inv(T & ~255u);
            float ex[4]; float es = 0.f;
#pragma unroll
            for (int e = 0; e < 4; ++e) { ex[e] = (ck[e] >= T) ? __expf(cv[e] - Tf) : 0.f; es += ex[e]; }
            const float inv = 1.f / wave_sum(es);
            const size_t o = ((size_t)(t0 + tl) * 8 + hp) * 16;
            int base = 0;
#pragma unroll
            for (int e = 0; e < 4; ++e) {
                const bool f = ck[e] >= T;
                const unsigned long long bm = __ballot(f);
                const int slot = base + mbcnt64(bm);
                if (f && slot < 16) { PIDX[o + slot] = i1 * 128 + wsi[16 + (lane & 3) * 4 + e]; PG[o + slot] = ex[e] * inv; }
                base += __popcll(bm);
            }
        }
        __syncthreads();
    }
}

__device__ __forceinline__ void ins16(unsigned (&t)[16], unsigned x) {
#pragma unroll
    for (int k = 0; k < 16; ++k) { const unsigned hi = max(t[k], x); x = min(t[k], x); t[k] = hi; }
}
__device__ __forceinline__ void bsort16(unsigned (&a)[16]) {
#pragma unroll
    for (int k = 2; k <= 16; k <<= 1)
#pragma unroll
        for (int j = k >> 1; j > 0; j >>= 1)
#pragma unroll
            for (int i = 0; i < 16; ++i) {
                const int l = i ^ j;
                if (l > i) { const unsigned hi = max(a[i], a[l]), lo = min(a[i], a[l]); if ((i & k) == 0) { a[i] = hi; a[l] = lo; } else { a[i] = lo; a[l] = hi; } }
            }
}
__device__ __forceinline__ void bmerge16(unsigned (&a)[16], const unsigned (&b)[16]) {
#pragma unroll
    for (int i = 0; i < 16; ++i) a[i] = max(a[i], b[15 - i]);
#pragma unroll
    for (int j = 8; j > 0; j >>= 1)
#pragma unroll
        for (int i = 0; i < 16; ++i) { const int l = i ^ j; if (l > i) { const unsigned hi = max(a[i], a[l]), lo = min(a[i], a[l]); a[i] = hi; a[l] = lo; } }
}
__device__ __forceinline__ void topk3_phase(const Params& p, float* lds) {
    constexpr int LDW = 260;
    const bf16_t* PQ = (const bf16_t*)(p.ws + WS_PQ); const bf16_t* KEYS = (const bf16_t*)(p.ws + WS_KEYS);
    int* PIDX = (int*)(p.ws + WS_PIDX); float* PG = (float*)(p.ws + WS_PG);
    int* tab = (int*)(lds + 128 * LDW);
    const int tid = threadIdx.x, lane = tid & 63, wave = tid >> 6, fr = lane & 15, fq = lane >> 4;
    for (int unit_ = 0; unit_ < ((MT / 64 + (int)gridDim.x - 1) / (int)gridDim.x) * 4; ++unit_) {
        const int hp2 = unit_ & 3, tb = (int)blockIdx.x + (unit_ >> 2) * (int)gridDim.x, t0 = tb * 64;
        if (tb >= MT / 64) break;
        {
            const int hs = wave >> 2, c = (wave >> 1) & 1, kb = (wave & 1) * 64, hp = hp2 * 2 + hs;
            f32x4 acc[4][4];
#pragma unroll
            for (int i = 0; i < 4; ++i)
#pragma unroll
                for (int j = 0; j < 4; ++j) acc[i][j] = (f32x4){0.f, 0.f, 0.f, 0.f};
#pragma unroll
            for (int ks = 0; ks < 4; ++ks) {
                bf16x8 fa[4], fb[4];
#pragma unroll
                for (int i = 0; i < 4; ++i) fa[i] = *(const bf16x8*)(PQ + (size_t)(t0 + i * 16 + fr) * 2048 + hp * 256 + c * 128 + ks * 32 + fq * 8);
#pragma unroll
                for (int j = 0; j < 4; ++j) fb[j] = *(const bf16x8*)(KEYS + (size_t)((hp * 2 + c) * 128 + kb + j * 16 + fr) * 128 + ks * 32 + fq * 8);
#pragma unroll
                for (int i = 0; i < 4; ++i)
#pragma unroll
                    for (int j = 0; j < 4; ++j) acc[i][j] = __builtin_amdgcn_mfma_f32_16x16x32_bf16(fa[i], fb[j], acc[i][j], 0, 0, 0);
            }
#pragma unroll
            for (int i = 0; i < 4; ++i)
#pragma unroll
                for (int j = 0; j < 4; ++j)
#pragma unroll
                    for (int e = 0; e < 4; ++e) lds[(hs * 64 + i * 16 + fq * 4 + e) * LDW + (c * 2 + (wave & 1)) * 65 + j * 16 + fr] = acc[i][j][e];
        }
        __syncthreads();
        {
            const int task = tid >> 2, q = tid & 3;
            const float* row = lds + task * LDW + q * 65;
            unsigned t[16], o[16];
            {
                unsigned t1[16], t2[16], t3[16];
#pragma unroll
                for (int i = 0; i < 16; ++i) {
                    t[i] = (ukey(row[i]) & ~127u) | (unsigned)(127 - ((q & 1) * 64 + i));
                    t1[i] = (ukey(row[16 + i]) & ~127u) | (unsigned)(127 - ((q & 1) * 64 + 16 + i));
                    t2[i] = (ukey(row[32 + i]) & ~127u) | (unsigned)(127 - ((q & 1) * 64 + 32 + i));
                    t3[i] = (ukey(row[48 + i]) & ~127u) | (unsigned)(127 - ((q & 1) * 64 + 48 + i));
                }
                bsort16(t); bsort16(t1); bsort16(t2); bsort16(t3);
                bmerge16(t, t1); bmerge16(t2, t3); bmerge16(t, t2);
            }
#pragma unroll
            for (int k = 0; k < 16; ++k) o[k] = (unsigned)__shfl_xor((int)t[k], 1);
            bmerge16(t, o);
#pragma unroll
            for (int k = 0; k < 16; ++k) o[k] = (unsigned)__shfl_xor((int)t[k], 2);
            float v1[16], v2[16];
#pragma unroll
            for (int k = 0; k < 16; ++k) {
                const unsigned s1 = (q & 2) ? o[k] : t[k], s2 = (q & 2) ? t[k] : o[k];
                v1[k] = ukey_inv(s1 & ~127u); v2[k] = ukey_inv(s2 & ~127u);
                if ((k & 3) == q) { tab[task * 32 + k] = 127 - (int)(s1 & 127u); tab[task * 32 + 16 + k] = 127 - (int)(s2 & 127u); }
            }
#define CKEY(i, j) ((ukey(v1[i] + v2[j]) & ~255u) | (unsigned)(255 - ((i) * 16 + (j))))
            unsigned cd[16], cb[16], cc[16], ce[16];
#pragma unroll
            for (int j = 0; j < 16; ++j) cd[j] = CKEY(0, j);
#pragma unroll
            for (int j = 0; j < 8; ++j) cb[j] = CKEY(1, j);
#pragma unroll
            for (int j = 0; j < 5; ++j) cb[8 + j] = CKEY(2, j);
#pragma unroll
            for (int j = 0; j < 3; ++j) cb[13 + j] = CKEY(4, j);
#pragma unroll
            for (int j = 0; j < 4; ++j) cc[j] = CKEY(3, j);
#pragma unroll
            for (int i = 5; i < 8; ++i) { cc[4 + (i - 5) * 2] = CKEY(i, 0); cc[5 + (i - 5) * 2] = CKEY(i, 1); }
#pragma unroll
            for (int i = 8; i < 14; ++i) cc[10 + (i - 8)] = CKEY(i, 0);
            ce[0] = CKEY(14, 0); ce[1] = CKEY(15, 0);
#pragma unroll
            for (int j = 2; j < 16; ++j) ce[j] = 0u;
#undef CKEY
            bsort16(cb); bsort16(cc);
            { const unsigned hi = max(ce[0], ce[1]), lo = min(ce[0], ce[1]); ce[0] = hi; ce[1] = lo; }
            bmerge16(cd, cb); bmerge16(cc, ce); bmerge16(cd, cc);
            const float vmax = ukey_inv(cd[0] & ~255u);
            float es = 0.f;
#pragma unroll
            for (int k = 0; k < 16; ++k) es += __expf(ukey_inv(cd[k] & ~255u) - vmax);
            const float inv = 1.f / es;
            const size_t ob = ((size_t)(t0 + (task & 63)) * 8 + hp2 * 2 + (task >> 6)) * 16 + q * 4;
#pragma unroll
            for (int e = 0; e < 4; ++e) {
                const unsigned key = q == 0 ? cd[e] : q == 1 ? cd[4 + e] : q == 2 ? cd[8 + e] : cd[12 + e];
                const int pos = 255 - (int)(key & 255u);
                PIDX[ob + e] = tab[task * 32 + (pos >> 4)] * 128 + tab[task * 32 + 16 + (pos & 15)];
                PG[ob + e] = __expf(ukey_inv(key & ~255u) - vmax) * inv;
            }
        }
        __syncthreads();
    }
}

__device__ __forceinline__ void gather_phase(const Params& p, float* lds) {
    const bf16_t* H2 = (const bf16_t*)(p.ws + WS_XN); const bf16_t* U = (const bf16_t*)(p.ws + WS_U); const bf16_t* V = (const bf16_t*)(p.ws + WS_V);
    const int* PIDX = (const int*)(p.ws + WS_PIDX); const float* PG = (const float*)(p.ws + WS_PG);
    const float* mod = (const float*)(p.ws + WS_MOD);
    const int tid = threadIdx.x, lane = tid & 63, wave = tid >> 6;
    float* part = lds;
    float* red = lds + 8 * 1024;
    for (int tok = blockIdx.x; tok < MT; tok += gridDim.x) {
        const int b = tok / NS;
        float hv[16];
        {
            const u32x4 w0 = *(const u32x4*)(H2 + (size_t)tok * ND + lane * 8), w1 = *(const u32x4*)(H2 + (size_t)tok * ND + 512 + lane * 8);
#pragma unroll
            for (int e = 0; e < 4; ++e) { hv[e * 2] = bflo(w0[e]); hv[e * 2 + 1] = bfhi(w0[e]); hv[8 + e * 2] = bflo(w1[e]); hv[8 + e * 2 + 1] = bfhi(w1[e]); }
        }
        float acc[16];
#pragma unroll
        for (int e = 0; e < 16; ++e) acc[e] = 0.f;
        for (int k = 0; k < 16; ++k) {
            const size_t o = ((size_t)tok * 8 + wave) * 16 + k;
            const int idx = PIDX[o]; const float g = PG[o];
            const u32x4 u0 = *(const u32x4*)(U + (size_t)idx * ND + lane * 8), u1 = *(const u32x4*)(U + (size_t)idx * ND + 512 + lane * 8);
            float d = 0.f;
#pragma unroll
            for (int e = 0; e < 4; ++e) { d += hv[e * 2] * bflo(u0[e]) + hv[e * 2 + 1] * bfhi(u0[e]); d += hv[8 + e * 2] * bflo(u1[e]) + hv[8 + e * 2 + 1] * bfhi(u1[e]); }
            d = wave_sum(d);
            const float a = 0.5f * d * (1.f + erff(d * 0.70710678118654752f));
            const float w = g * a;
            const u32x4 v0 = *(const u32x4*)(V + (size_t)idx * ND + lane * 8), v1 = *(const u32x4*)(V + (size_t)idx * ND + 512 + lane * 8);
#pragma unroll
            for (int e = 0; e < 4; ++e) { acc[e * 2] += w * bflo(v0[e]); acc[e * 2 + 1] += w * bfhi(v0[e]); acc[8 + e * 2] += w * bflo(v1[e]); acc[8 + e * 2 + 1] += w * bfhi(v1[e]); }
        }
#pragma unroll
        for (int e = 0; e < 8; ++e) { part[wave * 1024 + lane * 8 + e] = acc[e]; part[wave * 1024 + 512 + lane * 8 + e] = acc[8 + e]; }
        __syncthreads();
        float y[2]; float ss = 0.f;
#pragma unroll
        for (int q = 0; q < 2; ++q) {
            const int d = tid + q * NT;
            float s = 0.f;
#pragma unroll
            for (int w = 0; w < 8; ++w) s += part[w * 1024 + d];
            y[q] = p.out[(size_t)tok * ND + d] + mod[b * 6144 + 5120 + d] * s;
            ss += y[q] * y[q];
        }
        ss = wave_sum(ss);
        if (lane == 0) red[wave] = ss;
        __syncthreads();
        float tot = 0.f;
#pragma unroll
        for (int w = 0; w < 8; ++w) tot += red[w];
        const float rstd = rsqrtf(tot * (1.f / ND) + EPS);
#pragma unroll
        for (int q = 0; q < 2; ++q) { const int d = tid + q * NT; p.out[(size_t)tok * ND + d] = y[q] * rstd * p.norm_f[d]; }
        __syncthreads();
    }
}

typedef float f32x2 __attribute__((ext_vector_type(2)));
__device__ __forceinline__ int rfl(int v) { return __builtin_amdgcn_readfirstlane(v); }
__device__ __forceinline__ void gather2_phase(const Params& p, unsigned char* lds) {
    const unsigned char* UV = p.ws + WS_U; const bf16_t* H2 = (const bf16_t*)(p.ws + WS_XN);
    const int* PIDX = (const int*)(p.ws + WS_PIDX); const float* PG = (const float*)(p.ws + WS_PG);
    const float* mod = (const float*)(p.ws + WS_MOD);
    const int tid = threadIdx.x, lane = tid & 63, wave = tid >> 6;
    unsigned char* wl = lds + wave * 4608;
    int* Lidx = (int*)wl; float* Lw = (float*)(wl + 2048); int* Loff = (int*)(wl + 4096);
    for (int pass = blockIdx.x; pass < MT / 32; pass += gridDim.x) {
        const int tokbase = pass * 32 + wave * 4;
#pragma unroll
        for (int tk = 0; tk < 4; ++tk) {
            const size_t o = (size_t)(tokbase + tk) * 128;
            const int i0 = PIDX[o + lane], i1 = PIDX[o + 64 + lane]; const float w0 = PG[o + lane], w1 = PG[o + 64 + lane];
            const int r0 = i0 >> 10, r1 = i1 >> 10;
            int pos0 = 0, pos1 = 0, myoff = 0, base = 0;
#pragma unroll
            for (int q = 0; q < 16; ++q) {
                const unsigned long long m0 = __ballot(r0 == q), m1 = __ballot(r1 == q); const int c0 = __popcll(m0);
                if (r0 == q) pos0 = base + mbcnt64(m0);
                if (r1 == q) pos1 = base + c0 + mbcnt64(m1);
                if (lane == q) myoff = base;
                base += c0 + __popcll(m1);
            }
            if (lane == 16) myoff = base;
            Lidx[tk * 128 + pos0] = i0; Lw[tk * 128 + pos0] = w0; Lidx[tk * 128 + pos1] = i1; Lw[tk * 128 + pos1] = w1;
            if (lane < 17) Loff[tk * 32 + lane] = myoff;
        }
        f32x2 h[4][8], acc[4][8];
#pragma unroll
        for (int tk = 0; tk < 4; ++tk) {
            const u32x4 a = *(const u32x4*)(H2 + (size_t)(tokbase + tk) * ND + lane * 16), c = *(const u32x4*)(H2 + (size_t)(tokbase + tk) * ND + lane * 16 + 8);
#pragma unroll
            for (int e = 0; e < 4; ++e) { h[tk][e] = (f32x2){bflo(a[e]), bfhi(a[e])}; h[tk][4 + e] = (f32x2){bflo(c[e]), bfhi(c[e])}; acc[tk][e] = (f32x2){0.f, 0.f}; acc[tk][4 + e] = (f32x2){0.f, 0.f}; }
        }
#pragma unroll 1
        for (int r = 0; r < 16; ++r) {
#pragma unroll
            for (int tk = 0; tk < 4; ++tk) {
                const int beg = rfl(Loff[tk * 32 + r]), end = rfl(Loff[tk * 32 + r + 1]);
                for (int j0 = beg; j0 < end; j0 += 8) {
                    const int n = min(8, end - j0);
                    u32x4 rr[8]; const unsigned char* rowp[8];
#pragma unroll
                    for (int j = 0; j < 8; ++j) if (j < n) { rowp[j] = UV + (size_t)rfl(Lidx[tk * 128 + j0 + j]) * 2048 + lane * 16; rr[j] = *(const u32x4*)rowp[j]; }
                    float d[8];
#pragma unroll
                    for (int j = 0; j < 8; ++j) {
                        d[j] = 0.f;
                        if (j < n) {
                            f32x2 s = (f32x2){0.f, 0.f};
#pragma unroll
                            for (int k = 0; k < 4; ++k) {
                                s = __builtin_elementwise_fma(__builtin_amdgcn_cvt_pk_f32_fp8(rr[j][k], false), h[tk][2 * k], s);
                                s = __builtin_elementwise_fma(__builtin_amdgcn_cvt_pk_f32_fp8(rr[j][k], true), h[tk][2 * k + 1], s);
                            }
                            d[j] = s.x + s.y;
                            rr[j] = *(const u32x4*)(rowp[j] + 1024);
                        }
                    }
                    float r4[4], r2[2], r1;
#pragma unroll
                    for (int j = 0; j < 4; ++j) { const float keep = (lane & 32) ? d[j + 4] : d[j], send = (lane & 32) ? d[j] : d[j + 4]; r4[j] = keep + __shfl_xor(send, 32); }
#pragma unroll
                    for (int j = 0; j < 2; ++j) { const float keep = (lane & 16) ? r4[j + 2] : r4[j], send = (lane & 16) ? r4[j] : r4[j + 2]; r2[j] = keep + __shfl_xor(send, 16); }
                    { const float keep = (lane & 8) ? r2[1] : r2[0], send = (lane & 8) ? r2[0] : r2[1]; r1 = keep + __shfl_xor(send, 8); }
                    r1 += __shfl_xor(r1, 4); r1 += __shfl_xor(r1, 2); r1 += __shfl_xor(r1, 1);
                    float wq = 0.f;
                    if ((lane >> 3) < n) { const float x = r1 * (1.f / 64.f); wq = Lw[tk * 128 + j0 + (lane >> 3)] * (0.5f * x * (1.f + erff(x * 0.70710678118654752f))) * 0.125f; }
#pragma unroll
                    for (int j = 0; j < 8; ++j) if (j < n) {
                        const float wj = __int_as_float(__builtin_amdgcn_readlane(__float_as_int(wq), j * 8));
                        const f32x2 w2 = (f32x2){wj, wj};
#pragma unroll
                        for (int k = 0; k < 4; ++k) {
                            acc[tk][2 * k] = __builtin_elementwise_fma(__builtin_amdgcn_cvt_pk_f32_fp8(rr[j][k], false), w2, acc[tk][2 * k]);
                            acc[tk][2 * k + 1] = __builtin_elementwise_fma(__builtin_amdgcn_cvt_pk_f32_fp8(rr[j][k], true), w2, acc[tk][2 * k + 1]);
                        }
                    }
                }
            }
        }
#pragma unroll
        for (int tk = 0; tk < 4; ++tk) {
            const int tok = tokbase + tk, b = tok / NS;
            float* xo = p.out + (size_t)tok * ND + lane * 16; const float* g2 = mod + b * 6144 + 5120 + lane * 16; const float* nf = p.norm_f + lane * 16;
            f32x4 y[4]; float ss = 0.f;
#pragma unroll
            for (int q = 0; q < 4; ++q) {
                const f32x4 xv = *(const f32x4*)(xo + q * 4), gv = *(const f32x4*)(g2 + q * 4);
                y[q] = xv + gv * (f32x4){acc[tk][2 * q].x, acc[tk][2 * q].y, acc[tk][2 * q + 1].x, acc[tk][2 * q + 1].y};
                ss += y[q][0] * y[q][0] + y[q][1] * y[q][1] + y[q][2] * y[q][2] + y[q][3] * y[q][3];
            }
            ss = wave_sum(ss);
            const float rstd = rsqrtf(ss * (1.f / ND) + EPS);
#pragma unroll
            for (int q = 0; q < 4; ++q) *(f32x4*)(xo + q * 4) = y[q] * rstd * *(const f32x4*)(nf + q * 4);
        }
    }
}

__device__ __forceinline__ void gather3_phase(const Params& p, unsigned char* lds) {
    const unsigned char* UV = p.ws + WS_U; const bf16_t* H2 = (const bf16_t*)(p.ws + WS_XN);
    const int* PIDX = (const int*)(p.ws + WS_PIDX); const float* PG = (const float*)(p.ws + WS_PG);
    const float* mod = (const float*)(p.ws + WS_MOD);
    const int tid = threadIdx.x, lane = tid & 63, wave = tid >> 6;
    unsigned char* wl = lds + wave * 12800;
    int* Lidx = (int*)wl; float* Lw = (float*)(wl + 2048); int* cnt = (int*)(wl + 4096); int* bs = (int*)(wl + 4352); unsigned char* hl = wl + 4608;
    for (int pass = blockIdx.x; pass < MT / 32; pass += gridDim.x) {
        const int tokbase = pass * 32 + wave * 4;
        cnt[lane] = 0;
        int ei[8]; float ew[8]; int pib[8];
#pragma unroll
        for (int tk = 0; tk < 4; ++tk) {
            const size_t o = (size_t)(tokbase + tk) * 128;
            ei[tk * 2] = PIDX[o + lane]; ei[tk * 2 + 1] = PIDX[o + 64 + lane]; ew[tk * 2] = PG[o + lane]; ew[tk * 2 + 1] = PG[o + 64 + lane];
        }
#pragma unroll
        for (int s = 0; s < 8; ++s) pib[s] = atomicAdd(&cnt[ei[s] >> 8], 1);
        {
            const int c = cnt[lane]; int x = c;
#pragma unroll
            for (int off = 1; off < 64; off <<= 1) { const int y = __shfl_up(x, off); if (lane >= off) x += y; }
            bs[lane] = x - c;
        }
#pragma unroll
        for (int s = 0; s < 8; ++s) { const int pos = bs[ei[s] >> 8] + pib[s]; Lidx[pos] = ei[s] | ((s >> 1) << 16); Lw[pos] = ew[s]; }
        f32x2 acc[4][8];
#pragma unroll
        for (int tk = 0; tk < 4; ++tk) {
            *(u32x4*)(hl + tk * 2048 + lane * 32) = *(const u32x4*)(H2 + (size_t)(tokbase + tk) * ND + lane * 16);
            *(u32x4*)(hl + tk * 2048 + lane * 32 + 16) = *(const u32x4*)(H2 + (size_t)(tokbase + tk) * ND + lane * 16 + 8);
#pragma unroll
            for (int e = 0; e < 8; ++e) acc[tk][e] = (f32x2){0.f, 0.f};
        }
#define G3_ACC(T) { asm volatile("; acc slot"); _Pragma("unroll") for (int k = 0; k < 4; ++k) { \
            acc[T][2 * k] = __builtin_elementwise_fma(__builtin_amdgcn_cvt_pk_f32_fp8(rv[j][k], false), w2, acc[T][2 * k]); \
            acc[T][2 * k + 1] = __builtin_elementwise_fma(__builtin_amdgcn_cvt_pk_f32_fp8(rv[j][k], true), w2, acc[T][2 * k + 1]); } }
#pragma unroll 1
        for (int j0 = 0; j0 < 512; j0 += 8) {
            u32x4 rr[8], rv[8]; int tkj[8];
#pragma unroll
            for (int j = 0; j < 8; ++j) { const int e = rfl(Lidx[j0 + j]); tkj[j] = e >> 16; const unsigned char* rowp = UV + (size_t)(e & 0xffff) * 2048 + lane * 16; rr[j] = *(const u32x4*)rowp; rv[j] = *(const u32x4*)(rowp + 1024); }
            float d[8];
#pragma unroll
            for (int j = 0; j < 8; ++j) {
                f32x2 s = (f32x2){0.f, 0.f};
                {
                    const unsigned char* hp = hl + tkj[j] * 2048 + lane * 32;
                    const u32x4 ha = *(const u32x4*)hp, hb = *(const u32x4*)(hp + 16);
#pragma unroll
                    for (int k = 0; k < 4; ++k) {
                        const unsigned h0 = k < 2 ? ha[2 * k] : hb[2 * k - 4], h1 = k < 2 ? ha[2 * k + 1] : hb[2 * k - 3];
                        s = __builtin_elementwise_fma(__builtin_amdgcn_cvt_pk_f32_fp8(rr[j][k], false), (f32x2){bflo(h0), bfhi(h0)}, s);
                        s = __builtin_elementwise_fma(__builtin_amdgcn_cvt_pk_f32_fp8(rr[j][k], true), (f32x2){bflo(h1), bfhi(h1)}, s);
                    }
                }
                d[j] = s.x + s.y;
            }
            float r4[4], r2[2], r1;
#pragma unroll
            for (int j = 0; j < 4; ++j) { const float keep = (lane & 32) ? d[j + 4] : d[j], send = (lane & 32) ? d[j] : d[j + 4]; r4[j] = keep + __shfl_xor(send, 32); }
#pragma unroll
            for (int j = 0; j < 2; ++j) { const float keep = (lane & 16) ? r4[j + 2] : r4[j], send = (lane & 16) ? r4[j] : r4[j + 2]; r2[j] = keep + __shfl_xor(send, 16); }
            { const float keep = (lane & 8) ? r2[1] : r2[0], send = (lane & 8) ? r2[0] : r2[1]; r1 = keep + __shfl_xor(send, 8); }
            r1 += __shfl_xor(r1, 4); r1 += __shfl_xor(r1, 2); r1 += __shfl_xor(r1, 1);
            const float x = r1 * (1.f / 64.f);
            const float wq = Lw[j0 + (lane >> 3)] * (0.5f * x * (1.f + erff(x * 0.70710678118654752f))) * 0.125f;
#pragma unroll
            for (int j = 0; j < 8; ++j) {
                const float wj = __int_as_float(__builtin_amdgcn_readlane(__float_as_int(wq), j * 8));
                const f32x2 w2 = (f32x2){wj, wj};
                if (tkj[j] == 0) G3_ACC(0) else if (tkj[j] == 1) G3_ACC(1) else if (tkj[j] == 2) G3_ACC(2) else G3_ACC(3)
            }
        }
#undef G3_ACC
#pragma unroll
        for (int tk = 0; tk < 4; ++tk) {
            const int tok = tokbase + tk, b = tok / NS;
            float* xo = p.out + (size_t)tok * ND + lane * 16; const float* g2 = mod + b * 6144 + 5120 + lane * 16; const float* nf = p.norm_f + lane * 16;
            f32x4 y[4]; float ss = 0.f;
#pragma unroll
            for (int q = 0; q < 4; ++q) {
                const f32x4 xv = *(const f32x4*)(xo + q * 4), gv = *(const f32x4*)(g2 + q * 4);
                y[q] = xv + gv * (f32x4){acc[tk][2 * q].x, acc[tk][2 * q].y, acc[tk][2 * q + 1].x, acc[tk][2 * q + 1].y};
                ss += y[q][0] * y[q][0] + y[q][1] * y[q][1] + y[q][2] * y[q][2] + y[q][3] * y[q][3];
            }
            ss = wave_sum(ss);
            const float rstd = rsqrtf(ss * (1.f / ND) + EPS);
#pragma unroll
            for (int q = 0; q < 4; ++q) *(f32x4*)(xo + q * 4) = y[q] * rstd * *(const f32x4*)(nf + q * 4);
        }
    }
}

#define G4_LOAD(RU, RV, J0) { _Pragma("unroll") for (int j = 0; j < 4; ++j) { const int e = rfl(Lidx[(J0) + j]); \
        const unsigned char* rowp = UV + (size_t)(e & 0xffff) * 2048 + lane * 16; RU[j] = *(const u32x4*)rowp; RV[j] = *(const u32x4*)(rowp + 1024); } }
#define G4_DOT(T) { asm volatile("; dot slot %0" :: "i"(T)); _Pragma("unroll") for (int k = 0; k < 4; ++k) { \
        s = __builtin_elementwise_fma(__builtin_amdgcn_cvt_pk_f32_fp8(RU_[j][k], false), h[T][2 * k], s); \
        s = __builtin_elementwise_fma(__builtin_amdgcn_cvt_pk_f32_fp8(RU_[j][k], true), h[T][2 * k + 1], s); } }
#define G4_ACC(T) { asm volatile("; acc slot %0" :: "i"(T)); _Pragma("unroll") for (int k = 0; k < 4; ++k) { \
        acc[T][2 * k] = __builtin_elementwise_fma(__builtin_amdgcn_cvt_pk_f32_fp8(RV_[j][k], false), w2, acc[T][2 * k]); \
        acc[T][2 * k + 1] = __builtin_elementwise_fma(__builtin_amdgcn_cvt_pk_f32_fp8(RV_[j][k], true), w2, acc[T][2 * k + 1]); } }
__device__ __forceinline__ void gather4_batch(const u32x4 (&RU_)[4], const u32x4 (&RV_)[4], const int* Lidx, const float* Lw, int j0, int lane, const f32x2 (&h)[2][8], f32x2 (&acc)[2][8]) {
    int tkj[4];
#pragma unroll
    for (int j = 0; j < 4; ++j) tkj[j] = rfl(Lidx[j0 + j]) >> 16;
    float d[4];
#pragma unroll
    for (int j = 0; j < 4; ++j) {
        f32x2 s = (f32x2){0.f, 0.f};
        if (tkj[j] == 0) G4_DOT(0) else G4_DOT(1)
        d[j] = s.x + s.y;
    }
    float r2[2], r1;
#pragma unroll
    for (int j = 0; j < 2; ++j) { const float keep = (lane & 32) ? d[j + 2] : d[j], send = (lane & 32) ? d[j] : d[j + 2]; r2[j] = keep + __shfl_xor(send, 32); }
    { const float keep = (lane & 16) ? r2[1] : r2[0], send = (lane & 16) ? r2[0] : r2[1]; r1 = keep + __shfl_xor(send, 16); }
    r1 += __shfl_xor(r1, 8); r1 += __shfl_xor(r1, 4); r1 += __shfl_xor(r1, 2); r1 += __shfl_xor(r1, 1);
    const float x = r1 * (1.f / 64.f);
    const float wq = Lw[j0 + (lane >> 4)] * (0.5f * x * (1.f + erff(x * 0.70710678118654752f))) * 0.125f;
#pragma unroll
    for (int j = 0; j < 4; ++j) {
        const float wj = __int_as_float(__builtin_amdgcn_readlane(__float_as_int(wq), j * 16));
        const f32x2 w2 = (f32x2){wj, wj};
        if (tkj[j] == 0) G4_ACC(0) else G4_ACC(1)
    }
}
__device__ __forceinline__ void gather4_phase(const Params& p, unsigned char* lds) {
    const unsigned char* UV = p.ws + WS_U; const bf16_t* H2 = (const bf16_t*)(p.ws + WS_XN);
    const int* PIDX = (const int*)(p.ws + WS_PIDX); const float* PG = (const float*)(p.ws + WS_PG);
    const float* mod = (const float*)(p.ws + WS_MOD);
    const int tid = threadIdx.x, lane = tid & 63, wave = tid >> 6;
    unsigned char* wl = lds + wave * 2560;
    int* Lidx = (int*)wl; float* Lw = (float*)(wl + 1024); int* cnt = (int*)(wl + 2048); int* bs = (int*)(wl + 2304);
    for (int pass = blockIdx.x; pass < MT / 16; pass += gridDim.x) {
        const int tokbase = pass * 16 + wave * 2;
        cnt[lane] = 0;
        int ei[4]; float ew[4]; int pib[4];
#pragma unroll
        for (int tk = 0; tk < 2; ++tk) {
            const size_t o = (size_t)(tokbase + tk) * 128;
            ei[tk * 2] = PIDX[o + lane]; ei[tk * 2 + 1] = PIDX[o + 64 + lane]; ew[tk * 2] = PG[o + lane]; ew[tk * 2 + 1] = PG[o + 64 + lane];
        }
#pragma unroll
        for (int s = 0; s < 4; ++s) pib[s] = atomicAdd(&cnt[ei[s] >> 8], 1);
        {
            const int c = cnt[lane]; int x = c;
#pragma unroll
            for (int off = 1; off < 64; off <<= 1) { const int y = __shfl_up(x, off); if (lane >= off) x += y; }
            bs[lane] = x - c;
        }
#pragma unroll
        for (int s = 0; s < 4; ++s) { const int pos = bs[ei[s] >> 8] + pib[s]; Lidx[pos] = ei[s] | ((s >> 1) << 16); Lw[pos] = ew[s]; }
        f32x2 h[2][8], acc[2][8];
#pragma unroll
        for (int tk = 0; tk < 2; ++tk) {
            const u32x4 a = *(const u32x4*)(H2 + (size_t)(tokbase + tk) * ND + lane * 16), c = *(const u32x4*)(H2 + (size_t)(tokbase + tk) * ND + lane * 16 + 8);
#pragma unroll
            for (int e = 0; e < 4; ++e) { h[tk][e] = (f32x2){bflo(a[e]), bfhi(a[e])}; h[tk][4 + e] = (f32x2){bflo(c[e]), bfhi(c[e])}; acc[tk][e] = (f32x2){0.f, 0.f}; acc[tk][4 + e] = (f32x2){0.f, 0.f}; }
        }
        u32x4 ua[4], va[4], ub[4], vb[4];
        G4_LOAD(ua, va, 0)
#pragma unroll 1
        for (int j0 = 0; j0 < 256; j0 += 8) {
            G4_LOAD(ub, vb, j0 + 4)
            gather4_batch(ua, va, Lidx, Lw, j0, lane, h, acc);
            if (j0 + 8 < 256) G4_LOAD(ua, va, j0 + 8)
            gather4_batch(ub, vb, Lidx, Lw, j0 + 4, lane, h, acc);
        }
#pragma unroll
        for (int tk = 0; tk < 2; ++tk) {
            const int tok = tokbase + tk, b = tok / NS;
            float* xo = p.out + (size_t)tok * ND + lane * 16; const float* g2 = mod + b * 6144 + 5120 + lane * 16; const float* nf = p.norm_f + lane * 16;
            f32x4 y[4]; float ss = 0.f;
#pragma unroll
            for (int q = 0; q < 4; ++q) {
                const f32x4 xv = *(const f32x4*)(xo + q * 4), gv = *(const f32x4*)(g2 + q * 4);
                y[q] = xv + gv * (f32x4){acc[tk][2 * q].x, acc[tk][2 * q].y, acc[tk][2 * q + 1].x, acc[tk][2 * q + 1].y};
                ss += y[q][0] * y[q][0] + y[q][1] * y[q][1] + y[q][2] * y[q][2] + y[q][3] * y[q][3];
            }
            ss = wave_sum(ss);
            const float rstd = rsqrtf(ss * (1.f / ND) + EPS);
#pragma unroll
            for (int q = 0; q < 4; ++q) *(f32x4*)(xo + q * 4) = y[q] * rstd * *(const f32x4*)(nf + q * 4);
        }
    }
}
#undef G4_LOAD
#undef G4_DOT
#undef G4_ACC

__device__ __forceinline__ void gather5_phase(const Params& p, unsigned char* lds, float* outp) {
    const unsigned char* UV = p.ws + WS_U; const bf16_t* H2 = (const bf16_t*)(p.ws + WS_XN);
    const int* PIDX = (const int*)(p.ws + WS_PIDX); const float* PG = (const float*)(p.ws + WS_PG);
    const float* mod = (const float*)(p.ws + WS_MOD);
    const int tid = threadIdx.x, lane = tid & 63, wave = tid >> 6, half = lane >> 5, hl = lane & 31;
    unsigned char* wl = lds + wave * 2560 + half * 1280;
    int* Lidx = (int*)wl; float* Lw = (float*)(wl + 512); int* cnt = (int*)(wl + 1024);
    for (int pass = blockIdx.x; pass < MT / 16; pass += gridDim.x) {
        const int tok = pass * 16 + wave * 2 + half;
        cnt[hl] = 0; cnt[32 + hl] = 0;
        int ei[4]; float ew[4]; int pib[4];
#pragma unroll
        for (int s = 0; s < 4; ++s) { ei[s] = PIDX[(size_t)tok * 128 + s * 32 + hl]; ew[s] = PG[(size_t)tok * 128 + s * 32 + hl]; }
#pragma unroll
        for (int s = 0; s < 4; ++s) pib[s] = atomicAdd(&cnt[ei[s] >> 8], 1);
        {
            const int c0 = cnt[2 * hl], c1 = cnt[2 * hl + 1]; int x = c0 + c1;
#pragma unroll
            for (int off = 1; off < 32; off <<= 1) { const int y = __shfl_up(x, off, 32); if (hl >= off) x += y; }
            const int ex = x - c0 - c1;
            cnt[2 * hl] = ex; cnt[2 * hl + 1] = ex + c0;
        }
#pragma unroll
        for (int s = 0; s < 4; ++s) { const int pos = cnt[ei[s] >> 8] + pib[s]; Lidx[pos] = ei[s]; Lw[pos] = ew[s]; }
        f32x2 h[16], acc[16];
        {
            const bf16_t* hp = H2 + (size_t)tok * ND + hl * 32;
#pragma unroll
            for (int q = 0; q < 4; ++q) { const u32x4 a = *(const u32x4*)(hp + q * 8);
#pragma unroll
                for (int e = 0; e < 4; ++e) { h[q * 4 + e] = (f32x2){bflo(a[e]), bfhi(a[e])}; acc[q * 4 + e] = (f32x2){0.f, 0.f}; } }
        }
        u32x4 ru[4][2], rv[4][2];
#define G5_ROW(j0_, j_) (UV + (size_t)Lidx[(j0_) + (j_)] * 2048 + hl * 32)
#pragma unroll
        for (int j = 0; j < 4; ++j) { const unsigned char* rp = G5_ROW(0, j); ru[j][0] = *(const u32x4*)rp; ru[j][1] = *(const u32x4*)(rp + 16); rv[j][0] = *(const u32x4*)(rp + 1024); rv[j][1] = *(const u32x4*)(rp + 1040); }
#pragma unroll 1
        for (int j0 = 0; j0 < 128; j0 += 4) {
            const int jn = (j0 + 4 < 128) ? j0 + 4 : j0;
            float d[4];
#pragma unroll
            for (int j = 0; j < 4; ++j) {
                f32x2 s = (f32x2){0.f, 0.f};
#pragma unroll
                for (int w = 0; w < 2; ++w)
#pragma unroll
                    for (int k = 0; k < 4; ++k) {
                        s = __builtin_elementwise_fma(__builtin_amdgcn_cvt_pk_f32_fp8(ru[j][w][k], false), h[w * 8 + 2 * k], s);
                        s = __builtin_elementwise_fma(__builtin_amdgcn_cvt_pk_f32_fp8(ru[j][w][k], true), h[w * 8 + 2 * k + 1], s);
                    }
                d[j] = s.x + s.y;
                const unsigned char* rp = G5_ROW(jn, j); ru[j][0] = *(const u32x4*)rp; ru[j][1] = *(const u32x4*)(rp + 16);
            }
            float r2[2], r1;
#pragma unroll
            for (int j = 0; j < 2; ++j) { const float keep = (hl & 16) ? d[j + 2] : d[j], send = (hl & 16) ? d[j] : d[j + 2]; r2[j] = keep + __shfl_xor(send, 16); }
            { const float keep = (hl & 8) ? r2[1] : r2[0], send = (hl & 8) ? r2[0] : r2[1]; r1 = keep + __shfl_xor(send, 8); }
            r1 += __shfl_xor(r1, 4); r1 += __shfl_xor(r1, 2); r1 += __shfl_xor(r1, 1);
            const float x = r1 * (1.f / 64.f);
            const float wq = Lw[j0 + (hl >> 3)] * (0.5f * x * (1.f + erff(x * 0.70710678118654752f))) * 0.125f;
#pragma unroll
            for (int j = 0; j < 4; ++j) {
                const float wj = __shfl(wq, (lane & 32) | (j * 8));
                const f32x2 w2 = (f32x2){wj, wj};
#pragma unroll
                for (int w = 0; w < 2; ++w)
#pragma unroll
                    for (int k = 0; k < 4; ++k) {
                        acc[w * 8 + 2 * k] = __builtin_elementwise_fma(__builtin_amdgcn_cvt_pk_f32_fp8(rv[j][w][k], false), w2, acc[w * 8 + 2 * k]);
                        acc[w * 8 + 2 * k + 1] = __builtin_elementwise_fma(__builtin_amdgcn_cvt_pk_f32_fp8(rv[j][w][k], true), w2, acc[w * 8 + 2 * k + 1]);
                    }
                const unsigned char* rp = G5_ROW(jn, j); rv[j][0] = *(const u32x4*)(rp + 1024); rv[j][1] = *(const u32x4*)(rp + 1040);
            }
        }
#undef G5_ROW
        {
            const int b = tok / NS;
            const float* xo = p.out + (size_t)tok * ND + hl * 32; float* yo = outp + (size_t)tok * ND + hl * 32; const float* g2 = mod + b * 6144 + 5120 + hl * 32; const float* nf = p.norm_f + hl * 32;
            f32x4 y[8]; float ss = 0.f;
#pragma unroll
            for (int q = 0; q < 8; ++q) {
                const f32x4 xv = *(const f32x4*)(xo + q * 4), gv = *(const f32x4*)(g2 + q * 4);
                y[q] = xv + gv * (f32x4){acc[2 * q].x, acc[2 * q].y, acc[2 * q + 1].x, acc[2 * q + 1].y};
                ss += y[q][0] * y[q][0] + y[q][1] * y[q][1] + y[q][2] * y[q][2] + y[q][3] * y[q][3];
            }
            ss += __shfl_xor(ss, 16); ss += __shfl_xor(ss, 8); ss += __shfl_xor(ss, 4); ss += __shfl_xor(ss, 2); ss += __shfl_xor(ss, 1);
            const float rstd = rsqrtf(ss * (1.f / ND) + EPS);
#pragma unroll
            for (int q = 0; q < 8; ++q) *(f32x4*)(yo + q * 4) = y[q] * rstd * *(const f32x4*)(nf + q * 4);
        }
    }
}

typedef float f32x32 __attribute__((ext_vector_type(32)));
typedef unsigned u32x6 __attribute__((ext_vector_type(6)));
typedef unsigned u32x3 __attribute__((ext_vector_type(3)));
__device__ __forceinline__ u32x6 ld24(const unsigned char* p) { const u32x3 a = *(const u32x3*)p, b = *(const u32x3*)(p + 12); return (u32x6){a[0], a[1], a[2], b[0], b[1], b[2]}; }
__device__ __forceinline__ void gather6_phase(const Params& p, unsigned char* lds, float* outp) {
    const unsigned char* UV = p.ws + WS_U; const bf16_t* H2 = (const bf16_t*)(p.ws + WS_XN);
    const int* PIDX = (const int*)(p.ws + WS_PIDX); const float* PG = (const float*)(p.ws + WS_PG);
    const float* mod = (const float*)(p.ws + WS_MOD);
    const int tid = threadIdx.x, lane = tid & 63, wave = tid >> 6, half = lane >> 5, hl = lane & 31;
    unsigned char* wl = lds + wave * 2560 + half * 1280;
    int* Lidx = (int*)wl; float* Lw = (float*)(wl + 512); int* cnt = (int*)(wl + 1024);
    for (int pass = blockIdx.x; pass < MT / 16; pass += gridDim.x) {
        const int tok = pass * 16 + wave * 2 + half;
        cnt[hl] = 0; cnt[32 + hl] = 0;
        int ei[4]; float ew[4]; int pib[4];
#pragma unroll
        for (int s = 0; s < 4; ++s) { ei[s] = PIDX[(size_t)tok * 128 + s * 32 + hl]; ew[s] = PG[(size_t)tok * 128 + s * 32 + hl]; }
#pragma unroll
        for (int s = 0; s < 4; ++s) pib[s] = atomicAdd(&cnt[ei[s] >> 8], 1);
        {
            const int c0 = cnt[2 * hl], c1 = cnt[2 * hl + 1]; int x = c0 + c1;
#pragma unroll
            for (int off = 1; off < 32; off <<= 1) { const int y = __shfl_up(x, off, 32); if (hl >= off) x += y; }
            const int ex = x - c0 - c1;
            cnt[2 * hl] = ex; cnt[2 * hl + 1] = ex + c0;
        }
#pragma unroll
        for (int s = 0; s < 4; ++s) { const int pos = cnt[ei[s] >> 8] + pib[s]; Lidx[pos] = ei[s]; Lw[pos] = ew[s]; }
        f32x2 h[16], acc[16];
        {
            const bf16_t* hp = H2 + (size_t)tok * ND + hl * 32;
#pragma unroll
            for (int q = 0; q < 4; ++q) { const u32x4 a = *(const u32x4*)(hp + q * 8);
#pragma unroll
                for (int e = 0; e < 4; ++e) { h[q * 4 + e] = (f32x2){bflo(a[e]), bfhi(a[e])}; acc[q * 4 + e] = (f32x2){0.f, 0.f}; } }
        }
        u32x6 ru[4], rv[4];
#define G6_ROW(j0_, j_) (UV + (size_t)Lidx[(j0_) + (j_)] * 1536 + hl * 24)
#pragma unroll
        for (int j = 0; j < 4; ++j) { const unsigned char* rp = G6_ROW(0, j); ru[j] = ld24(rp); rv[j] = ld24(rp + 768); }
#pragma unroll 1
        for (int j0 = 0; j0 < 128; j0 += 4) {
            const int jn = (j0 + 4 < 128) ? j0 + 4 : j0;
            float d[4];
#pragma unroll
            for (int j = 0; j < 4; ++j) {
                const f32x32 x = __builtin_amdgcn_cvt_scalef32_pk32_f32_fp6(ru[j], 1.0f);
                f32x2 s = (f32x2){0.f, 0.f};
#pragma unroll
                for (int k = 0; k < 16; ++k) s = __builtin_elementwise_fma((f32x2){x[2 * k], x[2 * k + 1]}, h[k], s);
                d[j] = s.x + s.y;
                ru[j] = ld24(G6_ROW(jn, j));
                __builtin_amdgcn_sched_barrier(0);
            }
            float r2[2], r1;
#pragma unroll
            for (int j = 0; j < 2; ++j) { const float keep = (hl & 16) ? d[j + 2] : d[j], send = (hl & 16) ? d[j] : d[j + 2]; r2[j] = keep + __shfl_xor(send, 16); }
            { const float keep = (hl & 8) ? r2[1] : r2[0], send = (hl & 8) ? r2[0] : r2[1]; r1 = keep + __shfl_xor(send, 8); }
            r1 += __shfl_xor(r1, 4); r1 += __shfl_xor(r1, 2); r1 += __shfl_xor(r1, 1);
            const float xg = r1 * (1.f / 64.f);
            const float wq = Lw[j0 + (hl >> 3)] * (0.5f * xg * (1.f + erff(xg * 0.70710678118654752f))) * (1.f / 5.5f);
#pragma unroll
            for (int j = 0; j < 4; ++j) {
                const float wj = __shfl(wq, (lane & 32) | (j * 8));
                const f32x2 w2 = (f32x2){wj, wj};
                const f32x32 x = __builtin_amdgcn_cvt_scalef32_pk32_f32_fp6(rv[j], 1.0f);
#pragma unroll
                for (int k = 0; k < 16; ++k) acc[k] = __builtin_elementwise_fma((f32x2){x[2 * k], x[2 * k + 1]}, w2, acc[k]);
                rv[j] = ld24(G6_ROW(jn, j) + 768);
                __builtin_amdgcn_sched_barrier(0);
            }
        }
#undef G6_ROW
        {
            const int b = tok / NS;
            const float* xo = p.out + (size_t)tok * ND + hl * 32; float* yo = outp + (size_t)tok * ND + hl * 32; const float* g2 = mod + b * 6144 + 5120 + hl * 32; const float* nf = p.norm_f + hl * 32;
            f32x4 y[8]; float ss = 0.f;
#pragma unroll
            for (int q = 0; q < 8; ++q) {
                const f32x4 xv = *(const f32x4*)(xo + q * 4), gv = *(const f32x4*)(g2 + q * 4);
                y[q] = xv + gv * (f32x4){acc[2 * q].x, acc[2 * q].y, acc[2 * q + 1].x, acc[2 * q + 1].y};
                ss += y[q][0] * y[q][0] + y[q][1] * y[q][1] + y[q][2] * y[q][2] + y[q][3] * y[q][3];
            }
            ss += __shfl_xor(ss, 16); ss += __shfl_xor(ss, 8); ss += __shfl_xor(ss, 4); ss += __shfl_xor(ss, 2); ss += __shfl_xor(ss, 1);
            const float rstd = rsqrtf(ss * (1.f / ND) + EPS);
#pragma unroll
            for (int q = 0; q < 8; ++q) *(f32x4*)(yo + q * 4) = y[q] * rstd * *(const f32x4*)(nf + q * 4);
        }
    }
}

__device__ __forceinline__ void g8_batch(u32x6 (&ru)[4], u32x6 (&rv)[4], const unsigned char* UV, const int* Lidx, const float* Lw, int j0, int jr, int jv, int lane, int hl,
                                         const unsigned (&hp)[16], f32x2 (&acc)[16]) {
    float d[4];
#pragma unroll
    for (int j = 0; j < 4; ++j) {
        const f32x32 x = __builtin_amdgcn_cvt_scalef32_pk32_f32_fp6(ru[j], 1.0f);
        f32x2 s = (f32x2){0.f, 0.f};
#pragma unroll
        for (int k = 0; k < 16; ++k) s = __builtin_elementwise_fma((f32x2){x[2 * k], x[2 * k + 1]}, (f32x2){bflo(hp[k]), bfhi(hp[k])}, s);
        d[j] = s.x + s.y;
        ru[j] = ld24(UV + (size_t)Lidx[jr + j] * 1536 + hl * 24);
        __builtin_amdgcn_sched_barrier(0);
    }
    float r2[2], r1;
#pragma unroll
    for (int j = 0; j < 2; ++j) { const float keep = (hl & 16) ? d[j + 2] : d[j], send = (hl & 16) ? d[j] : d[j + 2]; r2[j] = keep + __shfl_xor(send, 16); }
    { const float keep = (hl & 8) ? r2[1] : r2[0], send = (hl & 8) ? r2[0] : r2[1]; r1 = keep + __shfl_xor(send, 8); }
    r1 += __shfl_xor(r1, 4); r1 += __shfl_xor(r1, 2); r1 += __shfl_xor(r1, 1);
    const float xg = r1 * (1.f / 64.f);
    const float wq = Lw[j0 + (hl >> 3)] * (0.5f * xg * (1.f + erff(xg * 0.70710678118654752f))) * (1.f / 5.5f);
#pragma unroll
    for (int j = 0; j < 4; ++j) {
        const float wj = __shfl(wq, (lane & 32) | (j * 8));
        const f32x2 w2 = (f32x2){wj, wj};
        const f32x32 x = __builtin_amdgcn_cvt_scalef32_pk32_f32_fp6(rv[j], 1.0f);
#pragma unroll
        for (int k = 0; k < 16; ++k) acc[k] = __builtin_elementwise_fma((f32x2){x[2 * k], x[2 * k + 1]}, w2, acc[k]);
        rv[j] = ld24(UV + (size_t)Lidx[jv + j] * 1536 + hl * 24 + 768);
        __builtin_amdgcn_sched_barrier(0);
    }
}
__device__ __forceinline__ void gather8_phase(const Params& p, unsigned char* lds, float* outp) {
    const unsigned char* UV = p.ws + WS_U; const bf16_t* H2 = (const bf16_t*)(p.ws + WS_XN);
    const int* PIDX = (const int*)(p.ws + WS_PIDX); const float* PG = (const float*)(p.ws + WS_PG);
    const float* mod = (const float*)(p.ws + WS_MOD);
    const int tid = threadIdx.x, lane = tid & 63, wave = tid >> 6, half = lane >> 5, hl = lane & 31;
    unsigned char* wl = lds + wave * 2560 + half * 1280;
    int* Lidx = (int*)wl; float* Lw = (float*)(wl + 512); int* cnt = (int*)(wl + 1024);
    for (int pass_ = 0; pass_ < ((MT / 64 + (int)gridDim.x - 1) / (int)gridDim.x) * 4; ++pass_) {
        const int tb = (int)blockIdx.x + (pass_ >> 2) * (int)gridDim.x;
        if (tb >= MT / 64) break;
        const int tok = tb * 64 + (pass_ & 3) * 16 + wave * 2 + half;
        cnt[hl] = 0; cnt[32 + hl] = 0;
        int ei[4]; float ew[4]; int pib[4];
#pragma unroll
        for (int s = 0; s < 4; ++s) { ei[s] = PIDX[(size_t)tok * 128 + s * 32 + hl]; ew[s] = PG[(size_t)tok * 128 + s * 32 + hl]; }
#pragma unroll
        for (int s = 0; s < 4; ++s) pib[s] = atomicAdd(&cnt[ei[s] >> 8], 1);
        {
            const int c0 = cnt[2 * hl], c1 = cnt[2 * hl + 1]; int x = c0 + c1;
#pragma unroll
            for (int off = 1; off < 32; off <<= 1) { const int y = __shfl_up(x, off, 32); if (hl >= off) x += y; }
            const int ex = x - c0 - c1;
            cnt[2 * hl] = ex; cnt[2 * hl + 1] = ex + c0;
        }
#pragma unroll
        for (int s = 0; s < 4; ++s) { const int pos = cnt[ei[s] >> 8] + pib[s]; Lidx[pos] = ei[s]; Lw[pos] = ew[s]; }
        unsigned hp[16]; f32x2 acc[16];
        {
            const bf16_t* hq = H2 + (size_t)tok * ND + hl * 32;
#pragma unroll
            for (int q = 0; q < 4; ++q) { const u32x4 a = *(const u32x4*)(hq + q * 8);
#pragma unroll
                for (int e = 0; e < 4; ++e) { hp[q * 4 + e] = a[e]; acc[q * 4 + e] = (f32x2){0.f, 0.f}; } }
        }
        u32x6 ruA[4], ruB[4], rv[4];
#pragma unroll
        for (int j = 0; j < 4; ++j) {
            const unsigned char* ra = UV + (size_t)Lidx[j] * 1536 + hl * 24; ruA[j] = ld24(ra); rv[j] = ld24(ra + 768);
            const unsigned char* rb = UV + (size_t)Lidx[4 + j] * 1536 + hl * 24; ruB[j] = ld24(rb);
        }
#pragma unroll 1
        for (int j0 = 0; j0 < 128; j0 += 8) {
            g8_batch(ruA, rv, UV, Lidx, Lw, j0, min(j0 + 8, 124), j0 + 4, lane, hl, hp, acc);
            g8_batch(ruB, rv, UV, Lidx, Lw, j0 + 4, min(j0 + 12, 124), min(j0 + 8, 124), lane, hl, hp, acc);
        }
        {
            const int b = tok / NS;
            const float* xo = p.out + (size_t)tok * ND + hl * 32; float* yo = outp + (size_t)tok * ND + hl * 32; const float* g2 = mod + b * 6144 + 5120 + hl * 32; const float* nf = p.norm_f + hl * 32;
            f32x4 y[8]; float ss = 0.f;
#pragma unroll
            for (int q = 0; q < 8; ++q) {
                const f32x4 xv = *(const f32x4*)(xo + q * 4), gv = *(const f32x4*)(g2 + q * 4);
                y[q] = xv + gv * (f32x4){acc[2 * q].x, acc[2 * q].y, acc[2 * q + 1].x, acc[2 * q + 1].y};
                ss += y[q][0] * y[q][0] + y[q][1] * y[q][1] + y[q][2] * y[q][2] + y[q][3] * y[q][3];
            }
            ss += __shfl_xor(ss, 16); ss += __shfl_xor(ss, 8); ss += __shfl_xor(ss, 4); ss += __shfl_xor(ss, 2); ss += __shfl_xor(ss, 1);
            const float rstd = rsqrtf(ss * (1.f / ND) + EPS);
#pragma unroll
            for (int q = 0; q < 8; ++q) *(f32x4*)(yo + q * 4) = y[q] * rstd * *(const f32x4*)(nf + q * 4);
        }
    }
}

#define XB_TMO      128
#define XB_XCNT(j)  (256  + 64 * (j))
#define XB_XSUB(j)  (1280 + 64 * (j))
#define XB_XGEN(j)  (2304 + 64 * (j))
#define XB_TOP      3328
#define XB_TOPGEN   3392
#define XCD_BAR_WORDS 3456
#define XB_SPIN_CAP (1u << 18)
#define LAS __attribute__((address_space(3)))
__device__ __forceinline__ unsigned xb_ld(unsigned* p)              { return __hip_atomic_load(p, __ATOMIC_RELAXED, __HIP_MEMORY_SCOPE_AGENT); }
__device__ __forceinline__ unsigned xb_add(unsigned* p, unsigned v) { return __hip_atomic_fetch_add(p, v, __ATOMIC_RELAXED, __HIP_MEMORY_SCOPE_AGENT); }
__device__ __forceinline__ unsigned xb_xcc_id() { return (unsigned)__builtin_amdgcn_s_getreg((3 << 11) | 20) & 0xFu; }
#define XB_SPIN(cond, bar) do { unsigned _sp = 0; while (cond) { __builtin_amdgcn_s_sleep(1); \
    if ((++_sp & 255u) == 0u) { if (xb_ld(&(bar)[XB_TMO])) break; if (_sp > XB_SPIN_CAP) { atomicAdd(&(bar)[XB_TMO], 1u); break; } } } } while (0)
struct XcdBarrier { unsigned* bar; unsigned x; volatile LAS unsigned* st; };
__device__ __forceinline__ XcdBarrier xcd_barrier_post(unsigned* bar, volatile LAS unsigned* st) {
    XcdBarrier b; b.bar = bar; b.x = xb_xcc_id(); b.st = st;
    if (threadIdx.x == 0) (void)xb_add(&bar[XB_XCNT(b.x)], 1u);
    return b;
}
__device__ __forceinline__ void xcd_barrier_complete(unsigned* bar, unsigned x, unsigned& nloc, unsigned& nx) {
    const unsigned G = gridDim.x * gridDim.y * gridDim.z;
    unsigned sum, cnt, mine, sp = 0u;
    for (;;) {
        sum = 0u; cnt = 0u; mine = 0u;
#pragma unroll
        for (unsigned j = 0; j < 16; ++j) { const unsigned c = xb_ld(&bar[XB_XCNT(j)]); sum += c; cnt += (c > 0u) ? 1u : 0u; mine = (j == x) ? c : mine; }
        if (sum == G) break;
        __builtin_amdgcn_s_sleep(1);
        if ((++sp & 255u) == 0u) { if (xb_ld(&bar[XB_TMO])) break; if (sp > XB_SPIN_CAP) { atomicAdd(&bar[XB_TMO], 1u); break; } }
    }
    nloc = mine > 0u ? mine : 1u; nx = cnt > 0u ? cnt : 1u;
}
__device__ __forceinline__ void xcd_barrier(const XcdBarrier& b) {
    asm volatile("s_waitcnt vmcnt(0)" ::: "memory");
    __syncthreads();
    if (threadIdx.x == 0) {
        unsigned* bar = b.bar;
        __builtin_amdgcn_s_waitcnt(0);
        unsigned nloc = b.st[0], nx = b.st[1];
        if (nloc == 0u) { xcd_barrier_complete(bar, b.x, nloc, nx); b.st[0] = nloc; b.st[1] = nx; }
        const unsigned old = xb_add(&bar[XB_XSUB(b.x)], 1u);
        const unsigned gen = old / nloc;
        if (old + 1u == (gen + 1u) * nloc) {
            __builtin_amdgcn_fence(__ATOMIC_RELEASE, "agent");
            asm volatile("s_waitcnt vmcnt(0)" ::: "memory");
            const unsigned og = xb_add(&bar[XB_TOP], 1u);
            const unsigned tg = og / nx;
            if (og + 1u == (tg + 1u) * nx) xb_add(&bar[XB_TOPGEN], 1u);
            else XB_SPIN(xb_ld(&bar[XB_TOPGEN]) == tg, bar);
            __builtin_amdgcn_fence(__ATOMIC_ACQUIRE, "agent");
            xb_add(&bar[XB_XGEN(b.x)], 1u);
            asm volatile("s_waitcnt vmcnt(0)" ::: "memory");
        } else {
            XB_SPIN(xb_ld(&bar[XB_XGEN(b.x)]) == gen, bar);
            __builtin_amdgcn_fence(__ATOMIC_ACQUIRE, "agent");
            asm volatile("s_waitcnt vmcnt(0)" ::: "memory");
        }
    }
    __syncthreads();
}

constexpr int LDS_BYTES = 157696 + 512 + 16;
__global__ void __launch_bounds__(NT, 2) k_mega(Params p) {
    __shared__ __attribute__((aligned(16))) unsigned char lds[LDS_BYTES];
    volatile LAS unsigned* xst = (volatile LAS unsigned*)(lds + 157696 + 512);
    if (threadIdx.x == 0) { xst[0] = 0u; xst[1] = 0u; }
    __syncthreads();
    (void)xcd_barrier_post((unsigned*)(p.ws + WS_CTL), xst);
#define GRID_BARRIER() do { XcdBarrier xb_; xb_.bar = (unsigned*)(p.ws + WS_CTL); xb_.x = xb_xcc_id(); xb_.st = (volatile LAS unsigned*)(lds + 157696 + 512); xcd_barrier(xb_); } while (0)
#define REPS(k) for (int rep_ = 0; rep_ < ((DUP == (k)) ? 2 : 1); ++rep_)
    _Pragma("unroll 1") REPS(1) {
    mod_phase(p, (float*)lds);
    transpose_convert(p.w_in, (bf16_t*)(p.ws + WS_WIN), ND, NIN, (float*)lds);
    transpose_convert(p.w_out, (bf16_t*)(p.ws + WS_WOUT), ND, ND, (float*)lds);
    transpose_convert(p.wq, (bf16_t*)(p.ws + WS_WQ), ND, 2048, (float*)lds);
    convert_flat(p.keys, (bf16_t*)(p.ws + WS_KEYS), (size_t)8 * 2 * 128 * 128);
    }
    GRID_BARRIER();
    _Pragma("unroll 1") REPS(2) prep_phase(p, 0);
    GRID_BARRIER();
    _Pragma("unroll 1") REPS(3) inproj8_phase(p, lds);
    GRID_BARRIER();
    _Pragma("unroll 1") REPS(4) {
        const bool split = gridDim.x >= 256;
        if (!split || blockIdx.x < 128) { _Pragma("unroll 1") REPS(10) hg_chunk_phase(p, lds); }
        if (!split || blockIdx.x >= 128) { _Pragma("unroll 1") REPS(11) na3_phase(p, lds, split ? blockIdx.x - 128 : blockIdx.x, split ? gridDim.x - 128 : gridDim.x); }
    }
    GRID_BARRIER();
#if DUP == 13
    na3_phase(p, lds, blockIdx.x, gridDim.x);
    __syncthreads();
#endif
#if DUP == 14
    hg_corr_phase(p);
#endif
    hg_corr_phase(p);
    GRID_BARRIER();
    _Pragma("unroll 1") REPS(5) hgmix_phase(p);
    GRID_BARRIER();
    _Pragma("unroll 1") REPS(6) outproj8_phase(p, lds);
    GRID_BARRIER();
    _Pragma("unroll 1") REPS(7) prep_phase(p, 1);
    GRID_BARRIER();
    _Pragma("unroll 1") REPS(8) pq8_phase(p, lds);
    GRID_BARRIER();
    _Pragma("unroll 1") REPS(9) topk3_phase(p, (float*)lds);
    __threadfence_block(); __syncthreads();
    _Pragma("unroll 1") for (int rep_ = ((DUP == 12) ? 0 : 1); rep_ < 2; ++rep_) gather8_phase(p, lds, rep_ ? p.out : (float*)(p.ws + WS_PQ));
}
}

extern "C" void kernel_launch(void* const* d_in, const int* in_sizes, int n_in, void* d_out, int out_size, void* d_ws, size_t ws_size, hipStream_t stream) {
    if (n_in != 18 || ws_size < WS_END) { fprintf(stderr, "kernel_launch: unexpected n_in %d / ws_size %zu\n", n_in, ws_size); return; }
    Params p{};
    p.x = (const float*)d_in[0]; p.c = (const float*)d_in[1]; p.ctx = (const float*)d_in[2]; p.c_ctx = (const float*)d_in[3];
    p.w_mod = (const float*)d_in[4]; p.b_mod = (const float*)d_in[5]; p.norm1 = (const float*)d_in[6]; p.norm2 = (const float*)d_in[7];
    p.w_in = (const float*)d_in[8]; p.w_out = (const float*)d_in[9]; p.rpb = (const float*)d_in[10]; p.hg_lb = (const float*)d_in[11];
    p.hg_norm = (const float*)d_in[12]; p.wq = (const float*)d_in[13]; p.keys = (const float*)d_in[14]; p.pu = (const float*)d_in[15];
    p.pv = (const float*)d_in[16]; p.norm_f = (const float*)d_in[17];
    p.out = (float*)d_out; p.ws = (unsigned char*)d_ws;
    static int grid_blocks = 0;
    if (!grid_blocks) {
        int dev = 0, cus = 0, per_cu = 0;
        hipGetDevice(&dev);
        hipDeviceGetAttribute(&cus, hipDeviceAttributeMultiprocessorCount, dev);
        hipOccupancyMaxActiveBlocksPerMultiprocessor(&per_cu, k_mega, NT, 0);
        if (per_cu < 1) { fprintf(stderr, "kernel_launch: occupancy query says %d blocks per CU\n", per_cu); per_cu = 1; }
        if (per_cu > 1) per_cu = 1;
        grid_blocks = cus * per_cu;
    }
    if (hipMemsetAsync((char*)d_ws + WS_CTL, 0, XCD_BAR_WORDS * 4, stream) != hipSuccess) { fprintf(stderr, "kernel_launch: memset of the barrier words failed\n"); return; }
    hipLaunchKernelGGL(k_mega, dim3(grid_blocks), dim3(NT), 0, stream, p);
}
```

```cpp
#include <hip/hip_runtime.h>
#include <hip/hip_cooperative_groups.h>
#include <cstdint>
#include <cstdio>

typedef unsigned short bf16_t;
typedef short bf16x8 __attribute__((ext_vector_type(8)));
typedef float f32x4 __attribute__((ext_vector_type(4)));
typedef unsigned u32x4 __attribute__((ext_vector_type(4)));
typedef unsigned u32x2 __attribute__((ext_vector_type(2)));

namespace pg8 {
#define PG8_LAS __attribute__((address_space(3)))
typedef unsigned short bf16_t;
typedef short bf16x8 __attribute__((ext_vector_type(8)));
typedef float f32x4 __attribute__((ext_vector_type(4)));
typedef unsigned u32x4 __attribute__((ext_vector_type(4)));
constexpr int BM = 256, BK = 64, HALF = 128, HTB = HALF * BK * 2  , STAGE_BYTES = 8 * HTB, NXCD = 8, WGM = 8;

__host__ __device__ __forceinline__ int lds_byte(int r, int c) { const int st = (r >> 4) * 2 + (c >> 5), rr = r & 15, cc = c & 31, ob = rr * 64 + cc * 2; return st * 1024 + (ob ^ (((ob >> 9) & 1) << 5)); }
__host__ __device__ __forceinline__ void stage_rc(int b, int& R, int& C) { const int st = b / 1024, sb = b % 1024, swz = sb ^ (((sb >> 9) & 1) << 5); R = (st >> 1) * 16 + swz / 64; C = (st & 1) * 32 + (swz % 64) / 2; }
__host__ __device__ __forceinline__ int perm32(int rho) { const int n = rho >> 4, i = rho & 15; return 8 * (i >> 2) + 4 * n + (i & 3); }

struct Unit { int pm, pn; };
struct Gemm { const bf16_t* A; const bf16_t* Bt; int M, N, K; };

struct StaticOrder {
    int nM, nN, nwg, G, c;
    __host__ __device__ void init(int M, int N, int G_, int c_) { nM = M / BM; nN = N / BM; nwg = nM * nN; G = G_; c = c_; }
    __host__ __device__ bool next(int i, Unit& u) const {
        const long L = (long)i * G + c; if (L >= nwg) return false;
        int wgid = (int)L; { const int q = nwg / NXCD, r = nwg % NXCD, xcd = wgid % NXCD, off = wgid / NXCD; wgid = (xcd < r ? xcd * (q + 1) : r * (q + 1) + (xcd - r) * q) + off; }
        const int nig = WGM * nN, gid = wgid / nig, fm = gid * WGM, gsz = (nM - fm) < WGM ? (nM - fm) : WGM;
        u.pm = fm + ((wgid % nig) % gsz); u.pn = (wgid % nig) / gsz; return true;
    }
    __device__ __forceinline__ void a_ready(const Unit&) const {}
    __device__ __forceinline__ void done(const Unit&) const {}
};
__device__ __forceinline__ unsigned cvt_pk_bf16(float lo, float hi) { unsigned r; asm volatile("v_cvt_pk_bf16_f32 %0, %1, %2" : "=v"(r) : "v"(lo), "v"(hi)); return r; }
template <class Epi, class Sched, bool STAMP = false>
__device__ __forceinline__ void gemm_phase(PG8_LAS unsigned char* lds, const Gemm g, const Sched& S, const Epi& E, unsigned long long* stamps) {
    int tid_ = threadIdx.x; asm volatile("" : "+v"(tid_));
    const int tid = tid_, wid = __builtin_amdgcn_readfirstlane(tid >> 6), lane = tid & 63, wr = wid >> 2, wc = wid & 3, fr = lane & 15, fq = lane >> 4;
    const int K = g.K, nt = K / BK;
    int ts_lo = 0, ts_hi = 0, nts = 0; const unsigned long long rt_entry = STAMP ? (unsigned long long)wall_clock64() : 0ull;
#define PG8_STAMP() do { if (STAMP && wid == 0 && nts < 64) { const unsigned long long _c = (unsigned long long)clock64(); \
        ts_lo = (lane == nts) ? (int)(unsigned)_c : ts_lo; ts_hi = (lane == nts) ? (int)(unsigned)(_c >> 32) : ts_hi; ++nts; } } while (0)
    PG8_STAMP();
    unsigned voffA[2], voffB[2];
#pragma unroll
    for (int i = 0; i < 2; ++i) { int R, C; stage_rc(tid * 16 + i * 8192, R, C); const int Rb = Epi::PERM ? ((R & ~31) + perm32(R & 31)) : R;
        voffA[i] = (unsigned)(R * K + C) * 2u; voffB[i] = (unsigned)(Rb * K + C) * 2u; }
    const size_t kstep = (size_t)(BK * 2);
    const size_t hstep = (size_t)HALF * K * 2;
    const size_t tstep = 2 * hstep;
    const unsigned ldsw = (unsigned)wid * 1024u;
    const int aoff = lds_byte(wr * 64 + fr, fq * 8), boff = lds_byte(wc * 32 + fr, fq * 8);
#define PG8_SA(b, h) (((b) * 2 + (h)) * HTB)
#define PG8_SB(b, h) ((4 + (b) * 2 + (h)) * HTB)
#define PG8_STAGE(bufoff, gbase, voff) do { _Pragma("unroll") for (int _i = 0; _i < 2; ++_i) \
        __builtin_amdgcn_global_load_lds((const unsigned*)((const char*)(gbase) + (voff)[_i]), (PG8_LAS unsigned*)(lds + (bufoff) + ldsw + _i * 8192), 16, 0, 0); } while (0)
#define PG8_LDA(dst, b, h) do { _Pragma("unroll") for (int m = 0; m < 4; ++m) _Pragma("unroll") for (int k = 0; k < 2; ++k) dst[m][k] = *(const PG8_LAS bf16x8*)(lds + PG8_SA(b, h) + aoff + m * 2048 + k * 1024); } while (0)
#define PG8_LDB(dst, b, h) do { _Pragma("unroll") for (int n = 0; n < 2; ++n) _Pragma("unroll") for (int k = 0; k < 2; ++k) dst[n][k] = *(const PG8_LAS bf16x8*)(lds + PG8_SB(b, h) + boff + n * 2048 + k * 1024); } while (0)
#define PG8_MMA(ai, bj, At, Bt) do { __builtin_amdgcn_s_setprio(1); _Pragma("unroll") for (int m = 0; m < 4; ++m) _Pragma("unroll") for (int n = 0; n < 2; ++n) _Pragma("unroll") for (int k = 0; k < 2; ++k) \
        acc[ai][bj][m][n] = __builtin_amdgcn_mfma_f32_16x16x32_bf16(Bt[n][k], At[m][k], acc[ai][bj][m][n], 0, 0, 0); __builtin_amdgcn_s_setprio(0); } while (0)
#define PG8_WAIT_V(n) asm volatile("s_waitcnt vmcnt(" #n ")" ::: "memory")
#define PG8_WAIT_L(n) asm volatile("s_waitcnt lgkmcnt(" #n ")" ::: "memory")
#define PG8_BAR __builtin_amdgcn_s_barrier()
#define PG8_SCHED __builtin_amdgcn_sched_barrier(0)
    Unit cur, nxt; int ui = 0;
    if (!S.next(0, cur)) return;
    f32x4 acc[2][2][4][2];
#pragma unroll
    for (int a = 0; a < 2; ++a)
#pragma unroll
        for (int b = 0; b < 2; ++b)
#pragma unroll
            for (int m = 0; m < 4; ++m)
#pragma unroll
                for (int n = 0; n < 2; ++n) acc[a][b][m][n] = (f32x4){0.f, 0.f, 0.f, 0.f};
    bf16x8 At[4][2], B0[2][2], B1[2][2];
    const char* cA = (const char*)g.A + (size_t)cur.pm * tstep; const char* cB = (const char*)g.Bt + (size_t)cur.pn * tstep;
    S.a_ready(cur);
    PG8_STAGE(PG8_SB(0, 0), cB, voffB); PG8_STAGE(PG8_SA(0, 0), cA, voffA); PG8_STAGE(PG8_SB(0, 1), cB + hstep, voffB); PG8_STAGE(PG8_SA(0, 1), cA + hstep, voffA);
    if (wr == 1) PG8_BAR;
    PG8_WAIT_V(4); PG8_BAR;
    PG8_STAGE(PG8_SB(1, 0), cB + kstep, voffB); PG8_STAGE(PG8_SA(1, 0), cA + kstep, voffA); PG8_STAGE(PG8_SB(1, 1), cB + hstep + kstep, voffB);
    PG8_WAIT_V(6); PG8_BAR;
    PG8_STAMP();
    for (;;) {
        const bool has_next = S.next(ui + 1, nxt);
        const char* nA = has_next ? (const char*)g.A + (size_t)nxt.pm * tstep : cA; const char* nB = has_next ? (const char*)g.Bt + (size_t)nxt.pn * tstep : cB;
        for (int t = 0; t < nt; t += 2) {
            const bool last = (t == nt - 2);
            const char* a1 = cA + (size_t)(t + 1) * kstep;
            const char* a2 = last ? nA : cA + (size_t)(t + 2) * kstep; const char* b2 = last ? nB : cB + (size_t)(t + 2) * kstep;
            const char* a3 = a2 + kstep; const char* b3 = b2 + kstep;
            if (last && has_next) S.a_ready(nxt);
            PG8_LDB(B0, 0, 0); PG8_SCHED; PG8_LDA(At, 0, 0); PG8_STAGE(PG8_SA(1, 1), a1 + hstep, voffA);
            PG8_WAIT_L(8); PG8_BAR; PG8_WAIT_L(0); PG8_MMA(0, 0, At, B0); PG8_BAR; PG8_SCHED;
            PG8_LDB(B1, 0, 1); PG8_STAGE(PG8_SB(0, 0), b2, voffB);
            PG8_BAR; PG8_WAIT_L(0); PG8_MMA(0, 1, At, B1); PG8_BAR;
            PG8_LDA(At, 0, 1); PG8_STAGE(PG8_SA(0, 0), a2, voffA);
            PG8_BAR; PG8_WAIT_L(0); PG8_MMA(1, 0, At, B0); PG8_BAR; PG8_SCHED;
            PG8_STAGE(PG8_SB(0, 1), b2 + hstep, voffB);
            PG8_WAIT_V(6); PG8_BAR; PG8_MMA(1, 1, At, B1); PG8_BAR;
            PG8_LDB(B0, 1, 0); PG8_SCHED; PG8_LDA(At, 1, 0); PG8_STAGE(PG8_SA(0, 1), a2 + hstep, voffA);
            PG8_WAIT_L(8); PG8_BAR; PG8_WAIT_L(0); PG8_MMA(0, 0, At, B0); PG8_BAR; PG8_SCHED;
            PG8_LDB(B1, 1, 1); PG8_STAGE(PG8_SB(1, 0), b3, voffB);
            PG8_BAR; PG8_WAIT_L(0); PG8_MMA(0, 1, At, B1); PG8_BAR;
            PG8_LDA(At, 1, 1); PG8_STAGE(PG8_SA(1, 0), a3, voffA);
            PG8_BAR; PG8_WAIT_L(0); PG8_MMA(1, 0, At, B0); PG8_BAR; PG8_SCHED;
            PG8_STAGE(PG8_SB(1, 1), b3 + hstep, voffB);
            PG8_WAIT_V(6); PG8_BAR; PG8_MMA(1, 1, At, B1); PG8_BAR;
        }
        PG8_STAMP();
        if constexpr (!Epi::AFTER_DRAIN) { E(acc, cur, wr, wc, fr, fq); S.done(cur); }
        PG8_STAMP();
        if (!has_next) break;
#pragma unroll
        for (int a = 0; a < 2; ++a)
#pragma unroll
            for (int b = 0; b < 2; ++b)
#pragma unroll
                for (int m = 0; m < 4; ++m)
#pragma unroll
                    for (int n = 0; n < 2; ++n) acc[a][b][m][n] = (f32x4){0.f, 0.f, 0.f, 0.f};
        cur = nxt; cA = nA; cB = nB; ++ui;
    }
    PG8_WAIT_V(0);
    if (wr == 0) PG8_BAR;
    PG8_BAR;
    if constexpr (Epi::AFTER_DRAIN) { E.fused(acc, cur, wr, wc, fr, fq, lds, wid, lane); S.done(cur); }
    PG8_STAMP();
    if (STAMP && wid == 0) { stamps[lane] = lane < nts ? (((unsigned long long)(unsigned)ts_hi << 32) | (unsigned)ts_lo) : 0ull;
        if (lane == 62) stamps[62] = rt_entry; if (lane == 63) stamps[63] = (unsigned long long)wall_clock64(); }
#undef PG8_STAMP
#undef PG8_SA
#undef PG8_SB
#undef PG8_STAGE
#undef PG8_LDA
#undef PG8_LDB
#undef PG8_MMA
#undef PG8_WAIT_V
#undef PG8_WAIT_L
#undef PG8_BAR
#undef PG8_SCHED
}
}

#ifndef PEER_V4
#define PEER_V4 1
#endif
namespace cg = cooperative_groups;
namespace {
constexpr int NB = 8, NS = 2048, ND = 1024, NL = 256, GW = 64, NROWS = 32;
constexpr int MT = NB * NS;
constexpr int MC = NB * NL;
constexpr int MA = MT + MC;
constexpr int NIN = 4096;
constexpr int NT = 512;
constexpr float EPS = 1e-6f;

constexpr size_t MiB = 1ull << 20;
constexpr size_t WS_CTL = 0;
constexpr size_t WS_MOD = 64 * 1024;
constexpr size_t WS_LB = 320 * 1024;
constexpr size_t WS_KEYS = 512 * 1024;
constexpr size_t WS_WIN = 1 * MiB;
constexpr size_t WS_WOUT = 9 * MiB;
constexpr size_t WS_WQ = 11 * MiB;
constexpr size_t WS_U = 15 * MiB;
constexpr size_t WS_V = 47 * MiB;
constexpr size_t WS_QHC = 47 * MiB;
constexpr size_t WS_S0T = 66 * MiB;
constexpr size_t WS_XN = 79 * MiB;
constexpr size_t WS_NAQ = 115 * MiB;
constexpr size_t WS_NAK = 131 * MiB;
constexpr size_t WS_NAV = 149 * MiB;
constexpr size_t WS_HQ = 167 * MiB;
constexpr size_t WS_ZF = 183 * MiB;
constexpr size_t WS_ZB = 201 * MiB;
constexpr size_t WS_HI = 219 * MiB;
constexpr size_t WS_HG = 237 * MiB;
constexpr size_t WS_END = 253 * MiB;
constexpr size_t WS_PQ = 115 * MiB;
constexpr size_t WS_PIDX = 179 * MiB;
constexpr size_t WS_PG = 187 * MiB;

struct Params {
    const float* x; const float* c; const float* ctx; const float* c_ctx; const float* w_mod; const float* b_mod;
    const float* norm1; const float* norm2; const float* w_in; const float* w_out; const float* rpb; const float* hg_lb;
    const float* hg_norm; const float* wq; const float* keys; const float* pu; const float* pv; const float* norm_f;
    float* out; unsigned char* ws;
};

__device__ __forceinline__ bf16_t f2bf(float f) { unsigned u = __float_as_uint(f); u += 0x7fffu + ((u >> 16) & 1u); return (bf16_t)(u >> 16); }
__device__ __forceinline__ float bf2f(bf16_t h) { return __uint_as_float(((unsigned)h) << 16); }
__device__ __forceinline__ unsigned pack2(float lo, float hi) { return (unsigned)f2bf(lo) | ((unsigned)f2bf(hi) << 16); }
__device__ __forceinline__ float bflo(unsigned w) { return __uint_as_float(w << 16); }
__device__ __forceinline__ float bfhi(unsigned w) { return __uint_as_float(w & 0xffff0000u); }
__device__ __forceinline__ float silu_f(float v) { return v / (1.f + __expf(-v)); }
__device__ __forceinline__ float wave_sum(float v) {
#pragma unroll
    for (int o = 32; o >= 1; o >>= 1) v += __shfl_xor(v, o);
    return v;
}

__device__ __forceinline__ void mod_phase(const Params& p, float* lds) {
    float* sc = lds;
    float* red = lds + 9 * 1024;
    const int tid = threadIdx.x;
    float* mod = (float*)(p.ws + WS_MOD);
    for (int i = tid; i < 9 * 1024; i += NT) {
        const int r = i >> 10, k = i & 1023;
        const float v = (r < 8) ? p.c[r * 1024 + k] : p.c_ctx[k];
        sc[i] = silu_f(v);
    }
    __syncthreads();
    const int c4 = tid & 15, ks = tid >> 4, lane = tid & 63, wave = tid >> 6;
    for (int unit = blockIdx.x; unit < 6144 / 64; unit += gridDim.x) {
        const int j0 = unit * 64 + c4 * 4;
        f32x4 acc[9];
#pragma unroll
        for (int r = 0; r < 9; ++r) acc[r] = (f32x4){0.f, 0.f, 0.f, 0.f};
#pragma unroll 1
        for (int kb = ks * 32; kb < ks * 32 + 32; kb += 8) {
            f32x4 w[8];
#pragma unroll
            for (int i = 0; i < 8; ++i) w[i] = *(const f32x4*)(p.w_mod + (size_t)(kb + i) * 6144 + j0);
#pragma unroll
            for (int i = 0; i < 8; ++i)
#pragma unroll
                for (int r = 0; r < 9; ++r) acc[r] += w[i] * sc[r * 1024 + kb + i];
        }
#pragma unroll
        for (int r = 0; r < 9; ++r)
#pragma unroll
            for (int e = 0; e < 4; ++e) { float v = acc[r][e]; v += __shfl_xor(v, 16); v += __shfl_xor(v, 32); acc[r][e] = v; }
        if (lane < 16) {
#pragma unroll
            for (int r = 0; r < 9; ++r) *(f32x4*)(red + (wave * 9 + r) * 64 + c4 * 4) = acc[r];
        }
        __syncthreads();
        for (int i = tid; i < 9 * 64; i += NT) {
            const int r = i >> 6, cc = i & 63;
            float s = 0.f;
#pragma unroll
            for (int q = 0; q < 8; ++q) s += red[(q * 9 + r) * 64 + cc];
            mod[r * 6144 + unit * 64 + cc] = s + p.b_mod[unit * 64 + cc];
        }
        __syncthreads();
    }
    float* lb = (float*)(p.ws + WS_LB);
    for (int i = blockIdx.x * NT + tid; i < 1024; i += gridDim.x * NT) {
        const float a0 = p.hg_lb[i], a1 = p.hg_lb[1024 + i];
        lb[i] = 1.f / (1.f + __expf(a1 - a0));
    }
}

__device__ __forceinline__ void transpose_convert(const float* W, bf16_t* Wt, int K, int N, float* lds) {
    const int tid = threadIdx.x;
    const int tk = K / 64, tn = N / 64;
    for (int unit = blockIdx.x; unit < tk * tn; unit += gridDim.x) {
        const int k0 = (unit / tn) * 64, n0 = (unit % tn) * 64;
        for (int i = tid; i < 64 * 64; i += NT) { const int r = i >> 6, cc = i & 63; lds[r * 65 + cc] = W[(size_t)(k0 + r) * N + n0 + cc]; }
        __syncthreads();
        for (int i = tid; i < 64 * 64; i += NT) { const int n = i >> 6, k = i & 63; Wt[(size_t)(n0 + n) * K + k0 + k] = f2bf(lds[k * 65 + n]); }
        __syncthreads();
    }
}
__device__ __forceinline__ void convert_flat(const float* src, bf16_t* dst, size_t n) {
    const size_t stride = (size_t)gridDim.x * NT * 4;
    for (size_t i = ((size_t)blockIdx.x * NT + threadIdx.x) * 4; i < n; i += stride) {
        const f32x4 v = *(const f32x4*)(src + i);
        u32x2 o; o.x = pack2(v[0], v[1]); o.y = pack2(v[2], v[3]);
        *(u32x2*)(dst + i) = o;
    }
}


__device__ __forceinline__ unsigned fp6_code(float x) {
    const float a = fminf(fabsf(x), 7.5f);
    float c = a < 2.f ? __builtin_rintf(a * 8.f) : (a < 4.f ? 16.f + __builtin_rintf((a - 2.f) * 4.f) : 24.f + __builtin_rintf((a - 4.f) * 2.f));
    return (unsigned)c | (x < 0.f ? 32u : 0u);
}
__device__ __forceinline__ void convert_uv_fp6(const float* u, const float* v, unsigned char* uv, int blk, int nblk) {
    const size_t ng = (size_t)16384 * 32;
    const size_t stride = (size_t)nblk * NT;
    for (size_t i = (size_t)blk * NT + threadIdx.x; i < 2 * ng; i += stride) {
        const bool isv = i >= ng; const size_t q = isv ? i - ng : i;
        const size_t e = q >> 5, grp = q & 31;
        const float* src = (isv ? v : u) + q * 32; const float sc = isv ? 5.5f : 64.f;
        unsigned w[6] = {0u, 0u, 0u, 0u, 0u, 0u};
#pragma unroll
        for (int j = 0; j < 8; ++j) {
            const f32x4 x = *(const f32x4*)(src + j * 4) * sc;
#pragma unroll
            for (int k = 0; k < 4; ++k) {
                const int idx = j * 4 + k, bit = idx * 6, dw = bit >> 5, off = bit & 31;
                const unsigned code = fp6_code(x[k]);
                w[dw] |= code << off;
                if (off > 26) w[dw + 1] |= code >> (32 - off);
            }
        }
        unsigned* dst = (unsigned*)(uv + e * 1536 + (isv ? 768 : 0) + grp * 24);
        *(u32x2*)dst = (u32x2){w[0], w[1]}; *(u32x2*)(dst + 2) = (u32x2){w[2], w[3]}; *(u32x2*)(dst + 4) = (u32x2){w[4], w[5]};
    }
}

__device__ __forceinline__ unsigned fp4_code(float x) {
    const float a = fabsf(x);
    const unsigned m = a < 0.25f ? 0u : a < 0.75f ? 1u : a < 1.25f ? 2u : a < 1.75f ? 3u : a < 2.5f ? 4u : a < 3.5f ? 5u : a < 5.f ? 6u : 7u;
    return m | (x < 0.f ? 8u : 0u);
}
__device__ __forceinline__ void convert_uv_fp64(const float* u, const float* v, unsigned char* uv, unsigned* ctr, int* lds_slot) {
    const size_t ng = (size_t)16384 * 32;
    for (;;) {
        if (threadIdx.x == 0) *lds_slot = (int)__hip_atomic_fetch_add(ctr, 1u, __ATOMIC_RELAXED, __HIP_MEMORY_SCOPE_AGENT);
        __syncthreads();
        const size_t chunk = (size_t)*lds_slot;
        __syncthreads();
        if (chunk >= 2 * ng / NT) break;
        const size_t i = chunk * NT + threadIdx.x;
        {

        const bool isv = i >= ng; const size_t q = isv ? i - ng : i;
        const size_t e = q >> 5, grp = q & 31;
        const float* src = (isv ? v : u) + q * 32;
        if (!isv) {
            unsigned w[6] = {0u, 0u, 0u, 0u, 0u, 0u};
#pragma unroll
            for (int j = 0; j < 8; ++j) {
                const f32x4 x = *(const f32x4*)(src + j * 4) * 64.f;
#pragma unroll
                for (int k = 0; k < 4; ++k) {
                    const int idx = j * 4 + k, bit = idx * 6, dw = bit >> 5, off = bit & 31;
                    const unsigned code = fp6_code(x[k]);
                    w[dw] |= code << off;
                    if (off > 26) w[dw + 1] |= code >> (32 - off);
                }
            }
            unsigned* dst = (unsigned*)(uv + e * 1280 + grp * 24);
            *(u32x2*)dst = (u32x2){w[0], w[1]}; *(u32x2*)(dst + 2) = (u32x2){w[2], w[3]}; *(u32x2*)(dst + 4) = (u32x2){w[4], w[5]};
        } else {
            unsigned w[4] = {0u, 0u, 0u, 0u};
#pragma unroll
            for (int j = 0; j < 8; ++j) {
                const f32x4 x = *(const f32x4*)(src + j * 4) * 7.f;
#pragma unroll
                for (int k = 0; k < 4; ++k) { const int idx = j * 4 + k; w[idx >> 3] |= fp4_code(x[k]) << ((idx & 7) * 4); }
            }
            *(u32x4*)(uv + e * 1280 + 768 + grp * 16) = (u32x4){w[0], w[1], w[2], w[3]};
        }
    }
    }
}

__device__ __forceinline__ void prep_phase(const Params& p, int which) {
    const int tid = threadIdx.x, lane = tid & 63, wave = tid >> 6;
    const float* mod = (const float*)(p.ws + WS_MOD);
    bf16_t* dst = (bf16_t*)(p.ws + WS_XN);
    const int nrows = which == 0 ? MA : MT;
    const float* g = which == 0 ? p.norm1 : p.norm2;
    for (int row = blockIdx.x * 8 + wave; row < nrows; row += gridDim.x * 8) {
        const float* src; int mr;
        if (which == 0) { if (row < MT) { src = p.x + (size_t)row * ND; mr = row / NS; } else { src = p.ctx + (size_t)(row - MT) * ND; mr = 8; } }
        else { src = p.out + (size_t)row * ND; mr = row / NS; }
        const float* sh = mod + mr * 6144 + (which == 0 ? 0 : 3072);
        const float* scl = mod + mr * 6144 + (which == 0 ? 1024 : 4096);
        f32x4 v[4]; float ss = 0.f;
#pragma unroll
        for (int i = 0; i < 4; ++i) { v[i] = *(const f32x4*)(src + i * 256 + lane * 4); ss += v[i][0] * v[i][0] + v[i][1] * v[i][1] + v[i][2] * v[i][2] + v[i][3] * v[i][3]; }
        ss = wave_sum(ss);
        const float rstd = rsqrtf(ss * (1.f / ND) + EPS);
#pragma unroll
        for (int i = 0; i < 4; ++i) {
            const int d = i * 256 + lane * 4;
            const f32x4 gg = *(const f32x4*)(g + d), s1 = *(const f32x4*)(sh + d), s2 = *(const f32x4*)(scl + d);
            float h[4];
#pragma unroll
            for (int e = 0; e < 4; ++e) h[e] = (v[i][e] * rstd * gg[e]) * (1.f + s2[e]) + s1[e];
            u32x2 o; o.x = pack2(h[0], h[1]); o.y = pack2(h[2], h[3]);
            *(u32x2*)(dst + (size_t)row * ND + d) = o;
        }
    }
}


struct InProjOrder {
    pg8::StaticOrder so; int G, c;
    __device__ void init(int G_, int c_) { so.init(MT, NIN, G_, c_); G = G_; c = c_; }
    __device__ bool next(int i, pg8::Unit& u) const {
        const long L = (long)i * G + c;
        if (L < 1024) return so.next(i, u);
        const int j = (int)(L - 1024); if (j >= 80) return false;
        const int q = j % 10; u.pm = 64 + j / 10; u.pn = q < 4 ? 2 + q : 4 + q;
        return true;
    }
    __device__ __forceinline__ void a_ready(const pg8::Unit&) const {}
    __device__ __forceinline__ void done(const pg8::Unit&) const {}
};
struct EpiInProj8 {
    static constexpr bool PERM = true, AFTER_DRAIN = false;
    unsigned char* ws;
    __device__ __forceinline__ void operator()(const f32x4 (&acc)[2][2][4][2], const pg8::Unit& u, int wr, int wc, int fr, int fq) const {
#pragma unroll
        for (int bj = 0; bj < 2; ++bj) {
            const int c0 = u.pn * 256 + bj * 128 + wc * 32 + 8 * fq, seg = c0 >> 9, c = c0 & 511;
#pragma unroll
            for (int ai = 0; ai < 2; ++ai)
#pragma unroll
                for (int m = 0; m < 4; ++m) {
                    const int row = u.pm * 256 + ai * 128 + wr * 64 + m * 16 + fr;
                    f32x4 v0 = acc[ai][bj][m][0], v1 = acc[ai][bj][m][1];
                    if (seg == 2 || seg == 6) {
                        bf16_t* vt = (bf16_t*)(ws + (seg == 2 ? WS_NAV : WS_HI));
                        const int hd = seg == 2 ? 64 : 128, nh = 512 / hd, hh = c / hd, dim = c % hd;
                        bf16_t* q; size_t st;
                        if (row < MT) { const int b = row >> 11, s = row & 2047; q = vt + ((size_t)((b * nh + hh) * hd + dim)) * 2048 + s; st = 2048; }
                        else { const int mm = row - MT, b = mm >> 8, j = mm & 255; q = vt + (size_t)MT * 512 + ((size_t)((b * nh + hh) * hd + dim)) * 256 + j; st = 256; }
#pragma unroll
                        for (int e = 0; e < 4; ++e) { q[e * st] = f2bf(v0[e]); q[(4 + e) * st] = f2bf(v1[e]); }
                    } else {
                        if (seg == 0) { v0 = v0 * 0.18033688011f; v1 = v1 * 0.18033688011f; }
                        if (seg == 4 || seg == 5) {
                            const float* lbp = (const float*)(ws + WS_LB) + (seg - 4) * 512 + c;
                            const f32x4 l0 = *(const f32x4*)lbp, l1 = *(const f32x4*)(lbp + 4);
#pragma unroll
                            for (int e = 0; e < 4; ++e) {
                                v0[e] = __builtin_amdgcn_logf(l0[e] + (1.f - l0[e]) * __builtin_amdgcn_rcpf(1.f + __builtin_amdgcn_exp2f(-1.44269504f * v0[e])));
                                v1[e] = __builtin_amdgcn_logf(l1[e] + (1.f - l1[e]) * __builtin_amdgcn_rcpf(1.f + __builtin_amdgcn_exp2f(-1.44269504f * v1[e])));
                            }
                        }
                        if (seg == 3 || seg == 7) {
#pragma unroll
                            for (int e = 0; e < 4; ++e) { v0[e] = silu_f(v0[e]); v1[e] = silu_f(v1[e]); }
                        }
                        const size_t wsoff = seg == 0 ? WS_NAQ : seg == 1 ? WS_NAK : seg == 3 ? WS_HQ : seg == 4 ? WS_ZF : seg == 5 ? WS_ZB : seg == 6 ? WS_HI : WS_HG;
                        u32x4 w; w[0] = pack2(v0[0], v0[1]); w[1] = pack2(v0[2], v0[3]); w[2] = pack2(v1[0], v1[1]); w[3] = pack2(v1[2], v1[3]);
                        *(u32x4*)((bf16_t*)(ws + wsoff) + (size_t)row * 512 + c) = w;
                    }
                }
        }
    }
};
struct EpiOutProj8 {
    static constexpr bool PERM = false, AFTER_DRAIN = false;
    const float* x; const float* mod; float* out;
    __device__ __forceinline__ void operator()(const f32x4 (&acc)[2][2][4][2], const pg8::Unit& u, int wr, int wc, int fr, int fq) const {
        const int row0 = u.pm * 256 + wr * 64 + fr, col0 = u.pn * 256 + wc * 32 + 4 * fq;
        const int b = (u.pm * 256) / NS;
        f32x4 gv[2][2];
#pragma unroll
        for (int bj = 0; bj < 2; ++bj)
#pragma unroll
            for (int n = 0; n < 2; ++n) gv[bj][n] = *(const f32x4*)(mod + b * 6144 + 2048 + col0 + bj * 128 + n * 16);
#pragma unroll
        for (int ai = 0; ai < 2; ++ai)
#pragma unroll
            for (int m = 0; m < 4; ++m) {
                const size_t ro = (size_t)(row0 + ai * 128 + m * 16) * ND + col0;
#pragma unroll
                for (int bj = 0; bj < 2; ++bj)
#pragma unroll
                    for (int n = 0; n < 2; ++n) *(f32x4*)(out + ro + bj * 128 + n * 16) = *(const f32x4*)(x + ro + bj * 128 + n * 16) + gv[bj][n] * acc[ai][bj][m][n];
            }
    }
};
struct EpiPq8 {
    static constexpr bool PERM = true, AFTER_DRAIN = false;
    bf16_t* pq;
    __device__ __forceinline__ void operator()(const f32x4 (&acc)[2][2][4][2], const pg8::Unit& u, int wr, int wc, int fr, int fq) const {
#pragma unroll
        for (int ai = 0; ai < 2; ++ai)
#pragma unroll
            for (int m = 0; m < 4; ++m)
#pragma unroll
                for (int bj = 0; bj < 2; ++bj) {
                    const f32x4 v0 = acc[ai][bj][m][0], v1 = acc[ai][bj][m][1];
                    u32x4 w; w[0] = pack2(v0[0], v0[1]); w[1] = pack2(v0[2], v0[3]); w[2] = pack2(v1[0], v1[1]); w[3] = pack2(v1[2], v1[3]);
                    *(u32x4*)(pq + (size_t)(u.pm * 256 + ai * 128 + wr * 64 + m * 16 + fr) * 2048 + u.pn * 256 + bj * 128 + wc * 32 + 8 * fq) = w;
                }
    }
};
__device__ __forceinline__ void inproj8_phase(const Params& p, unsigned char* lds) {
    pg8::Gemm g{(const bf16_t*)(p.ws + WS_XN), (const bf16_t*)(p.ws + WS_WIN), MA, NIN, ND};
    InProjOrder S; S.init((int)gridDim.x, (int)blockIdx.x);
    EpiInProj8 E{p.ws};
    pg8::gemm_phase<EpiInProj8, InProjOrder>((PG8_LAS unsigned char*)lds, g, S, E, nullptr);
    const int G = (int)gridDim.x, nidle = G > 80 ? G - 80 : G;
    {
#if PEER_V4
        convert_uv_fp64(p.pu, p.pv, p.ws + WS_U, (unsigned*)(p.ws + WS_CTL) + 65, (int*)lds);
#else
        convert_uv_fp6(p.pu, p.pv, p.ws + WS_U, G > 80 ? (int)blockIdx.x - 80 : (int)blockIdx.x, nidle);
#endif
    }
}
__device__ __forceinline__ void outproj8_phase(const Params& p, unsigned char* lds) {
    pg8::Gemm g{(const bf16_t*)(p.ws + WS_XN), (const bf16_t*)(p.ws + WS_WOUT), MT, ND, ND};
    pg8::StaticOrder S; S.init(MT, ND, (int)gridDim.x, (int)blockIdx.x);
    EpiOutProj8 E{p.x, (const float*)(p.ws + WS_MOD), p.out};
    pg8::gemm_phase<EpiOutProj8, pg8::StaticOrder>((PG8_LAS unsigned char*)lds, g, S, E, nullptr);
}
__device__ __forceinline__ void pq8_phase(const Params& p, unsigned char* lds) {
    pg8::Gemm g{(const bf16_t*)(p.ws + WS_XN), (const bf16_t*)(p.ws + WS_WQ), MT, 2048, ND};
    pg8::StaticOrder S; S.init(MT, 2048, (int)gridDim.x, (int)blockIdx.x);
    EpiPq8 E{(bf16_t*)(p.ws + WS_PQ)};
    pg8::gemm_phase<EpiPq8, pg8::StaticOrder>((PG8_LAS unsigned char*)lds, g, S, E, nullptr);
}


constexpr int NA_KW = 0, NA_VW = 73728, NA_CK = 0, NA_CV = 32768, NA_RPB = 148480, NA_VWS = 1168, NA_CVS = 528;
template <bool WIN>
__device__ __forceinline__ void na3_group(const unsigned char* lds, const float* rpbL, int g, int kbase, int kdelta, int vbase, int bbase, int mlo,
                                          const bf16x8& q0, const bf16x8& q1, f32x4 (&o)[4], float& mx, float& l) {
    f32x4 s[8];
    const unsigned char* kp = lds + kbase + g * (WIN ? 4 * 64 * 128 : 8 * 16 * 128);
#pragma unroll
    for (int tl = 0; tl < 8; ++tl) {
        const int koff = WIN ? (tl >> 1) * 64 * 128 + (tl & 1) * 16 * 128 : tl * 16 * 128;
        const bf16x8 k0 = *(const bf16x8*)(kp + koff), k1 = *(const bf16x8*)(kp + koff + kdelta);
        f32x4 acc = (f32x4){0.f, 0.f, 0.f, 0.f};
        acc = __builtin_amdgcn_mfma_f32_16x16x32_bf16(k0, q0, acc, 0, 0, 0);
        acc = __builtin_amdgcn_mfma_f32_16x16x32_bf16(k1, q1, acc, 0, 0, 0);
        s[tl] = acc;
    }
    if (WIN) {
        const float* bp = rpbL + bbase + g * 4 * 31;
#pragma unroll
        for (int tl = 0; tl < 8; ++tl)
#pragma unroll
            for (int e = 0; e < 4; ++e) {
                const int rel = (tl & 1) * 16 + e;
                const float bias = bp[(tl >> 1) * 31 + rel];
                s[tl][e] = ((unsigned)(rel - mlo) < 16u) ? s[tl][e] + bias : -1e30f;
            }
    }
    float gm = -1e30f;
#pragma unroll
    for (int tl = 0; tl < 8; ++tl) gm = fmaxf(gm, fmaxf(fmaxf(s[tl][0], s[tl][1]), fmaxf(s[tl][2], s[tl][3])));
    gm = fmaxf(gm, __shfl_xor(gm, 16)); gm = fmaxf(gm, __shfl_xor(gm, 32));
    const float mn = fmaxf(mx, gm), sc = __builtin_amdgcn_exp2f(mx - mn);
    mx = mn;
    float ls = 0.f;
#pragma unroll
    for (int tl = 0; tl < 8; ++tl)
#pragma unroll
        for (int e = 0; e < 4; ++e) { const float pe = __builtin_amdgcn_exp2f(s[tl][e] - mn); s[tl][e] = pe; ls += pe; }
    l = l * sc + ls;
#pragma unroll
    for (int mt = 0; mt < 4; ++mt) o[mt] = o[mt] * sc;
    const unsigned char* vp0 = lds + vbase + g * (WIN ? 4 * 128 : 4 * 64);
#pragma unroll
    for (int pl = 0; pl < 4; ++pl) {
        u32x4 pw; pw[0] = pack2(s[2 * pl][0], s[2 * pl][1]); pw[1] = pack2(s[2 * pl][2], s[2 * pl][3]); pw[2] = pack2(s[2 * pl + 1][0], s[2 * pl + 1][1]); pw[3] = pack2(s[2 * pl + 1][2], s[2 * pl + 1][3]);
        const bf16x8 pf = __builtin_bit_cast(bf16x8, pw);
#pragma unroll
        for (int mt = 0; mt < 4; ++mt) {
            const unsigned char* vp = vp0 + mt * 16 * (WIN ? NA_VWS : NA_CVS) + pl * (WIN ? 128 : 64);
            const u32x2 va = *(const u32x2*)vp, vb = *(const u32x2*)(vp + 32);
            u32x4 vw; vw[0] = va[0]; vw[1] = va[1]; vw[2] = vb[0]; vw[3] = vb[1];
            o[mt] = __builtin_amdgcn_mfma_f32_16x16x32_bf16(__builtin_bit_cast(bf16x8, vw), pf, o[mt], 0, 0, 0);
        }
    }
}
__device__ __forceinline__ void na3_phase(const Params& p, unsigned char* lds) {
    const bf16_t* Q = (const bf16_t*)(p.ws + WS_NAQ); const bf16_t* Kk = (const bf16_t*)(p.ws + WS_NAK); const bf16_t* VT = (const bf16_t*)(p.ws + WS_NAV);
    bf16_t* mix = (bf16_t*)(p.ws + WS_XN);
    float* rpbL = (float*)(lds + NA_RPB);
    const int tid = threadIdx.x, lane = tid & 63, wave = tid >> 6, fr = lane & 15, fq = lane >> 4;
    unsigned* ctr = (unsigned*)(p.ws + WS_CTL) + 69; int* slot = (int*)(lds + 150464);
    if (tid == 0) slot[0] = (int)__hip_atomic_fetch_add(ctr, 1u, __ATOMIC_RELAXED, __HIP_MEMORY_SCOPE_AGENT);
    __syncthreads();
    int it = slot[0];
    if (it >= 1024) return;
    const int lch = tid & 7, lrc = tid >> 3;
    u32x4 wk[9], wv[9], ck[4], cv[4];
    int cur_h = -1;
#define NA3_WLOAD(it_) do { const int it__ = (it_); const int bh_ = it__ >> 4, rp_ = it__ & 15, b_ = bh_ >> 3, h_ = bh_ & 7; \
        const int rsA_ = min(max(2 * rp_ - 4, 0), NROWS - 8), rsB_ = min(max(2 * rp_ - 3, 0), NROWS - 8), nr_ = rsB_ + 8 - rsA_; \
        _Pragma("unroll") for (int i = 0; i < 9; ++i) if (i < nr_) { \
            wk[i] = *(const u32x4*)(Kk + ((size_t)b_ * NS + (rsA_ + i) * 64 + lrc) * 512 + h_ * 64 + lch * 8); \
            wv[i] = *(const u32x4*)(VT + ((size_t)((b_ * 8 + h_) * 64 + lrc)) * 2048 + (rsA_ + i) * 64 + lch * 8); } } while (0)
    NA3_WLOAD(it);
    for (;;) {
        const int bh = it >> 4, rp = it & 15, b = bh >> 3, h = bh & 7;
        const int rsA = min(max(2 * rp - 4, 0), NROWS - 8), rsB = min(max(2 * rp - 3, 0), NROWS - 8), nr = rsB + 8 - rsA;
        const int r = 2 * rp + (wave >> 2), cb = wave & 3;
        const int rs = (wave >> 2) ? rsB : rsA, kc0 = min(max(cb * 16 - 8, 0), GW - 32);
        const int qc = cb * 16 + fr, cs = min(max(qc - 8, 0), GW - 16);
        const size_t qtok = (size_t)b * NS + r * 64 + qc;
        __syncthreads();
        if (tid == 0) slot[0] = (int)__hip_atomic_fetch_add(ctr, 1u, __ATOMIC_RELAXED, __HIP_MEMORY_SCOPE_AGENT);
        if (h != cur_h) { for (int i = tid; i < 465; i += NT) rpbL[i] = p.rpb[h * 465 + i] * 1.44269504f; cur_h = h; }
#pragma unroll
        for (int i = 0; i < 9; ++i) if (i < nr) {
            const int key = i * 64 + lrc;
            *(u32x4*)(lds + NA_KW + key * 128 + ((lch ^ (key & 7)) << 4)) = wk[i];
            *(u32x4*)(lds + NA_VW + lrc * NA_VWS + i * 128 + lch * 16) = wv[i];
        }
#pragma unroll
        for (int i = 0; i < 4; ++i) {
            const int c = tid + i * NT;
            ck[i] = *(const u32x4*)(Kk + ((size_t)MT + b * NL + (c >> 3)) * 512 + h * 64 + (c & 7) * 8);
            cv[i] = *(const u32x4*)(VT + (size_t)MT * 512 + ((size_t)((b * 8 + h) * 64 + (c >> 5))) * 256 + (c & 31) * 8);
        }
        const bf16x8 q0 = *(const bf16x8*)(Q + qtok * 512 + h * 64 + fq * 8), q1 = *(const bf16x8*)(Q + qtok * 512 + h * 64 + 32 + fq * 8);
        __syncthreads();
        f32x4 o[4];
#pragma unroll
        for (int mt = 0; mt < 4; ++mt) o[mt] = (f32x4){0.f, 0.f, 0.f, 0.f};
        float mx = -1e30f, l = 0.f;
        const int sw = fr & 7, lrow0 = rs - rsA, kdl = ((fq ^ sw) & 4) ? -64 : 64;
        const int kbW = NA_KW + ((lrow0 * 64 + kc0 + fr) * 128) + ((fq ^ sw) << 4), vbW = NA_VW + fr * NA_VWS + (lrow0 * 64 + kc0 + fq * 4) * 2;
        const int bbW = (rs - r + 7) * 31 + (kc0 + fq * 4 - qc + 15), mlo = cs - kc0 - fq * 4;
#pragma unroll 1
        for (int g = 0; g < 2; ++g) na3_group<true>(lds, rpbL, g, kbW, kdl, vbW, bbW, mlo, q0, q1, o, mx, l);
        __syncthreads();
#pragma unroll
        for (int i = 0; i < 4; ++i) {
            const int c = tid + i * NT;
            const int key = c >> 3;
            *(u32x4*)(lds + NA_CK + key * 128 + (((c & 7) ^ (key & 7)) << 4)) = ck[i];
            *(u32x4*)(lds + NA_CV + (c >> 5) * NA_CVS + (c & 31) * 16) = cv[i];
        }
        const int nxt = slot[0];
        if (nxt < 1024) NA3_WLOAD(nxt);
        __syncthreads();
        const int kbC = NA_CK + fr * 128 + ((fq ^ sw) << 4), vbC = NA_CV + fr * NA_CVS + fq * 8;
#pragma unroll 1
        for (int g = 0; g < 2; ++g) na3_group<false>(lds, rpbL, g, kbC, kdl, vbC, 0, 0, q0, q1, o, mx, l);
        l += __shfl_xor(l, 16); l += __shfl_xor(l, 32);
        const float inv = 1.f / l;
#pragma unroll
        for (int mt = 0; mt < 4; ++mt)
            *(u32x2*)(mix + qtok * ND + h * 64 + mt * 16 + fq * 4) = (u32x2){pack2(o[mt][0] * inv, o[mt][1] * inv), pack2(o[mt][2] * inv, o[mt][3] * inv)};
        if (nxt >= 1024) break;
        it = nxt;
    }
#undef NA3_WLOAD
}


__device__ __forceinline__ int swz8(int row) { return (((row >> 3) & 1) ^ row) & 7; }
constexpr int HG_LDS = 157696;
__device__ __forceinline__ size_t hg_row(int ci, int t, int b, int dir) {
    const bool isctx = ci < 4; const int lc = isctx ? ci : ci - 4, T = isctx ? NL : NS; const size_t base = isctx ? (size_t)MT + b * NL : (size_t)b * NS;
    const int pos = lc * 64 + t; return dir ? base + T - 1 - pos : base + pos;
}
__device__ __forceinline__ void hg_chain(const Params& p, unsigned char* lds, int unit, int seg) {
    const int tid = threadIdx.x, lane = tid & 63, wave = tid >> 6, fr = lane & 15, fq = lane >> 4;
    const int dir = unit & 1, h = (unit >> 1) & 3, b = unit >> 3;
    float* BF = (float*)lds;
    unsigned char* QT = lds + 32768;
    unsigned char* QH = lds + 49152;
    unsigned char* KT = lds + 65536;
    unsigned char* KBT = lds + 81920;
    unsigned char* VT = lds + 98304;
    unsigned char* PP = lds + 114688;
    unsigned char* SB = lds + 122880;
    float* TOT = (float*)(lds + 155648);
    const bf16_t* HQ = (const bf16_t*)(p.ws + WS_HQ); const bf16_t* HIT = (const bf16_t*)(p.ws + WS_HI);
    const bf16_t* Z = (const bf16_t*)(p.ws + (dir ? WS_ZB : WS_ZF));
    float* O = p.out + (size_t)dir * MT * 512;
    const int bt = tid >> 3, bg = tid & 7;
    const int vdv = tid >> 2, vpart = tid & 3;
    int o256[4], o128[2];
#pragma unroll
    for (int kd = 0; kd < 4; ++kd) o256[kd] = fr * 256 + ((((kd * 4 + fq) ^ fr) & 15) << 4);
#pragma unroll
    for (int ks = 0; ks < 2; ++ks) o128[ks] = fr * 128 + ((((ks * 4 + fq) ^ swz8(fr)) & 7) << 4);
    for (int i = tid; i < (8192 + 32768) / 16; i += NT) *(u32x4*)(PP + i * 16) = (u32x4){0u, 0u, 0u, 0u};
    f32x4 accS[8];
#pragma unroll
    for (int i = 0; i < 8; ++i) accS[i] = (f32x4){0.f, 0.f, 0.f, 0.f};
    u32x4 zr[2], qr[2], vr[2];
#define HG_LOAD(ci_) do { const int ci__ = (ci_); const bool cx = ci__ < 4; const size_t r = hg_row(ci__, bt, b, dir); \
        _Pragma("unroll") for (int g = 0; g < 2; ++g) { const size_t o = r * 512 + h * 128 + g * 64 + bg * 8; zr[g] = *(const u32x4*)(Z + o); qr[g] = cx ? (u32x4){0u, 0u, 0u, 0u} : *(const u32x4*)(HQ + o); } \
        const int lc = cx ? ci__ : ci__ - 4, T = cx ? NL : NS; const int tok0 = dir ? T - 64 * (lc + 1) : lc * 64; \
        const bf16_t* vp = cx ? HIT + (size_t)MT * 512 + ((size_t)((b * 4 + h) * 128 + vdv)) * 256 + tok0 + vpart * 16 : HIT + ((size_t)((b * 4 + h) * 128 + vdv)) * 2048 + tok0 + vpart * 16; \
        vr[0] = *(const u32x4*)vp; vr[1] = *(const u32x4*)(vp + 8); } while (0)
    const int cbeg = seg * 18, cend = cbeg + 18;
    bf16_t* QHC = (bf16_t*)(p.ws + WS_QHC) + (size_t)unit * 18 * 64 * 128;
    float* CUM = (float*)(lds + 157696);
    if (tid < 128) CUM[tid] = 0.f;
    HG_LOAD(cbeg);
    __syncthreads();
#pragma unroll 1
    for (int ci = cbeg; ci < cend; ++ci) {
        const bool isctx = ci < 4;
#pragma unroll
        for (int g = 0; g < 2; ++g) {
            *(f32x4*)(BF + bt * 128 + g * 64 + bg * 8) = (f32x4){bflo(zr[g][0]), bfhi(zr[g][0]), bflo(zr[g][1]), bfhi(zr[g][1])};
            *(f32x4*)(BF + bt * 128 + g * 64 + bg * 8 + 4) = (f32x4){bflo(zr[g][2]), bfhi(zr[g][2]), bflo(zr[g][3]), bfhi(zr[g][3])};
            const int pc = vpart * 2 + g;
            u32x4 w = vr[g];
            if (dir) { w = (u32x4){__builtin_amdgcn_alignbit(vr[g][3], vr[g][3], 16), __builtin_amdgcn_alignbit(vr[g][2], vr[g][2], 16), __builtin_amdgcn_alignbit(vr[g][1], vr[g][1], 16), __builtin_amdgcn_alignbit(vr[g][0], vr[g][0], 16)}; }
            *(u32x4*)(VT + vdv * 128 + ((((dir ? 7 - pc : pc) ^ swz8(vdv)) & 7) << 4)) = w;
        }
        __syncthreads();
        {
            const int d = tid & 127, I = tid >> 7;
            float v[16];
#pragma unroll
            for (int j = 0; j < 16; ++j) v[j] = BF[(I * 16 + j) * 128 + d];
#pragma unroll
            for (int j = 1; j < 16; ++j) v[j] += v[j - 1];
#pragma unroll
            for (int j = 0; j < 16; ++j) BF[(I * 16 + j) * 128 + d] = v[j];
            TOT[I * 128 + d] = v[15];
        }
        __syncthreads();
#pragma unroll
        for (int g = 0; g < 2; ++g) {
            const int d0 = g * 64 + bg * 8;
            float bl[8], t0[8], t1[8], t2[8], b31[8], cm[8];
#pragma unroll
            for (int q4 = 0; q4 < 2; ++q4) {
                const f32x4 a = *(const f32x4*)(BF + bt * 128 + d0 + q4 * 4), x0 = *(const f32x4*)(TOT + d0 + q4 * 4), x1 = *(const f32x4*)(TOT + 128 + d0 + q4 * 4),
                            x2 = *(const f32x4*)(TOT + 256 + d0 + q4 * 4), m = *(const f32x4*)(BF + 31 * 128 + d0 + q4 * 4), m63 = *(const f32x4*)(CUM + d0 + q4 * 4);
#pragma unroll
                for (int e = 0; e < 4; ++e) { bl[q4 * 4 + e] = a[e]; t0[q4 * 4 + e] = x0[e]; t1[q4 * 4 + e] = x1[e]; t2[q4 * 4 + e] = x2[e]; b31[q4 * 4 + e] = m[e]; cm[q4 * 4 + e] = m63[e]; }
            }
            const int I = bt >> 4;
            float vq[8], vh[8], vk[8], vc[8];
#pragma unroll
            for (int e = 0; e < 8; ++e) {
                const float off = (I > 0 ? t0[e] : 0.f) + (I > 1 ? t1[e] : 0.f) + (I > 2 ? t2[e] : 0.f);
                const float bte = bl[e] + off, bmid = b31[e] + t0[e];
                const float x = fminf(fmaxf(bte - bmid, -115.f), 115.f);
                const unsigned zw = zr[g][e >> 1], qw = qr[g][e >> 1];
                const float qv = (e & 1) ? bfhi(qw) : bflo(qw), kf = 1.f - __builtin_amdgcn_exp2f((e & 1) ? bfhi(zw) : bflo(zw));
                vq[e] = qv * __builtin_amdgcn_exp2f(x); vh[e] = qv * __builtin_amdgcn_exp2f(bte); vk[e] = kf * __builtin_amdgcn_exp2f(-x);
                vc[e] = qv * __builtin_amdgcn_exp2f(bte + cm[e]);
            }
            if (seg) *(u32x4*)(QHC + ((size_t)(ci - 18) * 64 + bt) * 128 + d0) = (u32x4){pack2(vc[0], vc[1]), pack2(vc[2], vc[3]), pack2(vc[4], vc[5]), pack2(vc[6], vc[7])};
            const int so = bt * 256 + ((((d0 >> 3) ^ bt) & 15) << 4);
            *(u32x4*)(QT + so) = (u32x4){pack2(vq[0], vq[1]), pack2(vq[2], vq[3]), pack2(vq[4], vq[5]), pack2(vq[6], vq[7])};
            *(u32x4*)(QH + so) = (u32x4){pack2(vh[0], vh[1]), pack2(vh[2], vh[3]), pack2(vh[4], vh[5]), pack2(vh[6], vh[7])};
            *(u32x4*)(KT + so) = (u32x4){pack2(vk[0], vk[1]), pack2(vk[2], vk[3]), pack2(vk[4], vk[5]), pack2(vk[6], vk[7])};
        }
        if (ci + 1 < cend) HG_LOAD(ci + 1);
        __syncthreads();
        if (!isctx) {
            for (int n = wave; n < 10; n += 8) {
                const int I = n >= 6 ? 3 : n >= 3 ? 2 : n >= 1 ? 1 : 0, J = n - (I * (I + 1)) / 2;
                f32x4 acc = (f32x4){0.f, 0.f, 0.f, 0.f};
#pragma unroll
                for (int kd = 0; kd < 4; ++kd) acc = __builtin_amdgcn_mfma_f32_16x16x32_bf16(*(const bf16x8*)(KT + J * 4096 + o256[kd]), *(const bf16x8*)(QT + I * 4096 + o256[kd]), acc, 0, 0, 0);
                if (I == J) {
#pragma unroll
                    for (int e = 0; e < 4; ++e) if (fq * 4 + e > fr) acc[e] = 0.f;
                }
                const int t = I * 16 + fr;
                *(u32x2*)(PP + t * 128 + ((((J * 2 + (fq >> 1)) ^ swz8(t)) & 7) << 4) + (fq & 1) * 8) = (u32x2){pack2(acc[0], acc[1]), pack2(acc[2], acc[3])};
            }
        }
        {
            const int d = tid & 127, sg = tid >> 7;
            const float c2 = __builtin_amdgcn_exp2f(BF[63 * 128 + d] + TOT[128 + d] + TOT[256 + d] - BF[31 * 128 + d]);
            if (sg == 0) CUM[d] += BF[63 * 128 + d] + TOT[d] + TOT[128 + d] + TOT[256 + d];
            const unsigned char* kp = KT + sg * 4096 + (d & 7) * 2; const int dh = d >> 3;
            float kv[16];
#pragma unroll
            for (int j = 0; j < 16; ++j) kv[j] = bf2f(*(const bf16_t*)(kp + j * 256 + (((dh ^ j) & 15) << 4))) * c2;
            const int sw = swz8(d);
            *(u32x4*)(KBT + d * 128 + ((((sg * 2) ^ sw) & 7) << 4)) = (u32x4){pack2(kv[0], kv[1]), pack2(kv[2], kv[3]), pack2(kv[4], kv[5]), pack2(kv[6], kv[7])};
            *(u32x4*)(KBT + d * 128 + ((((sg * 2 + 1) ^ sw) & 7) << 4)) = (u32x4){pack2(kv[8], kv[9]), pack2(kv[10], kv[11]), pack2(kv[12], kv[13]), pack2(kv[14], kv[15])};
        }
        __syncthreads();
        if (!isctx) {
            f32x4 acc[4];
#pragma unroll
            for (int tt = 0; tt < 4; ++tt) acc[tt] = (f32x4){0.f, 0.f, 0.f, 0.f};
#pragma unroll
            for (int kd = 0; kd < 4; ++kd) {
                const bf16x8 a = *(const bf16x8*)(SB + wave * 4096 + o256[kd]);
#pragma unroll
                for (int tt = 0; tt < 4; ++tt) acc[tt] = __builtin_amdgcn_mfma_f32_16x16x32_bf16(a, *(const bf16x8*)(QH + tt * 4096 + o256[kd]), acc[tt], 0, 0, 0);
            }
#pragma unroll
            for (int ks = 0; ks < 2; ++ks) {
                const bf16x8 a = *(const bf16x8*)(VT + wave * 2048 + o128[ks]);
#pragma unroll
                for (int tt = 0; tt < 4; ++tt) acc[tt] = __builtin_amdgcn_mfma_f32_16x16x32_bf16(a, *(const bf16x8*)(PP + tt * 2048 + o128[ks]), acc[tt], 0, 0, 0);
            }
#pragma unroll
            for (int tt = 0; tt < 4; ++tt) *(f32x4*)(O + hg_row(ci, tt * 16 + fr, b, dir) * 512 + h * 128 + wave * 16 + fq * 4) = acc[tt];
        }
        {
            const int d4 = wave * 16 + fq * 4;
            const f32x4 l63 = *(const f32x4*)(BF + 63 * 128 + d4), x0 = *(const f32x4*)(TOT + d4), x1 = *(const f32x4*)(TOT + 128 + d4), x2 = *(const f32x4*)(TOT + 256 + d4);
            f32x4 c3;
#pragma unroll
            for (int e = 0; e < 4; ++e) c3[e] = __builtin_amdgcn_exp2f(l63[e] + x0[e] + x1[e] + x2[e]);
            const bf16x8 a0 = *(const bf16x8*)(KBT + wave * 2048 + o128[0]), a1 = *(const bf16x8*)(KBT + wave * 2048 + o128[1]);
#pragma unroll
            for (int vt = 0; vt < 8; ++vt) {
                accS[vt] = accS[vt] * c3;
                accS[vt] = __builtin_amdgcn_mfma_f32_16x16x32_bf16(a0, *(const bf16x8*)(VT + vt * 2048 + o128[0]), accS[vt], 0, 0, 0);
                accS[vt] = __builtin_amdgcn_mfma_f32_16x16x32_bf16(a1, *(const bf16x8*)(VT + vt * 2048 + o128[1]), accS[vt], 0, 0, 0);
            }
        }
        __syncthreads();
#pragma unroll
        for (int vt = 0; vt < 8; ++vt)
            *(u32x2*)(SB + vt * 4096 + fr * 256 + ((((wave * 2 + (fq >> 1)) ^ fr) & 15) << 4) + (fq & 1) * 8) = (u32x2){pack2(accS[vt][0], accS[vt][1]), pack2(accS[vt][2], accS[vt][3])};
    }
#undef HG_LOAD
    if (!seg) {
        bf16_t* S0 = (bf16_t*)(p.ws + WS_S0T) + (size_t)unit * 128 * 128;
#pragma unroll
        for (int vt = 0; vt < 8; ++vt) *(u32x2*)(S0 + (size_t)(vt * 16 + fr) * 128 + wave * 16 + fq * 4) = (u32x2){pack2(accS[vt][0], accS[vt][1]), pack2(accS[vt][2], accS[vt][3])};
    }
    __syncthreads();
}
__device__ __forceinline__ void hg_corr_phase(const Params& p) {
    const int tid = threadIdx.x, lane = tid & 63, wave = tid >> 6, fr = lane & 15, fq = lane >> 4;
    for (int u = blockIdx.x; u < 64 * 18; u += gridDim.x) {
        const int chain = u / 18, cc = u % 18, dir = chain & 1, h = (chain >> 1) & 3, b = chain >> 3;
        const bf16_t* S0 = (const bf16_t*)(p.ws + WS_S0T) + (size_t)chain * 128 * 128;
        const bf16_t* QH = (const bf16_t*)(p.ws + WS_QHC) + ((size_t)chain * 18 + cc) * 64 * 128;
        float* O = p.out + (size_t)dir * MT * 512;
        f32x4 acc[4];
#pragma unroll
        for (int tt = 0; tt < 4; ++tt) acc[tt] = (f32x4){0.f, 0.f, 0.f, 0.f};
#pragma unroll
        for (int kd = 0; kd < 4; ++kd) {
            const bf16x8 a = *(const bf16x8*)(S0 + (size_t)(wave * 16 + fr) * 128 + kd * 32 + fq * 8);
#pragma unroll
            for (int tt = 0; tt < 4; ++tt) acc[tt] = __builtin_amdgcn_mfma_f32_16x16x32_bf16(a, *(const bf16x8*)(QH + (size_t)(tt * 16 + fr) * 128 + kd * 32 + fq * 8), acc[tt], 0, 0, 0);
        }
#pragma unroll
        for (int tt = 0; tt < 4; ++tt) { float* op = O + hg_row(18 + cc, tt * 16 + fr, b, dir) * 512 + h * 128 + wave * 16 + fq * 4; *(f32x4*)op = *(const f32x4*)op + acc[tt]; }
    }
}
__device__ __forceinline__ void hg_chunk_phase(const Params& p, unsigned char* lds) {
    for (int unit = blockIdx.x; unit < 128; unit += gridDim.x) hg_chain(p, lds, unit >> 1, unit & 1);
}

__device__ __forceinline__ void hgmix_phase(const Params& p) {
    const float* OF = p.out; const float* OB = p.out + (size_t)MT * 512;
    const bf16_t* HG = (const bf16_t*)(p.ws + WS_HG);
    bf16_t* mix = (bf16_t*)(p.ws + WS_XN);
    const int tid = threadIdx.x, lane = tid & 63, wave = tid >> 6;
    for (int row = blockIdx.x * 8 + wave; row < MT; row += gridDim.x * 8) {
        const int c0 = lane * 8;
        float o[8]; float ss = 0.f;
        const f32x4 a0 = *(const f32x4*)(OF + (size_t)row * 512 + c0), a1 = *(const f32x4*)(OF + (size_t)row * 512 + c0 + 4);
        const f32x4 b0 = *(const f32x4*)(OB + (size_t)row * 512 + c0), b1 = *(const f32x4*)(OB + (size_t)row * 512 + c0 + 4);
#pragma unroll
        for (int e = 0; e < 4; ++e) { o[e] = a0[e] + b0[e]; o[4 + e] = a1[e] + b1[e]; }
#pragma unroll
        for (int e = 0; e < 8; ++e) ss += o[e] * o[e];
        ss += __shfl_xor(ss, 1); ss += __shfl_xor(ss, 2); ss += __shfl_xor(ss, 4); ss += __shfl_xor(ss, 8);
        const float rstd = rsqrtf(ss * (1.f / 128.f) + EPS);
        const u32x4 gw = *(const u32x4*)(HG + (size_t)row * 512 + c0);
        float r[8];
#pragma unroll
        for (int e = 0; e < 4; ++e) { r[e * 2] = o[e * 2] * rstd * p.hg_norm[c0 + e * 2] * bflo(gw[e]); r[e * 2 + 1] = o[e * 2 + 1] * rstd * p.hg_norm[c0 + e * 2 + 1] * bfhi(gw[e]); }
        u32x4 w; w[0] = pack2(r[0], r[1]); w[1] = pack2(r[2], r[3]); w[2] = pack2(r[4], r[5]); w[3] = pack2(r[6], r[7]);
        *(u32x4*)(mix + (size_t)row * ND + 512 + c0) = w;
    }
}

__device__ __forceinline__ unsigned ukey(float f) { const unsigned u = __float_as_uint(f); return (u & 0x80000000u) ? ~u : (u | 0x80000000u); }
__device__ __forceinline__ float ukey_inv(unsigned u) { return __uint_as_float((u & 0x80000000u) ? (u & 0x7fffffffu) : ~u); }
__device__ __forceinline__ int mbcnt64(unsigned long long m) { return (int)__builtin_amdgcn_mbcnt_hi((unsigned)(m >> 32), __builtin_amdgcn_mbcnt_lo((unsigned)m, 0u)); }

__device__ __forceinline__ void bsort16(unsigned (&a)[16]) {
#pragma unroll
    for (int k = 2; k <= 16; k <<= 1)
#pragma unroll
        for (int j = k >> 1; j > 0; j >>= 1)
#pragma unroll
            for (int i = 0; i < 16; ++i) {
                const int l = i ^ j;
                if (l > i) { const unsigned hi = max(a[i], a[l]), lo = min(a[i], a[l]); if ((i & k) == 0) { a[i] = hi; a[l] = lo; } else { a[i] = lo; a[l] = hi; } }
            }
}
__device__ __forceinline__ void bmerge16(unsigned (&a)[16], const unsigned (&b)[16]) {
#pragma unroll
    for (int i = 0; i < 16; ++i) a[i] = max(a[i], b[15 - i]);
#pragma unroll
    for (int j = 8; j > 0; j >>= 1)
#pragma unroll
        for (int i = 0; i < 16; ++i) { const int l = i ^ j; if (l > i) { const unsigned hi = max(a[i], a[l]), lo = min(a[i], a[l]); a[i] = hi; a[l] = lo; } }
}
__device__ __forceinline__ void topk3_phase(const Params& p, float* lds) {
    constexpr int LDW = 260;
    const bf16_t* PQ = (const bf16_t*)(p.ws + WS_PQ); const bf16_t* KEYS = (const bf16_t*)(p.ws + WS_KEYS);
    int* PIDX = (int*)(p.ws + WS_PIDX); float* PG = (float*)(p.ws + WS_PG);
    int* tab = (int*)(lds + 128 * LDW);
    const int tid = threadIdx.x, lane = tid & 63, wave = tid >> 6, fr = lane & 15, fq = lane >> 4;
    for (int unit_ = 0; unit_ < ((MT / 64 + (int)gridDim.x - 1) / (int)gridDim.x) * 4; ++unit_) {
        const int hp2 = unit_ & 3, tb = (int)blockIdx.x + (unit_ >> 2) * (int)gridDim.x, t0 = tb * 64;
        if (tb >= MT / 64) break;
        {
            const int hs = wave >> 2, c = (wave >> 1) & 1, kb = (wave & 1) * 64, hp = hp2 * 2 + hs;
            f32x4 acc[4][4];
#pragma unroll
            for (int i = 0; i < 4; ++i)
#pragma unroll
                for (int j = 0; j < 4; ++j) acc[i][j] = (f32x4){0.f, 0.f, 0.f, 0.f};
#pragma unroll
            for (int ks = 0; ks < 4; ++ks) {
                bf16x8 fa[4], fb[4];
#pragma unroll
                for (int i = 0; i < 4; ++i) fa[i] = *(const bf16x8*)(PQ + (size_t)(t0 + i * 16 + fr) * 2048 + hp * 256 + c * 128 + ks * 32 + fq * 8);
#pragma unroll
                for (int j = 0; j < 4; ++j) fb[j] = *(const bf16x8*)(KEYS + (size_t)((hp * 2 + c) * 128 + kb + j * 16 + fr) * 128 + ks * 32 + fq * 8);
#pragma unroll
                for (int i = 0; i < 4; ++i)
#pragma unroll
                    for (int j = 0; j < 4; ++j) acc[i][j] = __builtin_amdgcn_mfma_f32_16x16x32_bf16(fa[i], fb[j], acc[i][j], 0, 0, 0);
            }
#pragma unroll
            for (int i = 0; i < 4; ++i)
#pragma unroll
                for (int j = 0; j < 4; ++j)
#pragma unroll
                    for (int e = 0; e < 4; ++e) lds[(hs * 64 + i * 16 + fq * 4 + e) * LDW + (c * 2 + (wave & 1)) * 65 + j * 16 + fr] = acc[i][j][e];
        }
        __syncthreads();
        {
            const int task = tid >> 2, q = tid & 3;
            const float* row = lds + task * LDW + q * 65;
            unsigned t[16], o[16];
            {
                unsigned t1[16], t2[16], t3[16];
#pragma unroll
                for (int i = 0; i < 16; ++i) {
                    t[i] = (ukey(row[i]) & ~127u) | (unsigned)(127 - ((q & 1) * 64 + i));
                    t1[i] = (ukey(row[16 + i]) & ~127u) | (unsigned)(127 - ((q & 1) * 64 + 16 + i));
                    t2[i] = (ukey(row[32 + i]) & ~127u) | (unsigned)(127 - ((q & 1) * 64 + 32 + i));
                    t3[i] = (ukey(row[48 + i]) & ~127u) | (unsigned)(127 - ((q & 1) * 64 + 48 + i));
                }
                bsort16(t); bsort16(t1); bsort16(t2); bsort16(t3);
                bmerge16(t, t1); bmerge16(t2, t3); bmerge16(t, t2);
            }
#pragma unroll
            for (int k = 0; k < 16; ++k) o[k] = (unsigned)__shfl_xor((int)t[k], 1);
            bmerge16(t, o);
#pragma unroll
            for (int k = 0; k < 16; ++k) o[k] = (unsigned)__shfl_xor((int)t[k], 2);
            float v1[16], v2[16];
#pragma unroll
            for (int k = 0; k < 16; ++k) {
                const unsigned s1 = (q & 2) ? o[k] : t[k], s2 = (q & 2) ? t[k] : o[k];
                v1[k] = ukey_inv(s1 & ~127u); v2[k] = ukey_inv(s2 & ~127u);
                if ((k & 3) == q) { tab[task * 32 + k] = 127 - (int)(s1 & 127u); tab[task * 32 + 16 + k] = 127 - (int)(s2 & 127u); }
            }
#define CKEY(i, j) ((ukey(v1[i] + v2[j]) & ~255u) | (unsigned)(255 - ((i) * 16 + (j))))
            unsigned cd[16], cb[16], cc[16], ce[16];
#pragma unroll
            for (int j = 0; j < 16; ++j) cd[j] = CKEY(0, j);
#pragma unroll
            for (int j = 0; j < 8; ++j) cb[j] = CKEY(1, j);
#pragma unroll
            for (int j = 0; j < 5; ++j) cb[8 + j] = CKEY(2, j);
#pragma unroll
            for (int j = 0; j < 3; ++j) cb[13 + j] = CKEY(4, j);
#pragma unroll
            for (int j = 0; j < 4; ++j) cc[j] = CKEY(3, j);
#pragma unroll
            for (int i = 5; i < 8; ++i) { cc[4 + (i - 5) * 2] = CKEY(i, 0); cc[5 + (i - 5) * 2] = CKEY(i, 1); }
#pragma unroll
            for (int i = 8; i < 14; ++i) cc[10 + (i - 8)] = CKEY(i, 0);
            ce[0] = CKEY(14, 0); ce[1] = CKEY(15, 0);
#pragma unroll
            for (int j = 2; j < 16; ++j) ce[j] = 0u;
#undef CKEY
            bsort16(cb); bsort16(cc);
            { const unsigned hi = max(ce[0], ce[1]), lo = min(ce[0], ce[1]); ce[0] = hi; ce[1] = lo; }
            bmerge16(cd, cb); bmerge16(cc, ce); bmerge16(cd, cc);
            const float vmax = ukey_inv(cd[0] & ~255u);
            float es = 0.f;
#pragma unroll
            for (int k = 0; k < 16; ++k) es += __expf(ukey_inv(cd[k] & ~255u) - vmax);
            const float inv = 1.f / es;
            const size_t ob = ((size_t)(t0 + (task & 63)) * 8 + hp2 * 2 + (task >> 6)) * 16 + q * 4;
#pragma unroll
            for (int e = 0; e < 4; ++e) {
                const unsigned key = q == 0 ? cd[e] : q == 1 ? cd[4 + e] : q == 2 ? cd[8 + e] : cd[12 + e];
                const int pos = 255 - (int)(key & 255u);
                PIDX[ob + e] = tab[task * 32 + (pos >> 4)] * 128 + tab[task * 32 + 16 + (pos & 15)];
                PG[ob + e] = __expf(ukey_inv(key & ~255u) - vmax) * inv;
            }
        }
        __syncthreads();
    }
}


typedef float f32x2 __attribute__((ext_vector_type(2)));
typedef float f32x32 __attribute__((ext_vector_type(32)));
typedef unsigned u32x6 __attribute__((ext_vector_type(6)));
typedef unsigned u32x3 __attribute__((ext_vector_type(3)));
__device__ __forceinline__ u32x6 ld24(const unsigned char* p) { const u32x3 a = *(const u32x3*)p, b = *(const u32x3*)(p + 12); return (u32x6){a[0], a[1], a[2], b[0], b[1], b[2]}; }

__device__ __forceinline__ void g8_batch(u32x6 (&ru)[4], u32x6 (&rv)[4], const unsigned char* UV, const int* Lidx, const float* Lw, int j0, int jr, int jv, int lane, int hl,
                                         const unsigned (&hp)[16], f32x2 (&acc)[16]) {
    float d[4];
#pragma unroll
    for (int j = 0; j < 4; ++j) {
        const f32x32 x = __builtin_amdgcn_cvt_scalef32_pk32_f32_fp6(ru[j], 1.0f);
        f32x2 s = (f32x2){0.f, 0.f};
#pragma unroll
        for (int k = 0; k < 16; ++k) s = __builtin_elementwise_fma((f32x2){x[2 * k], x[2 * k + 1]}, (f32x2){bflo(hp[k]), bfhi(hp[k])}, s);
        d[j] = s.x + s.y;
        ru[j] = ld24(UV + (size_t)Lidx[jr + j] * 1536 + hl * 24);
        __builtin_amdgcn_sched_barrier(0);
    }
    float r2[2], r1;
#pragma unroll
    for (int j = 0; j < 2; ++j) { const float keep = (hl & 16) ? d[j + 2] : d[j], send = (hl & 16) ? d[j] : d[j + 2]; r2[j] = keep + __shfl_xor(send, 16); }
    { const float keep = (hl & 8) ? r2[1] : r2[0], send = (hl & 8) ? r2[0] : r2[1]; r1 = keep + __shfl_xor(send, 8); }
    r1 += __shfl_xor(r1, 4); r1 += __shfl_xor(r1, 2); r1 += __shfl_xor(r1, 1);
    const float xg = r1 * (1.f / 64.f);
    const float wq = Lw[j0 + (hl >> 3)] * (0.5f * xg * (1.f + erff(xg * 0.70710678118654752f))) * (1.f / 5.5f);
#pragma unroll
    for (int j = 0; j < 4; ++j) {
        const float wj = __shfl(wq, (lane & 32) | (j * 8));
        const f32x2 w2 = (f32x2){wj, wj};
        const f32x32 x = __builtin_amdgcn_cvt_scalef32_pk32_f32_fp6(rv[j], 1.0f);
#pragma unroll
        for (int k = 0; k < 16; ++k) acc[k] = __builtin_elementwise_fma((f32x2){x[2 * k], x[2 * k + 1]}, w2, acc[k]);
        rv[j] = ld24(UV + (size_t)Lidx[jv + j] * 1536 + hl * 24 + 768);
        __builtin_amdgcn_sched_barrier(0);
    }
}
__device__ __forceinline__ void gather8_phase(const Params& p, unsigned char* lds, float* outp) {
    const unsigned char* UV = p.ws + WS_U; const bf16_t* H2 = (const bf16_t*)(p.ws + WS_XN);
    const int* PIDX = (const int*)(p.ws + WS_PIDX); const float* PG = (const float*)(p.ws + WS_PG);
    const float* mod = (const float*)(p.ws + WS_MOD);
    const int tid = threadIdx.x, lane = tid & 63, wave = tid >> 6, half = lane >> 5, hl = lane & 31;
    unsigned char* wl = lds + wave * 2560 + half * 1280;
    int* Lidx = (int*)wl; float* Lw = (float*)(wl + 512); int* cnt = (int*)(wl + 1024);
    for (int pass_ = 0; pass_ < ((MT / 64 + (int)gridDim.x - 1) / (int)gridDim.x) * 4; ++pass_) {
        const int tb = (int)blockIdx.x + (pass_ >> 2) * (int)gridDim.x;
        if (tb >= MT / 64) break;
        const int tok = tb * 64 + (pass_ & 3) * 16 + wave * 2 + half;
        cnt[hl] = 0; cnt[32 + hl] = 0;
        int ei[4]; float ew[4]; int pib[4];
#pragma unroll
        for (int s = 0; s < 4; ++s) { ei[s] = PIDX[(size_t)tok * 128 + s * 32 + hl]; ew[s] = PG[(size_t)tok * 128 + s * 32 + hl]; }
#pragma unroll
        for (int s = 0; s < 4; ++s) pib[s] = atomicAdd(&cnt[ei[s] >> 8], 1);
        {
            const int c0 = cnt[2 * hl], c1 = cnt[2 * hl + 1]; int x = c0 + c1;
#pragma unroll
            for (int off = 1; off < 32; off <<= 1) { const int y = __shfl_up(x, off, 32); if (hl >= off) x += y; }
            const int ex = x - c0 - c1;
            cnt[2 * hl] = ex; cnt[2 * hl + 1] = ex + c0;
        }
#pragma unroll
        for (int s = 0; s < 4; ++s) { const int pos = cnt[ei[s] >> 8] + pib[s]; Lidx[pos] = ei[s]; Lw[pos] = ew[s]; }
        unsigned hp[16]; f32x2 acc[16];
        {
            const bf16_t* hq = H2 + (size_t)tok * ND + hl * 32;
#pragma unroll
            for (int q = 0; q < 4; ++q) { const u32x4 a = *(const u32x4*)(hq + q * 8);
#pragma unroll
                for (int e = 0; e < 4; ++e) { hp[q * 4 + e] = a[e]; acc[q * 4 + e] = (f32x2){0.f, 0.f}; } }
        }
        u32x6 ruA[4], ruB[4], rv[4];
#pragma unroll
        for (int j = 0; j < 4; ++j) {
            const unsigned char* ra = UV + (size_t)Lidx[j] * 1536 + hl * 24; ruA[j] = ld24(ra); rv[j] = ld24(ra + 768);
            const unsigned char* rb = UV + (size_t)Lidx[4 + j] * 1536 + hl * 24; ruB[j] = ld24(rb);
        }
#pragma unroll 1
        for (int j0 = 0; j0 < 128; j0 += 8) {
            g8_batch(ruA, rv, UV, Lidx, Lw, j0, min(j0 + 8, 124), j0 + 4, lane, hl, hp, acc);
            g8_batch(ruB, rv, UV, Lidx, Lw, j0 + 4, min(j0 + 12, 124), min(j0 + 8, 124), lane, hl, hp, acc);
        }
        {
            const int b = tok / NS;
            const float* xo = p.out + (size_t)tok * ND + hl * 32; float* yo = outp + (size_t)tok * ND + hl * 32; const float* g2 = mod + b * 6144 + 5120 + hl * 32; const float* nf = p.norm_f + hl * 32;
            f32x4 y[8]; float ss = 0.f;
#pragma unroll
            for (int q = 0; q < 8; ++q) {
                const f32x4 xv = *(const f32x4*)(xo + q * 4), gv = *(const f32x4*)(g2 + q * 4);
                y[q] = xv + gv * (f32x4){acc[2 * q].x, acc[2 * q].y, acc[2 * q + 1].x, acc[2 * q + 1].y};
                ss += y[q][0] * y[q][0] + y[q][1] * y[q][1] + y[q][2] * y[q][2] + y[q][3] * y[q][3];
            }
            ss += __shfl_xor(ss, 16); ss += __shfl_xor(ss, 8); ss += __shfl_xor(ss, 4); ss += __shfl_xor(ss, 2); ss += __shfl_xor(ss, 1);
            const float rstd = rsqrtf(ss * (1.f / ND) + EPS);
#pragma unroll
            for (int q = 0; q < 8; ++q) *(f32x4*)(yo + q * 4) = y[q] * rstd * *(const f32x4*)(nf + q * 4);
        }
    }
}

__device__ __forceinline__ void g9_batch(u32x6 (&ru)[4], u32x4 (&rv)[4], const unsigned char* UV, const int* Lidx, const float* Lw, int j0, int jr, int jv, int lane, int hl,
                                         const unsigned (&hp)[16], f32x2 (&acc)[16]) {
    float d[4];
#pragma unroll
    for (int j = 0; j < 4; ++j) {
        const f32x32 x = __builtin_amdgcn_cvt_scalef32_pk32_f32_fp6(ru[j], 1.0f);
        f32x2 s = (f32x2){0.f, 0.f};
#pragma unroll
        for (int k = 0; k < 16; ++k) s = __builtin_elementwise_fma((f32x2){x[2 * k], x[2 * k + 1]}, (f32x2){bflo(hp[k]), bfhi(hp[k])}, s);
        d[j] = s.x + s.y;
        ru[j] = ld24(UV + (size_t)Lidx[jr + j] * 1280 + hl * 24);
        __builtin_amdgcn_sched_barrier(0);
    }
    float r2[2], r1;
#pragma unroll
    for (int j = 0; j < 2; ++j) { const float keep = (hl & 16) ? d[j + 2] : d[j], send = (hl & 16) ? d[j] : d[j + 2]; r2[j] = keep + __shfl_xor(send, 16); }
    { const float keep = (hl & 8) ? r2[1] : r2[0], send = (hl & 8) ? r2[0] : r2[1]; r1 = keep + __shfl_xor(send, 8); }
    r1 += __shfl_xor(r1, 4); r1 += __shfl_xor(r1, 2); r1 += __shfl_xor(r1, 1);
    const float xg = r1 * (1.f / 64.f);
    const float wq = Lw[j0 + (hl >> 3)] * (0.5f * xg * (1.f + erff(xg * 0.70710678118654752f))) * (1.f / 7.f);
#pragma unroll
    for (int j = 0; j < 4; ++j) {
        const float wj = __shfl(wq, (lane & 32) | (j * 8));
        const f32x2 w2 = (f32x2){wj, wj};
#pragma unroll
        for (int k = 0; k < 16; ++k) {
            f32x2 y;
            if ((k & 3) == 0) y = __builtin_amdgcn_cvt_scalef32_pk_f32_fp4(rv[j][k >> 2], 1.0f, 0);
            else if ((k & 3) == 1) y = __builtin_amdgcn_cvt_scalef32_pk_f32_fp4(rv[j][k >> 2], 1.0f, 1);
            else if ((k & 3) == 2) y = __builtin_amdgcn_cvt_scalef32_pk_f32_fp4(rv[j][k >> 2], 1.0f, 2);
            else y = __builtin_amdgcn_cvt_scalef32_pk_f32_fp4(rv[j][k >> 2], 1.0f, 3);
            acc[k] = __builtin_elementwise_fma(y, w2, acc[k]);
        }
        rv[j] = *(const u32x4*)(UV + (size_t)Lidx[jv + j] * 1280 + 768 + hl * 16);
        __builtin_amdgcn_sched_barrier(0);
    }
}
__device__ __forceinline__ void gather9_phase(const Params& p, unsigned char* lds, float* outp) {
    const unsigned char* UV = p.ws + WS_U; const bf16_t* H2 = (const bf16_t*)(p.ws + WS_XN);
    const int* PIDX = (const int*)(p.ws + WS_PIDX); const float* PG = (const float*)(p.ws + WS_PG);
    const float* mod = (const float*)(p.ws + WS_MOD);
    const int tid = threadIdx.x, lane = tid & 63, wave = tid >> 6, half = lane >> 5, hl = lane & 31;
    unsigned char* wl = lds + wave * 2560 + half * 1280;
    int* Lidx = (int*)wl; float* Lw = (float*)(wl + 512); int* cnt = (int*)(wl + 1024);
    for (int pass_ = 0; pass_ < ((MT / 64 + (int)gridDim.x - 1) / (int)gridDim.x) * 4; ++pass_) {
        const int tb = (int)blockIdx.x + (pass_ >> 2) * (int)gridDim.x;
        if (tb >= MT / 64) break;
        const int tok = tb * 64 + (pass_ & 3) * 16 + wave * 2 + half;
        cnt[hl] = 0; cnt[32 + hl] = 0;
        int ei[4]; float ew[4]; int pib[4];
#pragma unroll
        for (int s = 0; s < 4; ++s) { ei[s] = PIDX[(size_t)tok * 128 + s * 32 + hl]; ew[s] = PG[(size_t)tok * 128 + s * 32 + hl]; }
#pragma unroll
        for (int s = 0; s < 4; ++s) pib[s] = atomicAdd(&cnt[ei[s] >> 8], 1);
        {
            const int c0 = cnt[2 * hl], c1 = cnt[2 * hl + 1]; int x = c0 + c1;
#pragma unroll
            for (int off = 1; off < 32; off <<= 1) { const int y = __shfl_up(x, off, 32); if (hl >= off) x += y; }
            const int ex = x - c0 - c1;
            cnt[2 * hl] = ex; cnt[2 * hl + 1] = ex + c0;
        }
#pragma unroll
        for (int s = 0; s < 4; ++s) { const int pos = cnt[ei[s] >> 8] + pib[s]; Lidx[pos] = ei[s]; Lw[pos] = ew[s]; }
        unsigned hp[16]; f32x2 acc[16];
        {
            const bf16_t* hq = H2 + (size_t)tok * ND + hl * 32;
#pragma unroll
            for (int q = 0; q < 4; ++q) { const u32x4 a = *(const u32x4*)(hq + q * 8);
#pragma unroll
                for (int e = 0; e < 4; ++e) { hp[q * 4 + e] = a[e]; acc[q * 4 + e] = (f32x2){0.f, 0.f}; } }
        }
        u32x6 ruA[4], ruB[4]; u32x4 rvA[4], rvB[4];
#pragma unroll
        for (int j = 0; j < 4; ++j) {
            const unsigned char* ra = UV + (size_t)Lidx[j] * 1280; ruA[j] = ld24(ra + hl * 24); rvA[j] = *(const u32x4*)(ra + 768 + hl * 16);
            const unsigned char* rb = UV + (size_t)Lidx[4 + j] * 1280; ruB[j] = ld24(rb + hl * 24); rvB[j] = *(const u32x4*)(rb + 768 + hl * 16);
        }
#pragma unroll 1
        for (int j0 = 0; j0 < 128; j0 += 8) {
            g9_batch(ruA, rvA, UV, Lidx, Lw, j0, min(j0 + 8, 124), min(j0 + 8, 124), lane, hl, hp, acc);
            g9_batch(ruB, rvB, UV, Lidx, Lw, j0 + 4, min(j0 + 12, 124), min(j0 + 12, 124), lane, hl, hp, acc);
        }
        {
            const int b = tok / NS;
            const float* xo = p.out + (size_t)tok * ND + hl * 32; float* yo = outp + (size_t)tok * ND + hl * 32; const float* g2 = mod + b * 6144 + 5120 + hl * 32; const float* nf = p.norm_f + hl * 32;
            f32x4 y[8]; float ss = 0.f;
#pragma unroll
            for (int q = 0; q < 8; ++q) {
                const f32x4 xv = *(const f32x4*)(xo + q * 4), gv = *(const f32x4*)(g2 + q * 4);
                y[q] = xv + gv * (f32x4){acc[2 * q].x, acc[2 * q].y, acc[2 * q + 1].x, acc[2 * q + 1].y};
                ss += y[q][0] * y[q][0] + y[q][1] * y[q][1] + y[q][2] * y[q][2] + y[q][3] * y[q][3];
            }
            ss += __shfl_xor(ss, 16); ss += __shfl_xor(ss, 8); ss += __shfl_xor(ss, 4); ss += __shfl_xor(ss, 2); ss += __shfl_xor(ss, 1);
            const float rstd = rsqrtf(ss * (1.f / ND) + EPS);
#pragma unroll
            for (int q = 0; q < 8; ++q) *(f32x4*)(yo + q * 4) = y[q] * rstd * *(const f32x4*)(nf + q * 4);
        }
    }
}

#define XB_TMO      128
#define XB_XCNT(j)  (256  + 64 * (j))
#define XB_XSUB(j)  (1280 + 64 * (j))
#define XB_XGEN(j)  (2304 + 64 * (j))
#define XB_TOP      3328
#define XB_TOPGEN   3392
#define XCD_BAR_WORDS 3456
#define XB_SPIN_CAP (1u << 18)
#define LAS __attribute__((address_space(3)))
__device__ __forceinline__ unsigned xb_ld(unsigned* p)              { return __hip_atomic_load(p, __ATOMIC_RELAXED, __HIP_MEMORY_SCOPE_AGENT); }
__device__ __forceinline__ unsigned xb_add(unsigned* p, unsigned v) { return __hip_atomic_fetch_add(p, v, __ATOMIC_RELAXED, __HIP_MEMORY_SCOPE_AGENT); }
__device__ __forceinline__ unsigned xb_xcc_id() { return (unsigned)__builtin_amdgcn_s_getreg((3 << 11) | 20) & 0xFu; }
#define XB_SPIN(cond, bar) do { unsigned _sp = 0; while (cond) { __builtin_amdgcn_s_sleep(1); \
    if ((++_sp & 255u) == 0u) { if (xb_ld(&(bar)[XB_TMO])) break; if (_sp > XB_SPIN_CAP) { atomicAdd(&(bar)[XB_TMO], 1u); break; } } } } while (0)
struct XcdBarrier { unsigned* bar; unsigned x; volatile LAS unsigned* st; };
__device__ __forceinline__ XcdBarrier xcd_barrier_post(unsigned* bar, volatile LAS unsigned* st) {
    XcdBarrier b; b.bar = bar; b.x = xb_xcc_id(); b.st = st;
    if (threadIdx.x == 0) (void)xb_add(&bar[XB_XCNT(b.x)], 1u);
    return b;
}
__device__ __forceinline__ void xcd_barrier_complete(unsigned* bar, unsigned x, unsigned& nloc, unsigned& nx) {
    const unsigned G = gridDim.x * gridDim.y * gridDim.z;
    unsigned sum, cnt, mine, sp = 0u;
    for (;;) {
        sum = 0u; cnt = 0u; mine = 0u;
#pragma unroll
        for (unsigned j = 0; j < 16; ++j) { const unsigned c = xb_ld(&bar[XB_XCNT(j)]); sum += c; cnt += (c > 0u) ? 1u : 0u; mine = (j == x) ? c : mine; }
        if (sum == G) break;
        __builtin_amdgcn_s_sleep(1);
        if ((++sp & 255u) == 0u) { if (xb_ld(&bar[XB_TMO])) break; if (sp > XB_SPIN_CAP) { atomicAdd(&bar[XB_TMO], 1u); break; } }
    }
    nloc = mine > 0u ? mine : 1u; nx = cnt > 0u ? cnt : 1u;
}
__device__ __forceinline__ void xcd_barrier(const XcdBarrier& b) {
    asm volatile("s_waitcnt vmcnt(0)" ::: "memory");
    __syncthreads();
    if (threadIdx.x == 0) {
        unsigned* bar = b.bar;
        __builtin_amdgcn_s_waitcnt(0);
        unsigned nloc = b.st[0], nx = b.st[1];
        if (nloc == 0u) { xcd_barrier_complete(bar, b.x, nloc, nx); b.st[0] = nloc; b.st[1] = nx; }
        const unsigned old = xb_add(&bar[XB_XSUB(b.x)], 1u);
        const unsigned gen = old / nloc;
        if (old + 1u == (gen + 1u) * nloc) {
            __builtin_amdgcn_fence(__ATOMIC_RELEASE, "agent");
            asm volatile("s_waitcnt vmcnt(0)" ::: "memory");
            const unsigned og = xb_add(&bar[XB_TOP], 1u);
            const unsigned tg = og / nx;
            if (og + 1u == (tg + 1u) * nx) xb_add(&bar[XB_TOPGEN], 1u);
            else XB_SPIN(xb_ld(&bar[XB_TOPGEN]) == tg, bar);
            __builtin_amdgcn_fence(__ATOMIC_ACQUIRE, "agent");
            xb_add(&bar[XB_XGEN(b.x)], 1u);
            asm volatile("s_waitcnt vmcnt(0)" ::: "memory");
        } else {
            XB_SPIN(xb_ld(&bar[XB_XGEN(b.x)]) == gen, bar);
            __builtin_amdgcn_fence(__ATOMIC_ACQUIRE, "agent");
            asm volatile("s_waitcnt vmcnt(0)" ::: "memory");
        }
    }
    __syncthreads();
}

constexpr int LDS_BYTES = 157696 + 512 + 16;
__global__ void __launch_bounds__(NT, 2) k_mega(Params p) {
    __shared__ __attribute__((aligned(16))) unsigned char lds[LDS_BYTES];
    volatile LAS unsigned* xst = (volatile LAS unsigned*)(lds + 157696 + 512);
    if (threadIdx.x == 0) { xst[0] = 0u; xst[1] = 0u; }
    __syncthreads();
    (void)xcd_barrier_post((unsigned*)(p.ws + WS_CTL), xst);
#define GRID_BARRIER() do { XcdBarrier xb_; xb_.bar = (unsigned*)(p.ws + WS_CTL); xb_.x = xb_xcc_id(); xb_.st = (volatile LAS unsigned*)(lds + 157696 + 512); xcd_barrier(xb_); } while (0)
    mod_phase(p, (float*)lds);
    transpose_convert(p.w_in, (bf16_t*)(p.ws + WS_WIN), ND, NIN, (float*)lds);
    transpose_convert(p.w_out, (bf16_t*)(p.ws + WS_WOUT), ND, ND, (float*)lds);
    transpose_convert(p.wq, (bf16_t*)(p.ws + WS_WQ), ND, 2048, (float*)lds);
    convert_flat(p.keys, (bf16_t*)(p.ws + WS_KEYS), (size_t)8 * 2 * 128 * 128);
    GRID_BARRIER();
    prep_phase(p, 0);
    GRID_BARRIER();
    inproj8_phase(p, lds);
    GRID_BARRIER();
    {
        const bool split = gridDim.x >= 256;
        if (!split || blockIdx.x < 128) { hg_chunk_phase(p, lds); }
        __syncthreads();
        na3_phase(p, lds);
    }
    GRID_BARRIER();
    hg_corr_phase(p);
    GRID_BARRIER();
    hgmix_phase(p);
    GRID_BARRIER();
    outproj8_phase(p, lds);
    GRID_BARRIER();
    prep_phase(p, 1);
    GRID_BARRIER();
    pq8_phase(p, lds);
    GRID_BARRIER();
    topk3_phase(p, (float*)lds);
    __threadfence_block(); __syncthreads();
#if PEER_V4
    gather9_phase(p, lds, p.out);
#else
    gather8_phase(p, lds, p.out);
#endif
}
}

extern "C" void kernel_launch(void* const* d_in, const int* in_sizes, int n_in, void* d_out, int out_size, void* d_ws, size_t ws_size, hipStream_t stream) {
    if (n_in != 18 || ws_size < WS_END) { fprintf(stderr, "kernel_launch: unexpected n_in %d / ws_size %zu\n", n_in, ws_size); return; }
    Params p{};
    p.x = (const float*)d_in[0]; p.c = (const float*)d_in[1]; p.ctx = (const float*)d_in[2]; p.c_ctx = (const float*)d_in[3];
    p.w_mod = (const float*)d_in[4]; p.b_mod = (const float*)d_in[5]; p.norm1 = (const float*)d_in[6]; p.norm2 = (const float*)d_in[7];
    p.w_in = (const float*)d_in[8]; p.w_out = (const float*)d_in[9]; p.rpb = (const float*)d_in[10]; p.hg_lb = (const float*)d_in[11];
    p.hg_norm = (const float*)d_in[12]; p.wq = (const float*)d_in[13]; p.keys = (const float*)d_in[14]; p.pu = (const float*)d_in[15];
    p.pv = (const float*)d_in[16]; p.norm_f = (const float*)d_in[17];
    p.out = (float*)d_out; p.ws = (unsigned char*)d_ws;
    static int grid_blocks = 0;
    if (!grid_blocks) {
        int dev = 0, cus = 0, per_cu = 0;
        hipGetDevice(&dev);
        hipDeviceGetAttribute(&cus, hipDeviceAttributeMultiprocessorCount, dev);
        hipOccupancyMaxActiveBlocksPerMultiprocessor(&per_cu, k_mega, NT, 0);
        if (per_cu < 1) { fprintf(stderr, "kernel_launch: occupancy query says %d blocks per CU\n", per_cu); per_cu = 1; }
        if (per_cu > 1) per_cu = 1;
        grid_blocks = cus * per_cu;
    }
    if (hipMemsetAsync((char*)d_ws + WS_CTL, 0, XCD_BAR_WORDS * 4, stream) != hipSuccess) { fprintf(stderr, "kernel_launch: memset of the barrier words failed\n"); return; }
    hipLaunchKernelGGL(k_mega, dim3(grid_blocks), dim3(NT), 0, stream, p);
}
```
